# Optimizing an MI355X kernel written in HIP

```python
import jax
import jax.numpy as jnp
from jax import lax
import numpy as np

D_MODEL = 1024
BATCH = 32
SEQ = 2048
DEPTH = 2

CHUNK = 64
N_MEM = 256
GROUP_WIDTH = D_MODEL // 4
N_GROUPS = 5
D_MIX = N_GROUPS * GROUP_WIDTH
N_HEADS = 4
HEAD_DIM = GROUP_WIDTH // N_HEADS
POOL_WINDOWS = (2, 4, 8, 16)
POOL_CH = GROUP_WIDTH // len(POOL_WINDOWS)
Q_BLOCK = 128
EPS = 1e-6
NEG_BIG = -1e30
LB_FLOOR = 1e-30
IN_SPLITS = (GROUP_WIDTH,) * 4 + (N_HEADS,) + (GROUP_WIDTH,) * 12
D_IN = sum(IN_SPLITS)

kernel_name = "hybrid_fox_stickbreak_hgrn2_pool_memory"

F32 = jnp.float32


def _rms(x, g):
    xf = x.astype(F32)
    y = xf * lax.rsqrt(jnp.mean(xf * xf, axis=-1, keepdims=True) + EPS)
    return (y * g.astype(F32)).astype(x.dtype)


def _split_heads(t):
    b, s, _ = t.shape
    return t.reshape(b, s, N_HEADS, HEAD_DIM).transpose(0, 2, 1, 3)


def _merge_heads(t):
    b, h, s, d = t.shape
    return t.transpose(0, 2, 1, 3).reshape(b, s, h * d)


def _forgetting_attention(q, k, v, log_f):
    s_len = q.shape[2]
    c = jnp.cumsum(log_f, axis=-1)
    scale = HEAD_DIM ** -0.5
    outs = []
    for i in range(s_len // Q_BLOCK):
        t0, t1 = i * Q_BLOCK, (i + 1) * Q_BLOCK
        logits = jnp.einsum('bhtd,bhsd->bhts', q[:, :, t0:t1], k[:, :, :t1]).astype(F32) * scale
        logits = logits + c[:, :, t0:t1, None] - c[:, :, None, :t1]
        mask = jnp.arange(t1)[None, :] <= jnp.arange(t0, t1)[:, None]
        probs = jax.nn.softmax(jnp.where(mask, logits, NEG_BIG), axis=-1)
        outs.append(jnp.einsum('bhts,bhsd->bhtd', probs.astype(v.dtype), v[:, :, :t1]))
    return jnp.concatenate(outs, axis=2)


def _stick_breaking_attention(q, k, v):
    s_len = q.shape[2]
    scale = HEAD_DIM ** -0.5
    outs = []
    for i in range(s_len // Q_BLOCK):
        t0, t1 = i * Q_BLOCK, (i + 1) * Q_BLOCK
        z = jnp.einsum('bhtd,bhsd->bhts', q[:, :, t0:t1], k[:, :, :t1]).astype(F32) * scale
        mask = jnp.arange(t1)[None, :] < jnp.arange(t0, t1)[:, None]
        log_one_minus = jnp.where(mask, jax.nn.log_sigmoid(-z), 0.0)
        log_between = lax.cumsum(log_one_minus, axis=3, reverse=True) - log_one_minus
        log_w = jnp.where(mask, jax.nn.log_sigmoid(z) + log_between, NEG_BIG)
        weights = jnp.where(mask, jnp.exp(log_w), 0.0)
        outs.append(jnp.einsum('bhts,bhsd->bhtd', weights.astype(v.dtype), v[:, :, :t1]))
    return jnp.concatenate(outs, axis=2)


def _hgrn2(q, k, v, log_f):
    b, h, s_len, dk = q.shape
    dv = v.shape[-1]
    n_chunks = s_len // CHUNK

    def chunks(t):
        return t.astype(F32).reshape(b, h, n_chunks, CHUNK, t.shape[-1]).transpose(2, 0, 1, 3, 4)

    causal = jnp.tril(jnp.ones((CHUNK, CHUNK), dtype=bool))[:, :, None]

    def step(state, inp):
        qc, kc, vc, gc = inp
        bcum = jnp.cumsum(gc, axis=2)
        o_inter = jnp.einsum('bhtd,bhde->bhte', qc * jnp.exp(bcum), state)
        diff = bcum[:, :, :, None, :] - bcum[:, :, None, :, :]
        decay = jnp.where(causal, jnp.exp(jnp.where(causal, diff, 0.0)), 0.0)
        scores = jnp.einsum('bhtd,bhsd,bhtsd->bhts', qc, kc, decay)
        o_intra = jnp.einsum('bhts,bhse->bhte', scores, vc)
        b_last = bcum[:, :, -1, :]
        state = jnp.exp(b_last)[..., None] * state + jnp.einsum(
            'bhsd,bhse->bhde', kc * jnp.exp(b_last[:, :, None, :] - bcum), vc)
        return state, o_inter + o_intra

    state0 = jnp.zeros((b, h, dk, dv), F32)
    _, o = lax.scan(step, state0, (chunks(q), chunks(k), chunks(v), chunks(log_f)))
    return o.transpose(1, 2, 0, 3, 4).reshape(b, h, s_len, dv)


def _pool_mixer(u, w, scale):
    b, s_len, _ = u.shape
    n_g = len(POOL_WINDOWS)
    uf = u.astype(F32).reshape(b, s_len, n_g, POOL_CH)
    cs = jnp.cumsum(uf, axis=1)
    cs = jnp.concatenate([jnp.zeros_like(cs[:, :1]), cs], axis=1)
    pos = jnp.arange(1, s_len + 1, dtype=F32)
    means = []
    for gi, win in enumerate(POOL_WINDOWS):
        c = cs[:, :, gi]
        hi = c[:, 1:]
        lo = jnp.pad(c[:, :s_len + 1 - win], ((0, 0), (win - 1, 0), (0, 0)))
        means.append((hi - lo) / jnp.minimum(pos, win)[None, :, None])
    pooled = jnp.stack(means, axis=2)
    y = jnp.einsum('bsgc,gcd->bsgd', pooled - uf, w.astype(F32))
    y = y * scale.astype(F32).reshape(n_g, POOL_CH)
    return y.reshape(b, s_len, GROUP_WIDTH)


def _memory_attention(q, mem, mem_norm_g, mem_w_kv, q_norm, k_norm):
    mn = _rms(mem, mem_norm_g)
    kv = jnp.einsum('bmd,dn->bmn', mn, mem_w_kv)
    k, v = jnp.split(kv, 2, axis=-1)
    qh = _rms(_split_heads(q), q_norm)
    kh = _rms(_split_heads(k), k_norm)
    vh = _split_heads(v)
    logits = jnp.einsum('bhtd,bhmd->bhtm', qh, kh).astype(F32) * (HEAD_DIM ** -0.5)
    probs = jax.nn.softmax(logits, axis=-1)
    return _merge_heads(jnp.einsum('bhtm,bhmd->bhtd', probs.astype(vh.dtype), vh))


def _hybrid_layer(x, mem, norm_g, w_in, fox_f_bias, fox_q_norm, fox_k_norm, lower_bound,
                  hgrn_out_norm, pool_w, pool_scale, mem_norm_g, mem_w_kv, mem_q_norm,
                  mem_k_norm, w_out):
    h = _rms(x, norm_g)
    proj = jnp.einsum('bsd,dn->bsn', h, w_in)
    split_points = np.cumsum(IN_SPLITS)[:-1].tolist()
    (fq, fk, fv, fg, ff, sq, sk, sv, sg, hq, hf, hi, hg, pv, pg, mq, mg) = jnp.split(
        proj, split_points, axis=-1)

    log_f_fox = jax.nn.log_sigmoid((ff + fox_f_bias).astype(F32)).transpose(0, 2, 1)
    qa = _rms(_split_heads(fq), fox_q_norm)
    ka = _rms(_split_heads(fk), fox_k_norm)
    out_a = _merge_heads(_forgetting_attention(qa, ka, _split_heads(fv), log_f_fox))

    out_b = _merge_heads(_stick_breaking_attention(_split_heads(sq), _split_heads(sk), _split_heads(sv)))

    lb = lower_bound.astype(F32)
    hf32 = hf.astype(F32)
    log_lb = jnp.log(jnp.maximum(lb, LB_FLOOR))
    log_f_h = jnp.logaddexp(log_lb, jnp.log1p(-lb) + jax.nn.log_sigmoid(hf32))
    k_h = (1.0 - lb) * jax.nn.sigmoid(-hf32)
    oc = _hgrn2(_split_heads(jax.nn.silu(hq)), _split_heads(k_h), _split_heads(hi), _split_heads(log_f_h))
    oc = _rms(oc, hgrn_out_norm.reshape(N_HEADS, 1, HEAD_DIM))
    out_c = _merge_heads(oc)

    out_d = _pool_mixer(pv, pool_w, pool_scale)

    out_e = _memory_attention(mq, mem, mem_norm_g, mem_w_kv, mem_q_norm, mem_k_norm)

    mixed = jnp.concatenate([
        out_a.astype(x.dtype) * jax.nn.silu(fg),
        out_b.astype(x.dtype) * jax.nn.silu(sg),
        out_c.astype(x.dtype) * jax.nn.silu(hg),
        out_d.astype(x.dtype) * jax.nn.silu(pg),
        out_e.astype(x.dtype) * jax.nn.silu(mg),
    ], axis=-1)
    return x + jnp.einsum('bsn,nd->bsd', mixed, w_out).astype(x.dtype)


def setup_inputs(seed: int = 0) -> dict:
    key = jax.random.key(seed)
    ks = jax.random.split(key, 16)

    def nrm(k, shape, scale):
        return scale * jax.random.normal(k, shape, F32)

    return {
        "x": nrm(ks[0], (BATCH, SEQ, D_MODEL), 1.0),
        "mem": nrm(ks[1], (BATCH, N_MEM, D_MODEL), 1.0),
        "norm_g": 1.0 + nrm(ks[2], (DEPTH, D_MODEL), 0.02),
        "w_in": nrm(ks[3], (DEPTH, D_MODEL, D_IN), D_MODEL ** -0.5),
        "fox_f_bias": nrm(ks[4], (DEPTH, N_HEADS), 0.1),
        "fox_q_norm": 1.0 + nrm(ks[5], (DEPTH, HEAD_DIM), 0.02),
        "fox_k_norm": 1.0 + nrm(ks[6], (DEPTH, HEAD_DIM), 0.02),
        "hgrn_lb_logits": nrm(ks[7], (DEPTH, GROUP_WIDTH), 0.5),
        "hgrn_out_norm": 1.0 + nrm(ks[8], (DEPTH, GROUP_WIDTH), 0.02),
        "pool_w": nrm(ks[9], (DEPTH, len(POOL_WINDOWS), POOL_CH, POOL_CH), POOL_CH ** -0.5),
        "pool_scale": 1.0 + nrm(ks[10], (DEPTH, GROUP_WIDTH), 0.1),
        "mem_norm_g": 1.0 + nrm(ks[11], (DEPTH, D_MODEL), 0.02),
        "mem_w_kv": nrm(ks[12], (DEPTH, D_MODEL, 2 * GROUP_WIDTH), D_MODEL ** -0.5),
        "mem_q_norm": 1.0 + nrm(ks[13], (DEPTH, HEAD_DIM), 0.02),
        "mem_k_norm": 1.0 + nrm(ks[14], (DEPTH, HEAD_DIM), 0.02),
        "w_out": nrm(ks[15], (DEPTH, D_MIX, D_MODEL), D_MIX ** -0.5),
    }


def reference(x, mem, norm_g, w_in, fox_f_bias, fox_q_norm, fox_k_norm, hgrn_lb_logits,
              hgrn_out_norm, pool_w, pool_scale, mem_norm_g, mem_w_kv, mem_q_norm,
              mem_k_norm, w_out):
    p = jax.nn.softmax(hgrn_lb_logits.astype(F32), axis=0)
    lower_bounds = jnp.clip(jnp.cumsum(p, axis=0) - p[0:1], 0.0, 1.0 - 1e-6)
    for l in range(DEPTH):
        x = _hybrid_layer(x, mem, norm_g[l], w_in[l], fox_f_bias[l], fox_q_norm[l], fox_k_norm[l],
                          lower_bounds[l], hgrn_out_norm[l], pool_w[l], pool_scale[l],
                          mem_norm_g[l], mem_w_kv[l], mem_q_norm[l], mem_k_norm[l], w_out[l])
    return x
```

```cpp
#include <hip/hip_runtime.h>
#include <hip/hip_cooperative_groups.h>
#include <cstdio>
#include <cstdint>
namespace cg = cooperative_groups;
namespace pg8 {
#define PG8_LAS __attribute__((address_space(3)))
typedef unsigned short bf16_t;
typedef short bf16x8 __attribute__((ext_vector_type(8)));
typedef float f32x4 __attribute__((ext_vector_type(4)));
typedef unsigned u32x4 __attribute__((ext_vector_type(4)));
constexpr int BM = 256, BK = 64, HALF = 128, HTB = HALF * BK * 2  , STAGE_BYTES = 8 * HTB, NXCD = 8, WGM = 8;

__host__ __device__ __forceinline__ int lds_byte(int r, int c) { const int st = (r >> 4) * 2 + (c >> 5), rr = r & 15, cc = c & 31, ob = rr * 64 + cc * 2; return st * 1024 + (ob ^ (((ob >> 9) & 1) << 5)); }
__host__ __device__ __forceinline__ void stage_rc(int b, int& R, int& C) { const int st = b / 1024, sb = b % 1024, swz = sb ^ (((sb >> 9) & 1) << 5); R = (st >> 1) * 16 + swz / 64; C = (st & 1) * 32 + (swz % 64) / 2; }
__host__ __device__ __forceinline__ int perm32(int rho) { const int n = rho >> 4, i = rho & 15; return 8 * (i >> 2) + 4 * n + (i & 3); }

struct Unit { int pm, pn; };
struct Gemm { const bf16_t* A; const bf16_t* Bt; int M, N, K; };

struct StaticOrder {
    int nM, nN, nwg, G, c;
    __host__ __device__ void init(int M, int N, int G_, int c_) { nM = M / BM; nN = N / BM; nwg = nM * nN; G = G_; c = c_; }
    __host__ __device__ bool next(int i, Unit& u) const {
        const long L = (long)i * G + c; if (L >= nwg) return false;
        int wgid = (int)L; { const int q = nwg / NXCD, r = nwg % NXCD, xcd = wgid % NXCD, off = wgid / NXCD; wgid = (xcd < r ? xcd * (q + 1) : r * (q + 1) + (xcd - r) * q) + off; }
        const int nig = WGM * nN, gid = wgid / nig, fm = gid * WGM, gsz = (nM - fm) < WGM ? (nM - fm) : WGM;
        u.pm = fm + ((wgid % nig) % gsz); u.pn = (wgid % nig) / gsz; return true;
    }
    __device__ __forceinline__ void a_ready(const Unit&) const {}
    __device__ __forceinline__ void done(const Unit&) const {}
};

__device__ __forceinline__ unsigned cvt_pk_bf16(float lo, float hi) { unsigned r; asm volatile("v_cvt_pk_bf16_f32 %0, %1, %2" : "=v"(r) : "v"(lo), "v"(hi)); return r; }
typedef float f32x2 __attribute__((ext_vector_type(2)));
__device__ __forceinline__ f32x2 gelu_pk(f32x2 v) {
    const f32x2 av = __builtin_elementwise_abs(v), d = av * 0.2316418882f + 1.0f;
    f32x2 t; t.x = __builtin_amdgcn_rcpf(d.x); t.y = __builtin_amdgcn_rcpf(d.y);
    f32x2 q = t * 0.5307027145f + (-0.7265760135f); q = q * t + 0.7107068705f; q = q * t + (-0.142248368f); q = q * t + 0.127414796f; q = q * t;
    const f32x2 s = (v * v) * (-0.72134752044f);
    f32x2 e; e.x = __builtin_amdgcn_exp2f(s.x); e.y = __builtin_amdgcn_exp2f(s.y);
    const f32x2 m = v * (q * e), r = v - m;
    f32x2 o; o.x = v.x < 0.f ? m.x : r.x; o.y = v.y < 0.f ? m.y : r.y; return o;
}

template <int ACT  > struct EpiBf16 {
    static constexpr bool PERM = true, AFTER_DRAIN = false; static_assert(ACT == 0 || ACT == 1, "EpiBf16: ACT is 0 (none) or 1 (gelu_pk)");
    bf16_t* O; int ldc; const float* bias; int split_cols; size_t split_stride; float scale0;
    __device__ __forceinline__ void operator()(const f32x4 (&acc)[2][2][4][2], const Unit& u, int wr, int wc, int fr, int fq) const {
        const int row0 = u.pm * BM + wr * 64 + fr; int colt = u.pn * BM; bf16_t* base = O;
        float sc = 1.f; if (split_cols) { const int t = colt / split_cols; base += (size_t)t * split_stride; colt -= t * split_cols; if (t == 0) sc = scale0; }
        const int col0 = colt + wc * 32 + 8 * fq, bcol0 = u.pn * BM + wc * 32 + 8 * fq;
        f32x4 bv[2][2];
#pragma unroll
        for (int bj = 0; bj < 2; ++bj)
#pragma unroll
            for (int n = 0; n < 2; ++n) bv[bj][n] = bias ? *(const f32x4*)(bias + bcol0 + bj * HALF + 4 * n) : (f32x4){0.f, 0.f, 0.f, 0.f};
#pragma unroll
        for (int ai = 0; ai < 2; ++ai)
#pragma unroll
            for (int m = 0; m < 4; ++m) { bf16_t* rowp = base + (size_t)(row0 + ai * HALF + m * 16) * ldc + col0;
#pragma unroll
                for (int bj = 0; bj < 2; ++bj) { f32x4 v0 = acc[ai][bj][m][0] + bv[bj][0], v1 = acc[ai][bj][m][1] + bv[bj][1];
                    if (ACT == 1) { f32x2 a = gelu_pk((f32x2){v0[0], v0[1]}), b = gelu_pk((f32x2){v0[2], v0[3]}), c = gelu_pk((f32x2){v1[0], v1[1]}), d = gelu_pk((f32x2){v1[2], v1[3]});
                        v0 = (f32x4){a.x, a.y, b.x, b.y}; v1 = (f32x4){c.x, c.y, d.x, d.y}; }
                    v0 = v0 * sc; v1 = v1 * sc; u32x4 w; w.x = cvt_pk_bf16(v0[0], v0[1]); w.y = cvt_pk_bf16(v0[2], v0[3]); w.z = cvt_pk_bf16(v1[0], v1[1]); w.w = cvt_pk_bf16(v1[2], v1[3]);
                    *(u32x4*)(rowp + bj * HALF) = w; } }
    }
};

struct EpiRes {
    static constexpr bool PERM = false, AFTER_DRAIN = false;
    const float* base; float* out; int ldc;
    __device__ __forceinline__ void operator()(const f32x4 (&acc)[2][2][4][2], const Unit& u, int wr, int wc, int fr, int fq) const {
        const int col0 = u.pn * BM + wc * 32 + 4 * fq;
#pragma unroll
        for (int ai = 0; ai < 2; ++ai)
#pragma unroll
            for (int m = 0; m < 4; ++m) { const size_t off = (size_t)(u.pm * BM + ai * HALF + wr * 64 + m * 16 + fr) * ldc + col0;
#pragma unroll
                for (int bj = 0; bj < 2; ++bj)
#pragma unroll
                    for (int n = 0; n < 2; ++n) { const f32x4 bs = *(const f32x4*)(base + off + bj * HALF + n * 16); *(f32x4*)(out + off + bj * HALF + n * 16) = bs + acc[ai][bj][m][n]; } }
    }
};

struct EpiResStats {
    static constexpr bool PERM = false, AFTER_DRAIN = false;
    const float* base; float* out; int ldc; unsigned short* xb; const float* gw  ; float* ssp  ; float* ffp  ;
    __device__ __forceinline__ void operator()(const f32x4 (&acc)[2][2][4][2], const Unit& u, int wr, int wc, int fr, int fq) const {
        const int col0 = u.pn * BM + wc * 32 + 4 * fq;
#pragma unroll
        for (int ai = 0; ai < 2; ++ai) {
            float ss[4]; f32x4 ff[4];
#pragma unroll
            for (int m = 0; m < 4; ++m) { ss[m] = 0.f; ff[m] = (f32x4){0.f, 0.f, 0.f, 0.f}; }
#pragma unroll
            for (int bj = 0; bj < 2; ++bj)
#pragma unroll
                for (int n = 0; n < 2; ++n) {
                    const int c = col0 + bj * HALF + n * 16;
                    const f32x4 g0 = *(const f32x4*)(gw + 4 * (size_t)c), g1 = *(const f32x4*)(gw + 4 * (size_t)c + 4), g2 = *(const f32x4*)(gw + 4 * (size_t)c + 8), g3 = *(const f32x4*)(gw + 4 * (size_t)c + 12);
#pragma unroll
                    for (int m = 0; m < 4; ++m) { const size_t off = (size_t)(u.pm * BM + ai * HALF + wr * 64 + m * 16 + fr) * ldc + c;
                        const f32x4 o = *(const f32x4*)(base + off) + acc[ai][bj][m][n];
                        *(f32x4*)(out + off) = o;
                        typedef unsigned u32x2_ __attribute__((ext_vector_type(2)));
                        *(u32x2_*)(xb + off) = (u32x2_){cvt_pk_bf16(o[0], o[1]), cvt_pk_bf16(o[2], o[3])};
                        ss[m] += (o[0] * o[0] + o[1] * o[1]) + (o[2] * o[2] + o[3] * o[3]);
                        ff[m] += g0 * o[0] + g1 * o[1] + g2 * o[2] + g3 * o[3]; }
                }
#pragma unroll
            for (int m = 0; m < 4; ++m) {
                float v5[5] = {ss[m], ff[m][0], ff[m][1], ff[m][2], ff[m][3]};
#pragma unroll
                for (int q = 0; q < 5; ++q) { auto a_ = __builtin_amdgcn_permlane16_swap(__float_as_uint(v5[q]), __float_as_uint(v5[q]), false, false); const float s_ = __uint_as_float(a_[0]) + __uint_as_float(a_[1]);
                    auto b_ = __builtin_amdgcn_permlane32_swap(__float_as_uint(s_), __float_as_uint(s_), false, false); v5[q] = __uint_as_float(b_[0]) + __uint_as_float(b_[1]); }
                if (fq == 0) { const size_t row = (size_t)(u.pm * BM + ai * HALF + wr * 64 + m * 16 + fr); const int slot = u.pn * 4 + wc;
                    ssp[row * 16 + slot] = v5[0]; *(f32x4*)(ffp + (row * 16 + slot) * 4) = (f32x4){v5[1], v5[2], v5[3], v5[4]}; }
            }
            asm volatile("" ::: "memory");
        }
    }
};
struct EpiBf16RowScale {
    static constexpr bool PERM = true, AFTER_DRAIN = false;
    bf16_t* O; int ldc; const float* ssp; float inv_k, eps;
    __device__ __forceinline__ void operator()(const f32x4 (&acc)[2][2][4][2], const Unit& u, int wr, int wc, int fr, int fq) const {
        const int row0 = u.pm * BM + wr * 64 + fr; const int col0 = u.pn * BM + wc * 32 + 8 * fq;
#pragma unroll
        for (int ai = 0; ai < 2; ++ai)
#pragma unroll
            for (int m = 0; m < 4; ++m) { const size_t row = (size_t)(row0 + ai * HALF + m * 16);
                const f32x4 a = *(const f32x4*)(ssp + row * 16), b = *(const f32x4*)(ssp + row * 16 + 4), c = *(const f32x4*)(ssp + row * 16 + 8), d = *(const f32x4*)(ssp + row * 16 + 12);
                const float tot = ((a[0] + a[1]) + (a[2] + a[3])) + ((b[0] + b[1]) + (b[2] + b[3])) + ((c[0] + c[1]) + (c[2] + c[3])) + ((d[0] + d[1]) + (d[2] + d[3]));
                const float sc = 1.0f / sqrtf(tot * inv_k + eps);
                bf16_t* rowp = O + row * ldc + col0;
#pragma unroll
                for (int bj = 0; bj < 2; ++bj) { const f32x4 v0 = acc[ai][bj][m][0] * sc, v1 = acc[ai][bj][m][1] * sc;
                    u32x4 w; w.x = cvt_pk_bf16(v0[0], v0[1]); w.y = cvt_pk_bf16(v0[2], v0[3]); w.z = cvt_pk_bf16(v1[0], v1[1]); w.w = cvt_pk_bf16(v1[2], v1[3]);
                    *(u32x4*)(rowp + bj * HALF) = w; } }
    }
};
template <class Epi, class Sched, bool ALIGN_EPI = false, bool SP2 = false>
__device__ __forceinline__ void gemm_phase(PG8_LAS unsigned char* lds, const Gemm g, const Sched& S, const Epi& E) {
    const int tid = threadIdx.x, wid = __builtin_amdgcn_readfirstlane(tid >> 6), lane = tid & 63, wr = wid >> 2, wc = wid & 3, fr = lane & 15, fq = lane >> 4;
    const int K = g.K, nt = K / BK;
    unsigned voffA[2], voffB[2];
#pragma unroll
    for (int i = 0; i < 2; ++i) { int R, C; stage_rc(tid * 16 + i * 8192, R, C); const int Rb = Epi::PERM ? ((R & ~31) + perm32(R & 31)) : R;
        voffA[i] = (unsigned)(R * K + C) * 2u; voffB[i] = (unsigned)(Rb * K + C) * 2u; }
    const size_t kstep = (size_t)(BK * 2);
    const size_t hstep = (size_t)HALF * K * 2;
    const size_t tstep = 2 * hstep;
    const unsigned ldsw = (unsigned)wid * 1024u;
    const int aoff = lds_byte(wr * 64 + fr, fq * 8), boff = lds_byte(wc * 32 + fr, fq * 8);
#define PG8_SA(b, h) (((b) * 2 + (h)) * HTB)
#define PG8_SB(b, h) ((4 + (b) * 2 + (h)) * HTB)
#define PG8_STAGE(bufoff, gbase, voff) do { _Pragma("unroll") for (int _i = 0; _i < 2; ++_i) \
        __builtin_amdgcn_global_load_lds((const unsigned*)((const char*)(gbase) + (voff)[_i]), (PG8_LAS unsigned*)(lds + (bufoff) + ldsw + _i * 8192), 16, 0, 0); } while (0)
#define PG8_LDA(dst, b, h) do { _Pragma("unroll") for (int m = 0; m < 4; ++m) _Pragma("unroll") for (int k = 0; k < 2; ++k) dst[m][k] = *(const PG8_LAS bf16x8*)(lds + PG8_SA(b, h) + aoff + m * 2048 + k * 1024); } while (0)
#define PG8_LDB(dst, b, h) do { _Pragma("unroll") for (int n = 0; n < 2; ++n) _Pragma("unroll") for (int k = 0; k < 2; ++k) dst[n][k] = *(const PG8_LAS bf16x8*)(lds + PG8_SB(b, h) + boff + n * 2048 + k * 1024); } while (0)
#define PG8_MMA(ai, bj, At, Bt) do { __builtin_amdgcn_s_setprio(1); _Pragma("unroll") for (int m = 0; m < 4; ++m) _Pragma("unroll") for (int n = 0; n < 2; ++n) _Pragma("unroll") for (int k = 0; k < 2; ++k) \
        acc[ai][bj][m][n] = __builtin_amdgcn_mfma_f32_16x16x32_bf16(Bt[n][k], At[m][k], acc[ai][bj][m][n], 0, 0, 0); __builtin_amdgcn_s_setprio(0); } while (0)
#define PG8_WAIT_V(n) asm volatile("s_waitcnt vmcnt(" #n ")" ::: "memory")
#define PG8_WAIT_L(n) asm volatile("s_waitcnt lgkmcnt(" #n ")" ::: "memory")
#define PG8_BAR __builtin_amdgcn_s_barrier()
#define PG8_SCHED __builtin_amdgcn_sched_barrier(0)
    Unit cur, nxt; int ui = 0;
    if (!S.next(0, cur)) return;
    f32x4 acc[2][2][4][2];
#pragma unroll
    for (int a = 0; a < 2; ++a)
#pragma unroll
        for (int b = 0; b < 2; ++b)
#pragma unroll
            for (int m = 0; m < 4; ++m)
#pragma unroll
                for (int n = 0; n < 2; ++n) acc[a][b][m][n] = (f32x4){0.f, 0.f, 0.f, 0.f};
    bf16x8 At[4][2], B0[2][2], B1[2][2];
    const char* cA = (const char*)g.A + (size_t)cur.pm * tstep; const char* cB = (const char*)g.Bt + (size_t)cur.pn * tstep;
    S.a_ready(cur);
    if constexpr (SP2) {
        PG8_STAGE(PG8_SB(0, 0), cB, voffB); PG8_STAGE(PG8_SB(0, 1), cB + hstep, voffB); PG8_STAGE(PG8_SA(0, 0), cA, voffA); PG8_STAGE(PG8_SA(0, 1), cA + hstep, voffA);
        if (wr == 1) PG8_BAR;
        PG8_WAIT_V(2); PG8_BAR;
        PG8_STAGE(PG8_SB(1, 0), cB + kstep, voffB); PG8_STAGE(PG8_SA(1, 0), cA + kstep, voffA); PG8_STAGE(PG8_SB(1, 1), cB + hstep + kstep, voffB);
        PG8_WAIT_V(6); PG8_BAR;
    } else {
        PG8_STAGE(PG8_SB(0, 0), cB, voffB); PG8_STAGE(PG8_SA(0, 0), cA, voffA); PG8_STAGE(PG8_SB(0, 1), cB + hstep, voffB); PG8_STAGE(PG8_SA(0, 1), cA + hstep, voffA);
        if (wr == 1) PG8_BAR;
        PG8_WAIT_V(4); PG8_BAR;
        PG8_STAGE(PG8_SB(1, 0), cB + kstep, voffB); PG8_STAGE(PG8_SA(1, 0), cA + kstep, voffA); PG8_STAGE(PG8_SB(1, 1), cB + hstep + kstep, voffB);
        PG8_WAIT_V(6); PG8_BAR;
    }
    for (;;) {
        const bool has_next = S.next(ui + 1, nxt);
        const char* nA = has_next ? (const char*)g.A + (size_t)nxt.pm * tstep : cA; const char* nB = has_next ? (const char*)g.Bt + (size_t)nxt.pn * tstep : cB;
        for (int t = 0; t < nt; t += 2) {
            const bool last = (t == nt - 2);
            const char* a1 = cA + (size_t)(t + 1) * kstep;
            const char* a2 = last ? nA : cA + (size_t)(t + 2) * kstep; const char* b2 = last ? nB : cB + (size_t)(t + 2) * kstep;
            const char* a3 = a2 + kstep; const char* b3 = b2 + kstep;
            if (last && has_next) S.a_ready(nxt);
            if constexpr (SP2) {
            PG8_LDB(B0, 0, 0); PG8_LDB(B1, 0, 1); PG8_SCHED; PG8_LDA(At, 0, 0); PG8_STAGE(PG8_SA(1, 1), a1 + hstep, voffA);
            PG8_WAIT_V(8); PG8_WAIT_L(0); PG8_BAR; PG8_MMA(0, 0, At, B0); PG8_MMA(0, 1, At, B1); PG8_BAR; PG8_SCHED;
            PG8_LDA(At, 0, 1); PG8_STAGE(PG8_SB(0, 0), b2, voffB); PG8_STAGE(PG8_SB(0, 1), b2 + hstep, voffB); PG8_STAGE(PG8_SA(0, 0), a2, voffA);
            PG8_WAIT_V(8); PG8_WAIT_L(0); PG8_BAR; PG8_MMA(1, 0, At, B0); PG8_MMA(1, 1, At, B1); PG8_BAR; PG8_SCHED;
            PG8_LDB(B0, 1, 0); PG8_LDB(B1, 1, 1); PG8_SCHED; PG8_LDA(At, 1, 0); PG8_STAGE(PG8_SA(0, 1), a2 + hstep, voffA);
            PG8_WAIT_V(8); PG8_WAIT_L(0); PG8_BAR; PG8_MMA(0, 0, At, B0); PG8_MMA(0, 1, At, B1); PG8_BAR; PG8_SCHED;
            PG8_LDA(At, 1, 1); PG8_STAGE(PG8_SB(1, 0), b3, voffB); PG8_STAGE(PG8_SB(1, 1), b3 + hstep, voffB); PG8_STAGE(PG8_SA(1, 0), a3, voffA);
            PG8_WAIT_V(8); PG8_WAIT_L(0); PG8_BAR; PG8_MMA(1, 0, At, B0); PG8_MMA(1, 1, At, B1); PG8_BAR; PG8_SCHED;
            } else {
            PG8_LDB(B0, 0, 0); PG8_SCHED; PG8_LDA(At, 0, 0); PG8_STAGE(PG8_SA(1, 1), a1 + hstep, voffA);
            PG8_WAIT_L(8); PG8_BAR; PG8_WAIT_L(0); PG8_MMA(0, 0, At, B0); PG8_BAR; PG8_SCHED;
            PG8_LDB(B1, 0, 1); PG8_STAGE(PG8_SB(0, 0), b2, voffB);
            PG8_BAR; PG8_WAIT_L(0); PG8_MMA(0, 1, At, B1); PG8_BAR;
            PG8_LDA(At, 0, 1); PG8_STAGE(PG8_SA(0, 0), a2, voffA);
            PG8_BAR; PG8_WAIT_L(0); PG8_MMA(1, 0, At, B0); PG8_BAR; PG8_SCHED;
            PG8_STAGE(PG8_SB(0, 1), b2 + hstep, voffB);
            PG8_WAIT_V(6); PG8_BAR; PG8_MMA(1, 1, At, B1); PG8_BAR;
            PG8_LDB(B0, 1, 0); PG8_SCHED; PG8_LDA(At, 1, 0); PG8_STAGE(PG8_SA(0, 1), a2 + hstep, voffA);
            PG8_WAIT_L(8); PG8_BAR; PG8_WAIT_L(0); PG8_MMA(0, 0, At, B0); PG8_BAR; PG8_SCHED;
            PG8_LDB(B1, 1, 1); PG8_STAGE(PG8_SB(1, 0), b3, voffB);
            PG8_BAR; PG8_WAIT_L(0); PG8_MMA(0, 1, At, B1); PG8_BAR;
            PG8_LDA(At, 1, 1); PG8_STAGE(PG8_SA(1, 0), a3, voffA);
            PG8_BAR; PG8_WAIT_L(0); PG8_MMA(1, 0, At, B0); PG8_BAR; PG8_SCHED;
            PG8_STAGE(PG8_SB(1, 1), b3 + hstep, voffB);
            PG8_WAIT_V(6); PG8_BAR; PG8_MMA(1, 1, At, B1); PG8_BAR;
            }
        }
        if constexpr (ALIGN_EPI) { if (wr == 0) PG8_BAR; }
        if constexpr (!Epi::AFTER_DRAIN) { E(acc, cur, wr, wc, fr, fq); S.done(cur); }
        if (!has_next) break;
#pragma unroll
        for (int a = 0; a < 2; ++a)
#pragma unroll
            for (int b = 0; b < 2; ++b)
#pragma unroll
                for (int m = 0; m < 4; ++m)
#pragma unroll
                    for (int n = 0; n < 2; ++n) acc[a][b][m][n] = (f32x4){0.f, 0.f, 0.f, 0.f};
        cur = nxt; cA = nA; cB = nB; ++ui;
        if constexpr (ALIGN_EPI) { if (wr == 1) PG8_BAR; }
    }
    PG8_WAIT_V(0);
    if constexpr (!ALIGN_EPI) { if (wr == 0) PG8_BAR; }
    PG8_BAR;
    if constexpr (Epi::AFTER_DRAIN) { E.fused(acc, cur, wr, wc, fr, fq, lds, wid, lane); S.done(cur); }
#undef PG8_SA
#undef PG8_SB
#undef PG8_STAGE
#undef PG8_LDA
#undef PG8_LDB
#undef PG8_MMA
#undef PG8_WAIT_V
#undef PG8_WAIT_L
#undef PG8_BAR
#undef PG8_SCHED
}
}
#ifndef EPI_NORM
#define EPI_NORM 0
#endif

#ifndef PROBE_PH
#define PROBE_PH 0
#endif
#ifndef PROBE_UNIT
#define PROBE_UNIT 0
#endif
#ifndef PROBE_SUB
#define PROBE_SUB 0
#endif
#ifndef MK_SINGLE_LAUNCH
#define MK_SINGLE_LAUNCH 1
#endif

constexpr int DM = 1024, NB = 32, SEQ = 2048, NTOK = NB * SEQ, NMEM = 256, DIN = 4100, NP = 4096, DMIX = 1280, NH = 4, HD = 64, DEPTH = 2;
constexpr float EPS = 1e-6f, LOG2E = 1.4426950408889634f;
constexpr int C_FQ = 0, C_FK = 256, C_FV = 512, C_FG = 768, C_SQ = 1024, C_SK = 1280, C_SV = 1536, C_SG = 1792, C_HQ = 2048, C_HF = 2304, C_HI = 2560, C_HG = 2816, C_PV = 3072, C_PG = 3328, C_MQ = 3584, C_MG = 3840;
constexpr int O_FOX = 0, O_SB = 256, O_HG = 512, O_POOL = 768, O_MEM = 1024;

constexpr size_t MiB = 1u << 20;
constexpr size_t WS_CTL = 0, CTL_ZERO_BYTES = 32768;
constexpr size_t WS_WIN = 2 * MiB, WIN_BYTES = (size_t)NP * DM * 2;
constexpr size_t WS_WOUT = 18 * MiB, WOUT_BYTES = (size_t)DM * DMIX * 2;
constexpr size_t WS_WKV = 24 * MiB, WKV_BYTES = (size_t)512 * DM * 2;
constexpr size_t WS_WPOOL = 27 * MiB, WPOOL_BYTES = 4 * 64 * 64 * 2;
constexpr size_t WS_LF = 26 * MiB;
constexpr size_t WS_MNB = 28 * MiB, MNB_BYTES = (size_t)NB * NMEM * DM * 2;
constexpr size_t WS_KVM = 60 * MiB, KVM_BYTES = (size_t)NB * NMEM * 512 * 2;
constexpr size_t WS_HB = 76 * MiB;
constexpr size_t WS_MIX = 204 * MiB;
constexpr size_t WS_PROJ = 364 * MiB;
constexpr size_t WS_C2 = 876 * MiB;
constexpr size_t WS_SSP = 877 * MiB;
constexpr size_t WS_FFP = 881 * MiB;
constexpr size_t WS_GW = 897 * MiB;
constexpr size_t WS_END = 898 * MiB;

constexpr int LDS_BYTES = 147456;
constexpr int LDS_SLOT = LDS_BYTES - 64;

#define LAS __attribute__((address_space(3)))
typedef LAS unsigned char* ldsp;
typedef unsigned short bf16_t;
typedef short bf16x8 __attribute__((ext_vector_type(8)));
typedef short s16x4 __attribute__((ext_vector_type(4)));
typedef float f32x16 __attribute__((ext_vector_type(16)));
typedef float f32x4 __attribute__((ext_vector_type(4)));
typedef float f32x2 __attribute__((ext_vector_type(2)));
typedef unsigned u32x4 __attribute__((ext_vector_type(4)));
typedef unsigned u32x2 __attribute__((ext_vector_type(2)));
typedef __bf16 bf16x2_t __attribute__((ext_vector_type(2)));

#define DI __device__ __forceinline__
DI float bf_lo(unsigned u) { return __uint_as_float(u << 16); }
DI float bf_hi(unsigned u) { return __uint_as_float(u & 0xffff0000u); }
DI unsigned pk2(float lo, float hi) { f32x2 v = {lo, hi}; bf16x2_t b = __builtin_convertvector(v, bf16x2_t); return __builtin_bit_cast(unsigned, b); }
DI float ex2(float x) { return __builtin_amdgcn_exp2f(x); }
DI float rcpf_(float x) { return __builtin_amdgcn_rcpf(x); }
DI float silu_f(float x) { return x * rcpf_(1.f + ex2(-x * LOG2E)); }
template <int CTRL> DI float dppf(float v) { return __uint_as_float((unsigned)__builtin_amdgcn_update_dpp(0, (int)__float_as_uint(v), CTRL, 0xF, 0xF, true)); }
DI float sum8(float v) { v += dppf<0xB1>(v); v += dppf<0x4E>(v); v += dppf<0x141>(v); return v; }
DI float sum16(float v) { v = sum8(v); v += dppf<0x140>(v); return v; }
DI float wave_sum(float v) { v = sum16(v);
    return (__int_as_float(__builtin_amdgcn_readlane(__float_as_int(v), 0)) + __int_as_float(__builtin_amdgcn_readlane(__float_as_int(v), 16))) +
           (__int_as_float(__builtin_amdgcn_readlane(__float_as_int(v), 32)) + __int_as_float(__builtin_amdgcn_readlane(__float_as_int(v), 48))); }
DI void halves(float x, float& lo, float& hi) { auto rr = __builtin_amdgcn_permlane32_swap(__float_as_uint(x), __float_as_uint(x), false, false); lo = __uint_as_float(rr[0]); hi = __uint_as_float(rr[1]); }
template <class T> DI T* launder(T* p) { asm volatile("" : "+s"(p)); return p; }
#define MFMA32(a, b, c) __builtin_amdgcn_mfma_f32_32x32x16_bf16((a), (b), (c), 0, 0, 0)

struct Params {
    const float *x, *mem, *norm_g, *w_in, *fox_f_bias, *fox_q_norm, *fox_k_norm, *lb_logits, *hgrn_out_norm, *pool_w, *pool_scale, *mem_norm_g, *mem_w_kv, *mem_q_norm, *mem_k_norm, *w_out;
    float* out; unsigned char* ws; int ph_lo, ph_hi;
};
typedef const __attribute__((address_space(4))) Params* kargp;
DI kargp kargs() { kargp p = (kargp)__builtin_amdgcn_kernarg_segment_ptr(); asm volatile("" : "+s"(p)); return p; }

DI void transpose_item(const float* W, int K, int ldw, bf16_t* WT, int k0, int src_n0, int dst_n0, LAS float* scr, int lane, const float* kscale = nullptr) {
#pragma unroll 8
    for (int i = 0; i < 32; ++i) { const int kk = 2 * i + (lane >> 5); scr[kk * 33 + (lane & 31)] = W[(size_t)(k0 + kk) * ldw + src_n0 + (lane & 31)] * (kscale ? kscale[k0 + kk] : 1.f); }
    asm volatile("s_waitcnt lgkmcnt(0)" ::: "memory");
    const int c = lane & 7;
#pragma unroll
    for (int j = 0; j < 4; ++j) { const int n = (lane >> 3) + 8 * j; const LAS float* s = scr + (8 * c) * 33 + n;
        u32x4 o; o.x = pk2(s[0 * 33], s[1 * 33]); o.y = pk2(s[2 * 33], s[3 * 33]); o.z = pk2(s[4 * 33], s[5 * 33]); o.w = pk2(s[6 * 33], s[7 * 33]);
        *(u32x4*)(WT + (size_t)(dst_n0 + n) * K + k0 + 8 * c) = o; }
    asm volatile("s_waitcnt lgkmcnt(0)" ::: "memory");
}

DI void weights_phase(ldsp lds, int gw, int NGW, int wave, int lane) {
    if (EPI_NORM) { kargp P = kargs(); float* gwt = (float*)(P->ws + WS_GW);
      for (int i = gw * 64 + lane; i < DM * 4; i += NGW * 64) { const int c = i >> 2, j = i & 3; gwt[i] = P->norm_g[DM + c] * P->w_in[(size_t)DM * DIN + (size_t)c * DIN + 1024 + j]; } }
    { kargp P = kargs(); const float* pw = P->pool_w; bf16_t* wt = (bf16_t*)(P->ws + WS_WPOOL);
      for (int i = gw * 64 + lane; i < DEPTH * 4 * 64 * 64; i += NGW * 64) { const int lg = i >> 12, c = (i >> 6) & 63, d = i & 63; wt[(lg * 64 + d) * 64 + c] = (bf16_t)(pk2(pw[i], 0.f) & 0xffffu); } }
    LAS float* scr = (LAS float*)(lds + wave * 16384);
    constexpr int I_IN = (DM / 64) * (NP / 32), I_OUT = (DMIX / 64) * (DM / 32), I_KV = (DM / 64) * (512 / 32), I_L = I_IN + I_OUT + I_KV;
    for (int it = gw; it < DEPTH * I_L; it += NGW) {
        const int l = it / I_L; int r = it % I_L; kargp P = kargs();
        if (r < I_IN) { const int nblk = NP / 32, kb = r / nblk, nb = r % nblk, n0 = 32 * nb;
            transpose_item(P->w_in + (size_t)l * DM * DIN, DM, DIN, (bf16_t*)(P->ws + WS_WIN + l * WIN_BYTES), 64 * kb, n0 + (n0 >= 1024 ? 4 : 0), n0, scr, lane, (EPI_NORM && l == 1) ? P->norm_g + DM : nullptr); continue; }
        r -= I_IN;
        if (r < I_OUT) { const int nblk = DM / 32, kb = r / nblk, nb = r % nblk;
            transpose_item(P->w_out + (size_t)l * DMIX * DM, DMIX, DM, (bf16_t*)(P->ws + WS_WOUT + l * WOUT_BYTES), 64 * kb, 32 * nb, 32 * nb, scr, lane); continue; }
        r -= I_OUT;
        { const int nblk = 512 / 32, kb = r / nblk, nb = r % nblk;
            transpose_item(P->mem_w_kv + (size_t)l * DM * 512, DM, 512, (bf16_t*)(P->ws + WS_WKV + l * WKV_BYTES), 64 * kb, 32 * nb, 32 * nb, scr, lane); }
    }
}

DI void memnorm_phase(int gw, int NGW, int lane) {
    kargp P = kargs(); const float* mng = P->mem_norm_g; const float* memp = P->mem; unsigned char* ws = P->ws;
    f32x4 g0[4], g1[4];
#pragma unroll
    for (int j = 0; j < 4; ++j) { g0[j] = ((const f32x4*)mng)[64 * j + lane]; g1[j] = ((const f32x4*)(mng + DM))[64 * j + lane]; }
    for (int m = gw; m < NB * NMEM; m += NGW) {
        const f32x4* xr = (const f32x4*)(memp + (size_t)m * DM) + lane;
        f32x4 v[4]; float s = 0.f;
#pragma unroll
        for (int j = 0; j < 4; ++j) { v[j] = xr[64 * j]; s += (v[j].x * v[j].x + v[j].y * v[j].y) + (v[j].z * v[j].z + v[j].w * v[j].w); }
        const float rstd = 1.0f / sqrtf(wave_sum(s) * (1.f / DM) + EPS);
        u32x2* o0 = (u32x2*)(ws + WS_MNB + (size_t)m * DM * 2) + lane; u32x2* o1 = (u32x2*)(ws + WS_MNB + MNB_BYTES + (size_t)m * DM * 2) + lane;
#pragma unroll
        for (int j = 0; j < 4; ++j) { const f32x4 y = v[j] * rstd; const f32x4 a = y * g0[j], b = y * g1[j];
            o0[64 * j] = (u32x2){pk2(a.x, a.y), pk2(a.z, a.w)}; o1[64 * j] = (u32x2){pk2(b.x, b.y), pk2(b.z, b.w)}; }
    }
}

DI void norm_phase(ldsp lds, const float* x, const float* g, const float* w_in_l, const float* fbias, bf16_t* hb, float* lf, int gw, int NGW, int mend, int tid, int lane) {
    for (int k = tid; k < DM; k += 512) { const int j = k >> 8, ln = (k & 255) >> 2, i = k & 3;
        *(LAS f32x4*)(lds + 16 * ((j * 4 + i) * 64 + ln)) = *(const f32x4*)(w_in_l + (size_t)k * DIN + 1024); }
    __syncthreads();
    f32x4 gv[4];
#pragma unroll
    for (int j = 0; j < 4; ++j) gv[j] = ((const f32x4*)g)[64 * j + lane];
    const float mybias = fbias[lane & 3];
    f32x4 nv[4], nv2[4];
    if (gw < mend) { const f32x4* xr = (const f32x4*)(x + (size_t)gw * DM) + lane;
#pragma unroll
        for (int j = 0; j < 4; ++j) nv[j] = xr[64 * j]; }
    if (gw + NGW < mend) { const f32x4* xr = (const f32x4*)(x + (size_t)(gw + NGW) * DM) + lane;
#pragma unroll
        for (int j = 0; j < 4; ++j) nv2[j] = xr[64 * j]; }
    for (int m = gw; m < mend; m += NGW) {
        f32x4 v[4]; float s = 0.f;
#pragma unroll
        for (int j = 0; j < 4; ++j) { v[j] = nv[j]; nv[j] = nv2[j]; }
        if (m + 2 * NGW < mend) { const f32x4* xn = (const f32x4*)(x + (size_t)(m + 2 * NGW) * DM) + lane;
#pragma unroll
            for (int j = 0; j < 4; ++j) nv2[j] = xn[64 * j]; }
#pragma unroll
        for (int j = 0; j < 4; ++j) s += (v[j].x * v[j].x + v[j].y * v[j].y) + (v[j].z * v[j].z + v[j].w * v[j].w);
        const float rstd = 1.0f / sqrtf(wave_sum(s) * (1.f / DM) + EPS);
        u32x2* o8 = (u32x2*)(hb + (size_t)m * DM) + lane;
        f32x4 ff = {0.f, 0.f, 0.f, 0.f};
#pragma unroll
        for (int j = 0; j < 4; ++j) { const f32x4 y = (v[j] * rstd) * gv[j];
            o8[64 * j] = (u32x2){pk2(y.x, y.y), pk2(y.z, y.w)};
#pragma unroll
            for (int i = 0; i < 4; ++i) { const f32x4 w = *(LAS f32x4*)(lds + 16 * ((j * 4 + i) * 64 + lane)); ff += w * y[i]; } }
        ff.x = wave_sum(ff.x); ff.y = wave_sum(ff.y); ff.z = wave_sum(ff.z); ff.w = wave_sum(ff.w);
        if (lane < 4) { const float z = (lane == 0 ? ff.x : lane == 1 ? ff.y : lane == 2 ? ff.z : ff.w) + mybias;
            lf[(size_t)m * 4 + lane] = fminf(z, 0.f) - log1pf(expf(-fabsf(z))); }
    }
    __syncthreads();
}

DI void knorm_rows(bf16_t* base, int nrows4  , int stride, const float* kw, int gw, int NGW, int lane) {
    const f32x4 w0 = *(const f32x4*)(kw + 8 * (lane & 7)), w1 = *(const f32x4*)(kw + 8 * (lane & 7) + 4);
    for (int r8 = gw; r8 < nrows4 / 8; r8 += NGW) { const int rid = r8 * 8 + (lane >> 3);
        u32x4* p = (u32x4*)(base + (size_t)(rid >> 2) * stride + (rid & 3) * HD + 8 * (lane & 7));
        const u32x4 kr = *p;
        const float f[8] = {bf_lo(kr.x), bf_hi(kr.x), bf_lo(kr.y), bf_hi(kr.y), bf_lo(kr.z), bf_hi(kr.z), bf_lo(kr.w), bf_hi(kr.w)};
        float ss = 0.f;
#pragma unroll
        for (int j = 0; j < 8; ++j) ss += f[j] * f[j];
        ss = sum8(ss);
        const float rstd = __builtin_amdgcn_rsqf(ss * (1.f / HD) + EPS);
        *p = (u32x4){pk2(f[0] * rstd * w0.x, f[1] * rstd * w0.y), pk2(f[2] * rstd * w0.z, f[3] * rstd * w0.w), pk2(f[4] * rstd * w1.x, f[5] * rstd * w1.y), pk2(f[6] * rstd * w1.z, f[7] * rstd * w1.w)}; }
}
DI void kprep_phase(ldsp lds, int layer) {
    kargp P = kargs(); const int tid = threadIdx.x, lane = tid & 63, wave = __builtin_amdgcn_readfirstlane(tid >> 6), gw = blockIdx.x * 8 + wave, NGW = gridDim.x * 8;
    knorm_rows((bf16_t*)(P->ws + WS_PROJ) + C_FK, NTOK * 4, NP, P->fox_k_norm + layer * HD, gw, NGW, lane);
    knorm_rows((bf16_t*)(P->ws + WS_KVM + layer * KVM_BYTES), NB * NMEM * 4, 512, P->mem_k_norm + layer * HD, gw, NGW, lane);
    if (blockIdx.x < NB * NH) {
        const int b = blockIdx.x >> 2, h = blockIdx.x & 3;
        const float* lfp = (const float*)(P->ws + WS_LF) + (size_t)b * SEQ * 4 + h;
        float a[4];
#pragma unroll
        for (int j = 0; j < 4; ++j) a[j] = lfp[(size_t)(4 * tid + j) * 4];
        const float s0 = a[0], s1 = s0 + a[1], s2 = s1 + a[2], s3 = s2 + a[3];
        float inc = s3;
#pragma unroll
        for (int off = 1; off < 64; off <<= 1) { const float v = __shfl_up(inc, off); if (lane >= off) inc += v; }
        LAS float* wsum = (LAS float*)lds;
        if (lane == 63) wsum[wave] = inc;
        __syncthreads();
        float offs = 0.f;
        for (int w = 0; w < wave; ++w) offs += wsum[w];
        const float pre = offs + inc - s3;
        *(f32x4*)((float*)(P->ws + WS_C2) + (size_t)blockIdx.x * SEQ + 4 * tid) = (f32x4){(pre + s0) * LOG2E, (pre + s1) * LOG2E, (pre + s2) * LOG2E, (pre + s3) * LOG2E};
        __syncthreads();
    }
}

constexpr int ATT_SLOT = 16384, ATT_NSLOT = 5, ATT_NRES = 6, ATT_CS = ATT_NRES * ATT_SLOT, ATT_FLAG = ATT_CS + 8192, ATT_RK = ATT_FLAG + 128, ATT_WT = ATT_RK + ATT_NRES * 256, ATT_Q = ATT_WT + 64, ATT_END = ATT_Q + 32768;
static_assert(ATT_END <= 147392, "attention LDS map");
#ifndef FUSE_NORM
#define FUSE_NORM 0
#endif
#ifndef ATT_STAGGER
#define ATT_STAGGER 0
#endif
#ifndef ATT_TILE_SKIP
#define ATT_TILE_SKIP 1
#endif
DI int crow(int reg, int h) { return (reg & 3) + 8 * (reg >> 2) + 4 * h; }
DI int swz8(int row) { const int x = (row >> 1) & 7; return ((x & 1) << 2) | (x >> 1); }
DI u32x4 pack8(const f32x16& p, int s) { return (u32x4){pk2(p[8 * s], p[8 * s + 1]), pk2(p[8 * s + 2], p[8 * s + 3]), pk2(p[8 * s + 4], p[8 * s + 5]), pk2(p[8 * s + 6], p[8 * s + 7])}; }
DI s16x4 tr_rd(ldsp p) { typedef short v4i16_t __attribute__((ext_vector_type(4))); return __builtin_bit_cast(s16x4, __builtin_amdgcn_ds_read_tr16_b64_v4i16((LAS v4i16_t*)p)); }
DI void att_zero(f32x16& p0, f32x16& p1) {
#pragma unroll
    for (int i = 0; i < 16; ++i) { p0[i] = 0.f; p1[i] = 0.f; }
}
template <int MODE> DI void att_bias(f32x16& p0, f32x16& p1, ldsp lds, int slot, int kt, int hh) {
    if (MODE == 1) return;
#pragma unroll
    for (int g = 0; g < 4; ++g) {
        const f32x4 r0 = *(LAS f32x4*)(lds + ATT_RK + 4 * (64 * slot + 8 * g + 4 * hh)), r1 = *(LAS f32x4*)(lds + ATT_RK + 4 * (64 * slot + 32 + 8 * g + 4 * hh));
        if (MODE == 0) { const f32x4 c0 = *(LAS f32x4*)(lds + ATT_CS + 4 * (64 * kt + 8 * g + 4 * hh)), c1 = *(LAS f32x4*)(lds + ATT_CS + 4 * (64 * kt + 32 + 8 * g + 4 * hh));
#pragma unroll
            for (int j = 0; j < 4; ++j) { p0[4 * g + j] = p0[4 * g + j] * r0[j] + c0[j]; p1[4 * g + j] = p1[4 * g + j] * r1[j] + c1[j]; } }
        else {
#pragma unroll
            for (int j = 0; j < 4; ++j) { p0[4 * g + j] *= r0[j]; p1[4 * g + j] *= r1[j]; } }
    }
}
template <int MODE> DI void att_prep(ldsp lds, int slot, int kt, const float* lfp, int tid, int lane, int wid) {
    if (MODE == 1) return;
    { const int row = tid >> 3, sc = tid & 7;
      const u32x4 kr = *(LAS u32x4*)(lds + slot * ATT_SLOT + row * 128 + ((sc ^ swz8(row)) << 4));
      const float f[8] = {bf_lo(kr.x), bf_hi(kr.x), bf_lo(kr.y), bf_hi(kr.y), bf_lo(kr.z), bf_hi(kr.z), bf_lo(kr.w), bf_hi(kr.w)};
      float ss = 0.f;
#pragma unroll
      for (int j = 0; j < 8; ++j) ss += f[j] * f[j];
      ss = sum8(ss);
      if (sc == 0) *(LAS float*)(lds + ATT_RK + 4 * (64 * slot + row)) = __builtin_amdgcn_rsqf(ss * (1.f / HD) + EPS); }
    if (MODE == 0 && wid == 0) {
        const float a = lfp[(size_t)(64 * kt + lane) * 4] * LOG2E;
        float suf = a;
#pragma unroll
        for (int off = 1; off < 64; off <<= 1) { const float v = __shfl_down(suf, off); if (lane + off < 64) suf += v; }
        const float E = *(LAS float*)(lds + ATT_WT + 32);
        *(LAS float*)(lds + ATT_CS + 4 * (64 * kt + lane)) = E + suf - a;
        if (lane == 0) *(LAS float*)(lds + ATT_WT + 32) = E + suf;
    }
}
DI void att_qk(f32x16& p0, f32x16& p1, ldsp Kb, ldsp Qb  , int r, int hh) {
    const int sw = swz8(r);
#pragma unroll
    for (int ks = 0; ks < 4; ++ks) {
        const int co = ((2 * ks + hh) ^ sw) << 4;
        const bf16x8 k0 = *(LAS bf16x8*)(Kb + r * 128 + co);
        const bf16x8 k1 = *(LAS bf16x8*)(Kb + (32 + r) * 128 + co);
        const bf16x8 qv = *(LAS bf16x8*)(Qb + 1024 * ks);
        p0 = MFMA32(k0, qv, p0); p1 = MFMA32(k1, qv, p1); }
}
DI void att_pv(f32x16& o0, f32x16& o1, ldsp Vb, const f32x16& p0, const f32x16& p1, int hh, int q4, int p4, int blk) {
    const int rl = 4 * hh + q4, sl = swz8(rl), sh = swz8(rl + 8), cb = 2 * blk + (p4 >> 1), in8 = 8 * (p4 & 1);
    const int ol0 = rl * 128 + ((cb ^ sl) << 4) + in8, ol1 = rl * 128 + (((4 + cb) ^ sl) << 4) + in8;
    const int oh0 = (rl + 8) * 128 + ((cb ^ sh) << 4) + in8, oh1 = (rl + 8) * 128 + (((4 + cb) ^ sh) << 4) + in8;
#pragma unroll
    for (int sb = 0; sb < 2; ++sb)
#pragma unroll
        for (int s = 0; s < 2; ++s) {
            const bf16x8 pf = __builtin_bit_cast(bf16x8, pack8(sb ? p1 : p0, s));
            ldsp a = Vb + (32 * sb + 16 * s) * 128;
            const s16x4 l0 = tr_rd(a + ol0), h0 = tr_rd(a + oh0), l1 = tr_rd(a + ol1), h1 = tr_rd(a + oh1);
            const bf16x8 v0 = __builtin_shufflevector(l0, h0, 0, 1, 2, 3, 4, 5, 6, 7), v1 = __builtin_shufflevector(l1, h1, 0, 1, 2, 3, 4, 5, 6, 7);
            o0 = MFMA32(v0, pf, o0); o1 = MFMA32(v1, pf, o1);
        }
}
DI void att_softmax(f32x16& p0, f32x16& p1, float& m_run, float& l_run, f32x16& o0, f32x16& o1) {
    float tm = fmaxf(p0[0], p1[0]);
#pragma unroll
    for (int i = 1; i < 16; ++i) tm = fmaxf(tm, fmaxf(p0[i], p1[i]));
    { float lo_, hi_; halves(tm, lo_, hi_); tm = fmaxf(lo_, hi_); }
    const float mn = fmaxf(m_run, tm);
    if (__any(mn > m_run)) { const float alpha = ex2(m_run - mn); l_run *= alpha;
#pragma unroll
        for (int i = 0; i < 16; ++i) { o0[i] *= alpha; o1[i] *= alpha; } }
    m_run = mn;
    float rs = 0.f;
#pragma unroll
    for (int i = 0; i < 16; ++i) { p0[i] = ex2(p0[i] - mn); p1[i] = ex2(p1[i] - mn); rs += p0[i] + p1[i]; }
    l_run += rs;
}
DI float mul_s(float a, float b) { return a * b; }
template <bool BAND> DI void att_sb(f32x16& p0, f32x16& p1, float& R, int jrel, int qrel, int hh) {
#pragma unroll
    for (int sb = 1; sb >= 0; --sb) {
#pragma unroll
        for (int g = 3; g >= 0; --g) {
            float omb[4], be[4];
#pragma unroll
            for (int j = 0; j < 4; ++j) { const float z = sb ? p1[4 * g + j] : p0[4 * g + j];
                float e = ex2(z);
                if (BAND) { const int kv = 64 * jrel + 32 * sb + 8 * g + 4 * hh + j; if (kv >= qrel) e = 0.f; }
                omb[j] = rcpf_(1.f + e); be[j] = 1.f - omb[j]; }
            const float t2 = omb[3], t1 = mul_s(t2, omb[2]), t0 = mul_s(t1, omb[1]), my4 = mul_s(t0, omb[0]);
            float lo_, hi_; halves(my4, lo_, hi_);
            const float base = hh ? R : mul_s(R, hi_);
            const float w3 = mul_s(be[3], base), w2 = mul_s(be[2], mul_s(base, t2)), w1 = mul_s(be[1], mul_s(base, t1)), w0 = mul_s(be[0], mul_s(base, t0));
            R = mul_s(R, mul_s(lo_, hi_));
            if (sb) { p1[4 * g] = w0; p1[4 * g + 1] = w1; p1[4 * g + 2] = w2; p1[4 * g + 3] = w3; }
            else { p0[4 * g] = w0; p0[4 * g + 1] = w1; p0[4 * g + 2] = w2; p0[4 * g + 3] = w3; }
        }
    }
}
DI void glds16(const void* gsrc, unsigned lds_dst) { unsigned keep;
    asm volatile("s_mov_b32 %0, m0\n\ts_mov_b32 m0, %2\n\ts_nop 0\n\tglobal_load_lds_dwordx4 %1, off\n\ts_mov_b32 m0, %0" : "=&s"(keep) : "v"(gsrc), "s"(lds_dst) : "memory"); }
#define ATT_WAITBAR(N) asm volatile("s_waitcnt vmcnt(" #N ") lgkmcnt(0)\n\ts_barrier" ::: "memory")

template <int MODE>
DI void attn_unit(ldsp lds, const bf16_t* Qp, const bf16_t* Kp, const bf16_t* Vp, int kvstride, const bf16_t* Gp, bf16_t* Op, const float* lfp  , const float* qnw, const float* knw, int qt, int nq) {
    int tid_ = threadIdx.x; asm volatile("" : "+v"(tid_));
    const int tid = tid_, lane = tid & 63, wid = __builtin_amdgcn_readfirstlane(tid >> 6), r = lane & 31, hh = lane >> 5;
    qnw = launder(qnw); lfp = launder(lfp); knw = launder(knw);
    const int NT = (MODE == 2) ? 4 : 4 * qt + 4;
    const int NRES = NT < ATT_NRES ? NT : ATT_NRES;
#define ATT_KT(i) ((MODE == 2) ? (i) : NT - 1 - (i))
    const int drow = 8 * wid + (lane >> 3);
    const size_t dma_off = (size_t)drow * kvstride + 8 * ((lane & 7) ^ swz8(drow));
    const unsigned lds0 = (unsigned)(uintptr_t)lds;
#define ATT_DMA_TO(i, slot) do { const size_t to_ = (size_t)ATT_KT(i) * 64 * kvstride + dma_off; const unsigned sl_ = __builtin_amdgcn_readfirstlane(lds0 + (slot) * ATT_SLOT + wid * 1024); \
        glds16(Kp + to_, sl_); glds16(Vp + to_, sl_ + 8192); } while (0)
#define ATT_DMA(i) ATT_DMA_TO(i, (i) % ATT_NSLOT)
    u32x4 qraw[4];
    { const bf16_t* qrow = Qp + (size_t)(qt * 256 + wid * 32 + r) * NP + 8 * hh;
#pragma unroll
      for (int ks = 0; ks < 4; ++ks) qraw[ks] = *(const u32x4*)(qrow + 16 * ks); }
#pragma unroll 1
    for (int i = 0; i < NRES; ++i) ATT_DMA_TO(i, i);
    if (tid < 24) *(LAS unsigned*)(lds + ATT_FLAG + 4 * tid) = 0u;
    float sufv = 0.f, av = 0.f; const int klo = 64 * (NT - NRES), kcnt = 64 * NRES;
    if (MODE == 0) {
        if (tid < kcnt) av = lfp[(size_t)(klo + tid) * 4] * LOG2E;
        sufv = av;
#pragma unroll
        for (int off = 1; off < 64; off <<= 1) { const float v = __shfl_down(sufv, off); if (lane + off < 64) sufv += v; }
        if (lane == 0) *(LAS float*)(lds + ATT_WT + 4 * wid) = sufv;
    }
    ATT_WAITBAR(0);
#pragma unroll 1
    for (int i = 0; i < NRES; ++i) att_prep<(MODE == 0) ? 2 : MODE>(lds, i, 0, nullptr, tid, lane, wid);
    if (MODE == 0) { float offs = 0.f;
#pragma unroll
        for (int w = 0; w < 8; ++w) { const float x = *(LAS float*)(lds + ATT_WT + 4 * w); if (w > wid) offs += x; }
        if (tid < kcnt) *(LAS float*)(lds + ATT_CS + 4 * (klo + tid)) = offs + sufv - av;
        if (tid == 0) *(LAS float*)(lds + ATT_WT + 32) = offs + sufv; }
    asm volatile("s_waitcnt lgkmcnt(0)\n\ts_barrier" ::: "memory");
    const int qrel = 32 * wid + r;
    const int q4 = (lane & 15) >> 2, p4 = lane & 3, blk = (lane >> 4) & 1;
    ldsp Qb = lds + ATT_Q + wid * 4096 + lane * 16;
#pragma unroll 1
    for (int qq = 0; qq < nq; ++qq) {
        const int q0 = (qt + qq) * 256;
        float qn2 = 0.f;
        { float v[4][8]; float ss = 0.f;
#pragma unroll
          for (int ks = 0; ks < 4; ++ks) { const u32x4 raw = qraw[ks];
              v[ks][0] = bf_lo(raw.x); v[ks][1] = bf_hi(raw.x); v[ks][2] = bf_lo(raw.y); v[ks][3] = bf_hi(raw.y); v[ks][4] = bf_lo(raw.z); v[ks][5] = bf_hi(raw.z); v[ks][6] = bf_lo(raw.w); v[ks][7] = bf_hi(raw.w);
#pragma unroll
              for (int j = 0; j < 8; ++j) ss += v[ks][j] * v[ks][j]; }
          float sc_all = 0.125f * LOG2E;
          if (MODE != 1) { float lo_, hi_; halves(ss, lo_, hi_); sc_all *= __builtin_amdgcn_rsqf((lo_ + hi_) * (1.f / HD) + EPS); }
#pragma unroll
          for (int ks = 0; ks < 4; ++ks) {
              float w[8];
#pragma unroll
              for (int j = 0; j < 8; ++j) w[j] = (MODE != 1) ? qnw[16 * ks + 8 * hh + j] * knw[16 * ks + 8 * hh + j] : 1.f;
              u32x4 pk; pk.x = pk2(v[ks][0] * sc_all * w[0], v[ks][1] * sc_all * w[1]); pk.y = pk2(v[ks][2] * sc_all * w[2], v[ks][3] * sc_all * w[3]);
              pk.z = pk2(v[ks][4] * sc_all * w[4], v[ks][5] * sc_all * w[5]); pk.w = pk2(v[ks][6] * sc_all * w[6], v[ks][7] * sc_all * w[7]);
              *(LAS u32x4*)(Qb + ks * 1024) = pk;
              if (MODE == 0) {
#pragma unroll
                  for (int j = 0; j < 8; ++j) { const float t_ = v[ks][j] * sc_all * w[j]; qn2 += t_ * t_; } } } }
        if (qq + 1 < nq) { const bf16_t* qrow = Qp + (size_t)(q0 + 256 + wid * 32 + r) * NP + 8 * hh;
#pragma unroll
            for (int ks = 0; ks < 4; ++ks) qraw[ks] = *(const u32x4*)(qrow + 16 * ks); }
        u32x2 graw[8];
#pragma unroll
        for (int e = 0; e < 8; ++e) graw[e] = *(const u32x2*)(Gp + (size_t)(q0 + wid * 32 + r) * NP + 32 * (e >> 2) + 8 * (e & 3) + 4 * hh);
        float smax = 0.f;
        if (MODE == 0) { float lo_, hi_; halves(qn2, lo_, hi_); smax = sqrtf(lo_ + hi_) * 8.f * 1.02f; }

        float m_run = -INFINITY, l_run = 0.f, R = 1.f;
        f32x16 o0, o1, p0, p1;
#pragma unroll
        for (int i = 0; i < 16; ++i) { o0[i] = 0.f; o1[i] = 0.f; }
        bool done = false;
#pragma unroll 1
        for (int it = (MODE == 2) ? 0 : 3 - ((32 * wid + 31) >> 6); it < NRES; ++it) {
            const bool band = (MODE != 2) && it < 4;
            const int jrel = 3 - it;
#if ATT_TILE_SKIP
            if (MODE != 2 && !band) {
                bool sk;
                if (MODE == 0) { const float nmax = *(LAS float*)(lds + ATT_CS + 4 * (64 * ATT_KT(it) + 63));
                    sk = !__any(nmax + smax >= m_run - 48.f); }
                else sk = !__any(R >= 0x1p-48f);
                if (sk) { done = true; break; }
            }
#endif
            ldsp Kb = lds + it * ATT_SLOT;
            att_zero(p0, p1);
            att_qk(p0, p1, Kb, Qb, r, hh);
            att_bias<MODE>(p0, p1, lds, it, ATT_KT(it), hh);
            if (MODE == 1) { if (band) att_sb<true>(p0, p1, R, jrel, qrel, hh); else att_sb<false>(p0, p1, R, -1, qrel, hh); }
            else {
                if (MODE == 0 && band) {
#pragma unroll
                    for (int e = 0; e < 16; ++e) { const int kv = 64 * jrel + crow(e, hh); if (kv > qrel) p0[e] = -INFINITY; if (kv + 32 > qrel) p1[e] = -INFINITY; } }
                att_softmax(p0, p1, m_run, l_run, o0, o1);
            }
            att_pv(o0, o1, Kb + 8192, p0, p1, hh, q4, p4, blk);
        }
        if (MODE != 2 && NRES < NT) {
            if (lane == 0) *(LAS unsigned*)(lds + ATT_FLAG + 64 + 4 * wid) = done ? 0u : 1u;
            asm volatile("s_waitcnt lgkmcnt(0)\n\ts_barrier" ::: "memory");
            const u32x4 n0 = *(LAS u32x4*)(lds + ATT_FLAG + 64), n1 = *(LAS u32x4*)(lds + ATT_FLAG + 80);
            if (__builtin_amdgcn_readfirstlane((n0.x | n0.y) | (n0.z | n0.w) | (n1.x | n1.y) | (n1.z | n1.w)) != 0u) {
                const int it0 = NRES;
                ATT_DMA(it0); if (it0 + 1 < NT) ATT_DMA(it0 + 1); if (it0 + 2 < NT) ATT_DMA(it0 + 2);
                ATT_WAITBAR(0);
#pragma unroll 1
                for (int k = 0; k < 3; ++k) if (it0 + k < NT) att_prep<MODE>(lds, (it0 + k) % ATT_NSLOT, ATT_KT(it0 + k), lfp, tid, lane, wid);
                asm volatile("s_waitcnt lgkmcnt(0)\n\ts_barrier" ::: "memory");
                bool skipcur = false;
#pragma unroll 1
                for (int s2 = 2 * it0; s2 < 2 * NT; ++s2) {
                    const int i = s2 >> 1;
#if ATT_TILE_SKIP
                    if ((s2 & 1) == 0 && i > it0) {
                        const u32x4 f0 = *(LAS u32x4*)(lds + ATT_FLAG + 32 * ((i - 1) & 1)), f1 = *(LAS u32x4*)(lds + ATT_FLAG + 32 * ((i - 1) & 1) + 16);
                        if (__builtin_amdgcn_readfirstlane((f0.x & f0.y) & (f0.z & f0.w) & (f1.x & f1.y) & (f1.z & f1.w)) != 0u) break; }
#endif
                    if ((s2 & 1) == 0 && i + 3 < NT) ATT_DMA(i + 3);
                    ldsp Kb = lds + (i % ATT_NSLOT) * ATT_SLOT;
                    if ((s2 & 1) == 0) {
                        skipcur = done;
#if ATT_TILE_SKIP
                        if (!skipcur) {
                            if (MODE == 0) { const float nmax = *(LAS float*)(lds + ATT_CS + 4 * (64 * ATT_KT(i) + 63)); skipcur = !__any(nmax + smax >= m_run - 48.f); }
                            else skipcur = !__any(R >= 0x1p-48f);
                            if (skipcur) done = true; }
                        if (skipcur && lane == 0) *(LAS unsigned*)(lds + ATT_FLAG + 32 * (i & 1) + 4 * wid) = 1u;
#endif
                        if (!skipcur) { att_zero(p0, p1); att_qk(p0, p1, Kb, Qb, r, hh); att_bias<MODE>(p0, p1, lds, i % ATT_NSLOT, ATT_KT(i), hh); }
                    } else {
                        if (!skipcur) {
                            if (MODE == 1) att_sb<false>(p0, p1, R, -1, qrel, hh); else att_softmax(p0, p1, m_run, l_run, o0, o1);
                            att_pv(o0, o1, Kb + 8192, p0, p1, hh, q4, p4, blk); }
                        ATT_WAITBAR(0);
                        if (i + 3 < NT) att_prep<MODE>(lds, (i + 3) % ATT_NSLOT, ATT_KT(i + 3), lfp, tid, lane, wid);
                        asm volatile("s_waitcnt lgkmcnt(0)\n\ts_barrier" ::: "memory");
                    }
                }
                ATT_WAITBAR(0);
            }
        }
        float inv = 1.f;
        if (MODE != 1) { float lo_, hi_; halves(l_run, lo_, hi_); inv = 1.0f / (lo_ + hi_); }
        const size_t row = (size_t)(q0 + wid * 32 + r);
#pragma unroll
        for (int dt = 0; dt < 2; ++dt)
#pragma unroll
            for (int g = 0; g < 4; ++g) { const int d = 32 * dt + 8 * g + 4 * hh;
                const u32x2 gr = graw[4 * dt + g];
                const float g0 = silu_f(bf_lo(gr.x)), g1 = silu_f(bf_hi(gr.x)), g2 = silu_f(bf_lo(gr.y)), g3 = silu_f(bf_hi(gr.y));
                const float a0 = dt ? o1[4 * g] : o0[4 * g], a1 = dt ? o1[4 * g + 1] : o0[4 * g + 1], a2 = dt ? o1[4 * g + 2] : o0[4 * g + 2], a3 = dt ? o1[4 * g + 3] : o0[4 * g + 3];
                *(u32x2*)(Op + row * DMIX + d) = (u32x2){pk2(a0 * inv * g0, a1 * inv * g1), pk2(a2 * inv * g2, a3 * inv * g3)}; }
    }
    asm volatile("s_waitcnt lgkmcnt(0)\n\ts_barrier" ::: "memory");
#undef ATT_KT
#undef ATT_DMA
#undef ATT_DMA_TO
}

constexpr int HG_Q = 0, HG_F = 8192, HG_V = 16384, HG_O = 24576;
DI void hgrn_unit_valu(ldsp lds, const bf16_t* pj  , bf16_t* mx  , int h, int layer, const float* lb_logits, const float* onorm) {
    int tid_ = threadIdx.x; asm volatile("" : "+v"(tid_));
    const int tid = tid_, lane = tid & 63, wid = __builtin_amdgcn_readfirstlane(tid >> 6);
    lb_logits = launder(lb_logits); onorm = launder(onorm);
    const int tt = tid >> 4, c4 = (tid & 15) * 4;
    float oml[4], onw[4];
#pragma unroll
    for (int j = 0; j < 4; ++j) { const int c = h * HD + c4 + j;
        float lbv = 0.f;
        if (layer == 1) { const float l0 = lb_logits[c], l1 = lb_logits[256 + c], mx_ = fmaxf(l0, l1), e0 = expf(l0 - mx_), e1 = expf(l1 - mx_), p0 = e0 / (e0 + e1), p1 = e1 / (e0 + e1);
            lbv = fminf(fmaxf((p0 + p1) - p0, 0.f), 1.0f - 1e-6f); }
        oml[j] = 1.f - lbv; onw[j] = onorm[c]; }
    f32x2 S2[4];
#pragma unroll
    for (int i = 0; i < 4; ++i) S2[i] = (f32x2){0.f, 0.f};
    const bf16_t* base = pj + (size_t)tt * NP + h * HD + c4;
    u32x2 rq = *(const u32x2*)(base + C_HQ), rf = *(const u32x2*)(base + C_HF), ri = *(const u32x2*)(base + C_HI);
#pragma unroll 1
    for (int ch = 0; ch < SEQ / 32; ++ch) {
        { const float hq[4] = {bf_lo(rq.x), bf_hi(rq.x), bf_lo(rq.y), bf_hi(rq.y)}, hf[4] = {bf_lo(rf.x), bf_hi(rf.x), bf_lo(rf.y), bf_hi(rf.y)};
          f32x4 q, f;
#pragma unroll
          for (int j = 0; j < 4; ++j) { q[j] = silu_f(hq[j]); const float sg = rcpf_(1.f + ex2(hf[j] * LOG2E)); f[j] = 1.f - oml[j] * sg; }
          *(LAS f32x4*)(lds + HG_Q + 4 * (tt * 64 + c4)) = q; *(LAS f32x4*)(lds + HG_F + 4 * (tt * 64 + c4)) = f;
          *(LAS f32x4*)(lds + HG_V + 4 * (tt * 64 + c4)) = (f32x4){bf_lo(ri.x), bf_hi(ri.x), bf_lo(ri.y), bf_hi(ri.y)}; }
        __syncthreads();
        if (ch + 1 < SEQ / 32) { const bf16_t* nb = base + (size_t)(ch + 1) * 32 * NP; rq = *(const u32x2*)(nb + C_HQ); rf = *(const u32x2*)(nb + C_HF); ri = *(const u32x2*)(nb + C_HI); }
        const u32x2 gr = *(const u32x2*)(base + (size_t)ch * 32 * NP + C_HG);
        float acc[32];
#pragma unroll
        for (int t = 0; t < 32; ++t) {
            const f32x4 qa = *(LAS f32x4*)(lds + HG_Q + 4 * (t * 64 + 8 * wid)), qb = *(LAS f32x4*)(lds + HG_Q + 4 * (t * 64 + 8 * wid + 4));
            const f32x4 fa = *(LAS f32x4*)(lds + HG_F + 4 * (t * 64 + 8 * wid)), fb = *(LAS f32x4*)(lds + HG_F + 4 * (t * 64 + 8 * wid + 4));
            const float v = *(LAS float*)(lds + HG_V + 4 * (t * 64 + lane));
            const f32x2 v2 = {v, v};
            S2[0] = (f32x2){fa.x, fa.y} * (S2[0] - v2) + v2; S2[1] = (f32x2){fa.z, fa.w} * (S2[1] - v2) + v2;
            S2[2] = (f32x2){fb.x, fb.y} * (S2[2] - v2) + v2; S2[3] = (f32x2){fb.z, fb.w} * (S2[3] - v2) + v2;
            f32x2 a2 = S2[0] * (f32x2){qa.x, qa.y}, b2 = S2[1] * (f32x2){qa.z, qa.w};
            a2 += S2[2] * (f32x2){qb.x, qb.y}; b2 += S2[3] * (f32x2){qb.z, qb.w};
            a2 += b2; acc[t] = a2.x + a2.y;
        }
#pragma unroll
        for (int t = 0; t < 32; ++t) *(LAS float*)(lds + HG_O + 4 * ((wid * 32 + t) * 64 + lane)) = acc[t];
        __syncthreads();
        f32x4 o = *(LAS f32x4*)(lds + HG_O + 4 * (tt * 64 + c4));
#pragma unroll
        for (int w = 1; w < 8; ++w) o += *(LAS f32x4*)(lds + HG_O + 4 * ((w * 32 + tt) * 64 + c4));
        float ss = (o.x * o.x + o.y * o.y) + (o.z * o.z + o.w * o.w);
        ss = sum16(ss);
        const float rstd = 1.0f / sqrtf(ss * (1.f / HD) + EPS);
        const float g0 = silu_f(bf_lo(gr.x)), g1 = silu_f(bf_hi(gr.x)), g2 = silu_f(bf_lo(gr.y)), g3 = silu_f(bf_hi(gr.y));
        *(u32x2*)(mx + (size_t)(ch * 32 + tt) * DMIX + O_HG + h * HD + c4) = (u32x2){pk2(o.x * rstd * onw[0] * g0, o.y * rstd * onw[1] * g1), pk2(o.z * rstd * onw[2] * g2, o.w * rstd * onw[3] * g3)};
    }
    __syncthreads();
}

typedef short s16x4v __attribute__((ext_vector_type(4)));
#define MFMA16(a, b, c) __builtin_amdgcn_mfma_f32_16x16x16bf16_1k((a), (b), (c), 0, 0, 0)
constexpr int HM_QS = 0, HM_QM = 16 * 136, HM_KM = 2 * 16 * 136, HM_KET = 3 * 16 * 136, HM_VT = HM_KET + 64 * 40, HM_DEC = HM_VT + 64 * 40, HM_SLOT = HM_DEC + 256, HM_NS = 4, HM_OB = HM_NS * HM_SLOT, HM_OSTR = 272;
constexpr int HM_RAW = HM_OB + 2 * 16 * HM_OSTR, HM_RSLOT = 8192, HM_NR = 8;
static_assert(HM_SLOT % 16 == 0 && HM_RAW % 16 == 0 && HM_RAW + HM_NR * HM_RSLOT <= 147392, "HGRN LDS map");
DI s16x4v pack4(const f32x4 v) { u32x2 p = {pk2(v.x, v.y), pk2(v.z, v.w)}; return __builtin_bit_cast(s16x4v, p); }
DI void hgrn_unit(ldsp lds, const bf16_t* pj  , bf16_t* mx  , int h, int layer, const float* lb_logits, const float* onorm) {
    int tid_ = threadIdx.x; asm volatile("" : "+v"(tid_));
    const int tid = tid_, lane = tid & 63, wid = __builtin_amdgcn_readfirstlane(tid >> 6);
    lb_logits = launder(lb_logits); onorm = launder(onorm);
    const bool cons = wid < 4;
    const int fr = lane & 15, fq = lane >> 4;
    constexpr int NBLK = SEQ / 16;
    const int dl = lane >> 2, tq = lane & 3;
    const int pd = 16 * (wid & 3) + dl;
    float oml = 1.f;
    if (layer == 1) { const float l0 = lb_logits[h * HD + pd], l1 = lb_logits[256 + h * HD + pd], mx_ = fmaxf(l0, l1), e0 = expf(l0 - mx_), e1 = expf(l1 - mx_), p0 = e0 / (e0 + e1), p1 = e1 / (e0 + e1);
        oml = 1.f - fminf(fmaxf((p0 + p1) - p0, 0.f), 1.0f - 1e-6f); }
    f32x4 Sacc[4];
#pragma unroll
    for (int i = 0; i < 4; ++i) Sacc[i] = (f32x4){0.f, 0.f, 0.f, 0.f};
    const int e4 = 4 * fr, trow = 4 * wid + fq;
    const f32x4 onw = *(const f32x4*)(onorm + h * HD + e4);
    const unsigned lds0 = (unsigned)(uintptr_t)lds;
    const int pseg = (wid & 3);
    const bf16_t* dsrc = pj + (size_t)(lane >> 3) * NP + (pseg == 0 ? C_HQ : pseg == 1 ? C_HF : pseg == 2 ? C_HI : C_HG) + h * HD + 8 * (lane & 7);
#define HM_DMA(blk) do { const unsigned d_ = __builtin_amdgcn_readfirstlane(lds0 + HM_RAW + ((blk) & (HM_NR - 1)) * HM_RSLOT + pseg * 2048); \
        glds16(dsrc + (size_t)(blk) * 16 * NP, d_); glds16(dsrc + (size_t)((blk) * 16 + 8) * NP, d_ + 1024); } while (0)
    if (!cons) { HM_DMA(0); HM_DMA(1); HM_DMA(2); HM_DMA(3); asm volatile("s_waitcnt vmcnt(6)" ::: "memory"); }
    asm volatile("s_waitcnt lgkmcnt(0)\n\ts_barrier" ::: "memory");
#pragma unroll 1
    for (int n = -2; n <= NBLK; ++n) {
        if (!cons) {
            const int nb = n + 2;
            if (n + 6 < NBLK) HM_DMA(n + 6);
            if (nb < NBLK) {
                ldsp sb = lds + (nb & 3) * HM_SLOT;
                ldsp rw = lds + HM_RAW + (nb & (HM_NR - 1)) * HM_RSLOT + (4 * tq) * 128 + 2 * pd;
                float q[4], k[4], c[4], v[4];
#pragma unroll
                for (int i = 0; i < 4; ++i) { const float hq = __uint_as_float((unsigned)*(LAS bf16_t*)(rw + i * 128) << 16), hf = __uint_as_float((unsigned)*(LAS bf16_t*)(rw + 2048 + i * 128) << 16);
                    v[i] = __uint_as_float((unsigned)*(LAS bf16_t*)(rw + 4096 + i * 128) << 16);
                    q[i] = silu_f(hq); k[i] = oml * rcpf_(1.f + ex2(hf * LOG2E));
                    c[i] = fmaxf(__builtin_amdgcn_logf(1.f - k[i]), -15.f); }
                c[1] += c[0]; c[2] += c[1]; c[3] += c[2];
                float inc = c[3];
                { const float u1 = dppf<0x90>(inc); if (tq >= 1) inc += u1; const float u2 = dppf<0x44>(inc); if (tq >= 2) inc += u2; }
                const float exc = inc - c[3];
                const float Bm = dppf<0x55>(inc), Be = dppf<0xFF>(inc);
                s16x4v ket, vt; bf16_t* ketp = (bf16_t*)&ket; bf16_t* vtp = (bf16_t*)&vt;
#pragma unroll
                for (int i = 0; i < 4; ++i) { const float B = exc + c[i]; const int t = 4 * tq + i;
                    *(LAS bf16_t*)(sb + HM_QS + t * 136 + 2 * pd) = (bf16_t)(pk2(q[i] * ex2(B), 0.f) & 0xffffu);
                    *(LAS bf16_t*)(sb + HM_QM + t * 136 + 2 * pd) = (bf16_t)(pk2(q[i] * ex2(B - Bm), 0.f) & 0xffffu);
                    *(LAS bf16_t*)(sb + HM_KM + t * 136 + 2 * pd) = (bf16_t)(pk2(k[i] * ex2(Bm - B), 0.f) & 0xffffu);
                    ketp[i] = (bf16_t)(pk2(k[i] * ex2(Be - B), 0.f) & 0xffffu); vtp[i] = (bf16_t)(pk2(v[i], 0.f) & 0xffffu); }
                *(LAS s16x4v*)(sb + HM_KET + pd * 40 + 8 * tq) = ket;
                *(LAS s16x4v*)(sb + HM_VT + pd * 40 + 8 * tq) = vt;
                if (tq == 3) *(LAS float*)(sb + HM_DEC + 4 * pd) = ex2(Be);
            }
            { const int ahead = (n + 6 < NBLK ? n + 6 : NBLK - 1) - (n + 3);
              if (ahead >= 3) asm volatile("s_waitcnt vmcnt(6)" ::: "memory"); else if (ahead == 2) asm volatile("s_waitcnt vmcnt(4)" ::: "memory");
              else if (ahead == 1) asm volatile("s_waitcnt vmcnt(2)" ::: "memory"); else asm volatile("s_waitcnt vmcnt(0)" ::: "memory"); }
        } else {
            if (n >= 1) {
                const f32x4 o = *(LAS f32x4*)(lds + HM_OB + ((n - 1) & 1) * 16 * HM_OSTR + trow * HM_OSTR + 4 * e4);
                const u32x2 gv = *(LAS u32x2*)(lds + HM_RAW + ((n - 1) & (HM_NR - 1)) * HM_RSLOT + 3 * 2048 + trow * 128 + 2 * e4);
                const float ss = sum16((o.x * o.x + o.y * o.y) + (o.z * o.z + o.w * o.w));
                const float rstd = __builtin_amdgcn_rsqf(ss * (1.f / HD) + EPS);
                const float g0 = silu_f(bf_lo(gv.x)), g1 = silu_f(bf_hi(gv.x)), g2 = silu_f(bf_lo(gv.y)), g3 = silu_f(bf_hi(gv.y));
                *(u32x2*)(mx + (size_t)(16 * (n - 1) + trow) * DMIX + O_HG + h * HD + e4) = (u32x2){pk2(o.x * rstd * onw.x * g0, o.y * rstd * onw.y * g1), pk2(o.z * rstd * onw.z * g2, o.w * rstd * onw.w * g3)};
            }
            if (n >= 0 && n < NBLK) {
                ldsp sb = lds + (n & 3) * HM_SLOT;
                s16x4v qm[4], qs[4], km[4];
#pragma unroll
                for (int dt = 0; dt < 4; ++dt) { const int co = fr * 136 + (16 * dt + 4 * fq) * 2;
                    qm[dt] = *(LAS s16x4v*)(sb + HM_QM + co); qs[dt] = *(LAS s16x4v*)(sb + HM_QS + co); km[dt] = *(LAS s16x4v*)(sb + HM_KM + co); }
                const s16x4v vt = *(LAS s16x4v*)(sb + HM_VT + (16 * wid + fr) * 40 + 8 * fq);
                f32x4 pt = {0.f, 0.f, 0.f, 0.f};
#pragma unroll
                for (int dt = 0; dt < 4; ++dt) pt = MFMA16(km[dt], qm[dt], pt);
#pragma unroll
                for (int i = 0; i < 4; ++i) if (4 * fq + i > fr) pt[i] = 0.f;
                f32x4 ot = {0.f, 0.f, 0.f, 0.f};
#pragma unroll
                for (int dt = 0; dt < 4; ++dt) ot = MFMA16(pack4(Sacc[dt]), qs[dt], ot);
                ot = MFMA16(vt, pack4(pt), ot);
                *(LAS f32x4*)(lds + HM_OB + (n & 1) * 16 * HM_OSTR + fr * HM_OSTR + 4 * (16 * wid + 4 * fq)) = ot;
#pragma unroll
                for (int dt = 0; dt < 4; ++dt) { const f32x4 dc = *(LAS f32x4*)(sb + HM_DEC + 4 * (16 * dt + 4 * fq));
                    const s16x4v ke = *(LAS s16x4v*)(sb + HM_KET + (16 * dt + fr) * 40 + 8 * fq);
                    Sacc[dt] = MFMA16(ke, vt, Sacc[dt] * dc); }
            }
        }
        asm volatile("s_waitcnt lgkmcnt(0)\n\ts_barrier" ::: "memory");
    }
#undef HM_DMA
}

constexpr int PL_U = 0, PL_D = 79 * 512, PL_DSTR = 528, PL_Y = PL_D + 64 * PL_DSTR, PL_YSTR = 272;
static_assert(PL_Y + 8 * 32 * PL_YSTR <= 147392, "pooling LDS map");
DI void pool_unit(ldsp lds, const bf16_t* pj, bf16_t* mx, int t0, const bf16_t* wt  , const float* pscale) {
    wt = launder(wt); pscale = launder(pscale);
    int tid_ = threadIdx.x; asm volatile("" : "+v"(tid_));
    const int tid = tid_, lane = tid & 63, wid = __builtin_amdgcn_readfirstlane(tid >> 6), r = lane & 31, hh = lane >> 5;
    for (int idx = tid; idx < 79 * 32; idx += 512) { const int rr = idx >> 5, c16 = idx & 31, tok = t0 - 15 + rr;
        u32x4 v = {0u, 0u, 0u, 0u};
        if (tok >= 0) v = *(const u32x4*)(pj + (size_t)tok * NP + C_PV + 8 * c16);
        *(LAS u32x4*)(lds + PL_U + rr * 512 + 16 * c16) = v; }
    const int g = wid >> 1, th = wid & 1;
    bf16x8 bw[2][4];
#pragma unroll
    for (int nt = 0; nt < 2; ++nt)
#pragma unroll
        for (int ks = 0; ks < 4; ++ks) bw[nt][ks] = *(const bf16x8*)(wt + (size_t)(g * 64 + 32 * nt + r) * 64 + 16 * ks + 8 * hh);
    __syncthreads();
    { const int vec = lane & 7, run = lane >> 3, win = 2 << g, tl0 = 32 * th + 4 * run;
      ldsp ub = lds + PL_U + (15 + tl0) * 512 + g * 128 + vec * 16;
      float acc[8];
#pragma unroll
      for (int j = 0; j < 8; ++j) acc[j] = 0.f;
      for (int j = 0; j < win; ++j) { const u32x4 v = *(LAS u32x4*)(ub - j * 512);
          acc[0] += bf_lo(v.x); acc[1] += bf_hi(v.x); acc[2] += bf_lo(v.y); acc[3] += bf_hi(v.y); acc[4] += bf_lo(v.z); acc[5] += bf_hi(v.z); acc[6] += bf_lo(v.w); acc[7] += bf_hi(v.w); }
#pragma unroll
      for (int k = 0; k < 4; ++k) {
          const u32x4 u = *(LAS u32x4*)(ub + k * 512);
          const float us[8] = {bf_lo(u.x), bf_hi(u.x), bf_lo(u.y), bf_hi(u.y), bf_lo(u.z), bf_hi(u.z), bf_lo(u.w), bf_hi(u.w)};
          if (k > 0) { const u32x4 o = *(LAS u32x4*)(ub + (k - win) * 512);
              const float os[8] = {bf_lo(o.x), bf_hi(o.x), bf_lo(o.y), bf_hi(o.y), bf_lo(o.z), bf_hi(o.z), bf_lo(o.w), bf_hi(o.w)};
#pragma unroll
              for (int j = 0; j < 8; ++j) acc[j] += us[j] - os[j]; }
          const int t = t0 + tl0 + k, cnt = (t + 1 < win) ? t + 1 : win;
          const float icnt = 1.0f / (float)cnt;
          *(LAS u32x4*)(lds + PL_D + (tl0 + k) * PL_DSTR + g * 128 + vec * 16) = (u32x4){pk2(acc[0] * icnt - us[0], acc[1] * icnt - us[1]), pk2(acc[2] * icnt - us[2], acc[3] * icnt - us[3]),
                                                                                      pk2(acc[4] * icnt - us[4], acc[5] * icnt - us[5]), pk2(acc[6] * icnt - us[6], acc[7] * icnt - us[7])};
      } }
    { f32x16 y0, y1;
#pragma unroll
      for (int i = 0; i < 16; ++i) { y0[i] = 0.f; y1[i] = 0.f; }
#pragma unroll
      for (int ks = 0; ks < 4; ++ks) { const bf16x8 a = *(LAS bf16x8*)(lds + PL_D + (32 * th + r) * PL_DSTR + (64 * g + 16 * ks + 8 * hh) * 2);
          y0 = MFMA32(a, bw[0][ks], y0); y1 = MFMA32(a, bw[1][ks], y1); }
      const float sc0 = pscale[64 * g + r], sc1 = pscale[64 * g + 32 + r];
      ldsp ys = lds + PL_Y + wid * 32 * PL_YSTR;
#pragma unroll
      for (int i = 0; i < 16; ++i) { *(LAS float*)(ys + crow(i, hh) * PL_YSTR + 4 * r) = y0[i] * sc0; *(LAS float*)(ys + crow(i, hh) * PL_YSTR + 4 * (32 + r)) = y1[i] * sc1; }
      const int tok = lane >> 1, hf = lane & 1;
      const size_t trow = (size_t)(t0 + 32 * th + tok);
#pragma unroll
      for (int k = 0; k < 4; ++k) {
          const u32x4 gv = *(const u32x4*)(pj + trow * NP + C_PG + 64 * g + 32 * hf + 8 * k);
          const f32x4 ya = *(LAS f32x4*)(ys + tok * PL_YSTR + 4 * (32 * hf + 8 * k)), yb = *(LAS f32x4*)(ys + tok * PL_YSTR + 4 * (32 * hf + 8 * k + 4));
          *(u32x4*)(mx + trow * DMIX + O_POOL + 64 * g + 32 * hf + 8 * k) = (u32x4){pk2(ya.x * silu_f(bf_lo(gv.x)), ya.y * silu_f(bf_hi(gv.x))), pk2(ya.z * silu_f(bf_lo(gv.y)), ya.w * silu_f(bf_hi(gv.y))),
                                                                                  pk2(yb.x * silu_f(bf_lo(gv.z)), yb.y * silu_f(bf_hi(gv.z))), pk2(yb.z * silu_f(bf_lo(gv.w)), yb.w * silu_f(bf_hi(gv.w)))}; } }
    __syncthreads();
}

constexpr int U_HG = 128, U_AT = 1024, U_PL = 1024;
constexpr int U_ME = 256;
constexpr int U0_ME = U_HG, U0_SB = U0_ME + U_ME, U0_FX = U0_SB + U_AT, U0_PL = U0_FX + U_AT, U_TOTAL = U0_PL + U_PL;
DI void mixer_phase(ldsp lds, int layer, int cslot) {
    LAS int* slot = (LAS int*)(lds + LDS_SLOT);
    for (;;) {
        __syncthreads();
        if (threadIdx.x == 0) *slot = (int)atomicAdd((unsigned*)(kargs()->ws + WS_CTL) + 64 * cslot, 1u);
        __syncthreads();
        const int u = __builtin_amdgcn_readfirstlane(*slot);
        if (u >= U_TOTAL) break;
        kargp P = kargs();
        const bf16_t* proj = (const bf16_t*)(P->ws + WS_PROJ); bf16_t* mixed = (bf16_t*)(P->ws + WS_MIX);
        if (u < U0_ME) {
#ifndef NO_HGRN
            const int b = u >> 2, h = u & 3;
#pragma unroll 1
            for (int rep = 0; rep < ((PROBE_UNIT & 1) ? 2 : 1); ++rep)
            hgrn_unit(lds, proj + (size_t)b * SEQ * NP, mixed + (size_t)b * SEQ * DMIX, h, layer, P->lb_logits, P->hgrn_out_norm + layer * 256);
#endif
        } else if (u < U0_SB) {
#ifndef NO_MEM
            const int i = u - U0_ME, qt = 4 * (i >> 7), bh = i & 127, b = bh >> 2, h = bh & 3;
            const bf16_t* pb = proj + (size_t)b * SEQ * NP + h * HD; bf16_t* ob = mixed + (size_t)b * SEQ * DMIX + O_MEM + h * HD;
            const bf16_t* kb = (const bf16_t*)(P->ws + WS_KVM + layer * KVM_BYTES) + (size_t)b * NMEM * 512 + h * HD;
#pragma unroll 1
            for (int rep = 0; rep < ((PROBE_UNIT & 8) ? 2 : 1); ++rep)
            attn_unit<2>(lds, pb + C_MQ, kb, kb + 256, 512, pb + C_MG, ob, nullptr, P->mem_q_norm + layer * HD, P->mem_k_norm + layer * HD, qt, 4);
#endif
        } else if (u < U0_FX) {
#ifndef NO_SB
            const int i = u - U0_SB, qt = 7 - (i >> 7), bh = i & 127, b = bh >> 2, h = bh & 3;
            const bf16_t* pb = proj + (size_t)b * SEQ * NP + h * HD; bf16_t* ob = mixed + (size_t)b * SEQ * DMIX + O_SB + h * HD;
#pragma unroll 1
            for (int rep = 0; rep < ((PROBE_UNIT & 2) ? 2 : 1); ++rep)
            attn_unit<1>(lds, pb + C_SQ, pb + C_SK, pb + C_SV, NP, pb + C_SG, ob, nullptr, nullptr, nullptr, qt, 1);
#endif
        } else if (u < U0_PL) {
#ifndef NO_FOX
            const int i = u - U0_FX, qt = 7 - (i >> 7), bh = i & 127, b = bh >> 2, h = bh & 3;
            const bf16_t* pb = proj + (size_t)b * SEQ * NP + h * HD; bf16_t* ob = mixed + (size_t)b * SEQ * DMIX + O_FOX + h * HD;
            const float* lfp = (const float*)(P->ws + WS_LF) + (size_t)b * SEQ * 4 + h;
#pragma unroll 1
            for (int rep = 0; rep < ((PROBE_UNIT & 4) ? 2 : 1); ++rep)
            attn_unit<0>(lds, pb + C_FQ, pb + C_FK, pb + C_FV, NP, pb + C_FG, ob, lfp, P->fox_q_norm + layer * HD, P->fox_k_norm + layer * HD, qt, 1);
#endif
        } else {
#ifndef NO_POOL
            const int i = u - U0_PL, b = i >> 5, t0 = (i & 31) * 64;
#pragma unroll 1
            for (int rep = 0; rep < ((PROBE_UNIT & 16) ? 2 : 1); ++rep)
            pool_unit(lds, proj + (size_t)b * SEQ * NP, mixed + (size_t)b * SEQ * DMIX, t0, (const bf16_t*)(P->ws + WS_WPOOL + layer * WPOOL_BYTES), P->pool_scale + layer * 256);
#endif
        }
    }
}

#define XB_TMO      128
#define XB_XCNT(j)  (256  + 64 * (j))
#define XB_XSUB(j)  (1280 + 64 * (j))
#define XB_XGEN(j)  (2304 + 64 * (j))
#define XB_TOP      3328
#define XB_TOPGEN   3392
#define XCD_BAR_WORDS 3456
#define XB_SPIN_CAP (1u << 18)

__device__ __forceinline__ unsigned xb_ld(unsigned* p)              { return __hip_atomic_load(p, __ATOMIC_RELAXED, __HIP_MEMORY_SCOPE_AGENT); }
__device__ __forceinline__ unsigned xb_add(unsigned* p, unsigned v) { return __hip_atomic_fetch_add(p, v, __ATOMIC_RELAXED, __HIP_MEMORY_SCOPE_AGENT); }
__device__ __forceinline__ unsigned xb_xcc_id() { return (unsigned)__builtin_amdgcn_s_getreg((3 << 11) | 20) & 0xFu; }
#define XB_SPIN(cond, bar) do { unsigned _sp = 0; while (cond) { __builtin_amdgcn_s_sleep(1); \
    if ((++_sp & 255u) == 0u) { if (xb_ld(&(bar)[XB_TMO])) break; if (_sp > XB_SPIN_CAP) { atomicAdd(&(bar)[XB_TMO], 1u); break; } } } } while (0)

struct XcdBarrier {
    unsigned* bar; unsigned x;
    volatile LAS unsigned* st;
};

__device__ __forceinline__ XcdBarrier xcd_barrier_post(unsigned* bar, volatile LAS unsigned* st) {
    XcdBarrier b; b.bar = bar; b.x = xb_xcc_id(); b.st = st;
    if (threadIdx.x == 0) (void)xb_add(&bar[XB_XCNT(b.x)], 1u);
    return b;
}
__device__ __forceinline__ void xcd_barrier_complete(unsigned* bar, unsigned x, unsigned& nloc, unsigned& nx) {
    const unsigned G = gridDim.x * gridDim.y * gridDim.z;
    unsigned sum, cnt, mine, sp = 0u;
    for (;;) {
        sum = 0u; cnt = 0u; mine = 0u;
#pragma unroll
        for (unsigned j = 0; j < 16; ++j) { const unsigned c = xb_ld(&bar[XB_XCNT(j)]); sum += c; cnt += (c > 0u) ? 1u : 0u; mine = (j == x) ? c : mine; }
        if (sum == G) break;
        __builtin_amdgcn_s_sleep(1);
        if ((++sp & 255u) == 0u) { if (xb_ld(&bar[XB_TMO])) break; if (sp > XB_SPIN_CAP) { atomicAdd(&bar[XB_TMO], 1u); break; } }
    }
    nloc = mine > 0u ? mine : 1u; nx = cnt > 0u ? cnt : 1u;
}

__device__ __forceinline__ void xcd_barrier(const XcdBarrier& b) {
    asm volatile("s_waitcnt vmcnt(0)" ::: "memory");
    __syncthreads();
    if (threadIdx.x == 0) {
        unsigned* bar = b.bar;
        __builtin_amdgcn_s_waitcnt(0);
        unsigned nloc = b.st[0], nx = b.st[1];
        if (nloc == 0u) { xcd_barrier_complete(bar, b.x, nloc, nx); b.st[0] = nloc; b.st[1] = nx; }
        const unsigned old = xb_add(&bar[XB_XSUB(b.x)], 1u);
        const unsigned gen = old / nloc;
        if (old + 1u == (gen + 1u) * nloc) {
            __builtin_amdgcn_fence(__ATOMIC_RELEASE, "agent");
            asm volatile("s_waitcnt vmcnt(0)" ::: "memory");
            const unsigned og = xb_add(&bar[XB_TOP], 1u);
            const unsigned tg = og / nx;
            if (og + 1u == (tg + 1u) * nx) xb_add(&bar[XB_TOPGEN], 1u);
            else XB_SPIN(xb_ld(&bar[XB_TOPGEN]) == tg, bar);
            __builtin_amdgcn_fence(__ATOMIC_ACQUIRE, "agent");
            xb_add(&bar[XB_XGEN(b.x)], 1u);
            asm volatile("s_waitcnt vmcnt(0)" ::: "memory");
        } else {
            XB_SPIN(xb_ld(&bar[XB_XGEN(b.x)]) == gen, bar);
            __builtin_amdgcn_fence(__ATOMIC_ACQUIRE, "agent");
            asm volatile("s_waitcnt vmcnt(0)" ::: "memory");
        }
    }
    __syncthreads();
}

constexpr int CW_XBAR = 1024;
DI void seam_barrier(ldsp lds) {
    XcdBarrier b; b.bar = (unsigned*)(kargs()->ws + WS_CTL) + CW_XBAR; b.x = xb_xcc_id(); b.st = (volatile LAS unsigned*)(lds + LDS_BYTES - 32);
    xcd_barrier(b);
}

constexpr int N_PHASES = 8;
DI void in_gemm(ldsp lds, int layer) {
    kargp P = kargs(); unsigned char* ws = P->ws;
    pg8::Gemm g{(const bf16_t*)(ws + WS_HB), (const bf16_t*)(ws + WS_WIN + layer * WIN_BYTES), NTOK, NP, DM}; pg8::StaticOrder S; S.init(NTOK, NP, gridDim.x, blockIdx.x);
    if (EPI_NORM && layer == 1) {
        { const int tid = threadIdx.x, lane = tid & 63, wave = __builtin_amdgcn_readfirstlane(tid >> 6), p16 = lane & 15;
          const float* ssp = (const float*)(ws + WS_SSP); const float* ffp = (const float*)(ws + WS_FFP); float* lf = (float*)(ws + WS_LF);
          const f32x4 bias = *(const f32x4*)(P->fox_f_bias + NH);
          for (int r4 = blockIdx.x * 8 + wave; r4 < NTOK / 4; r4 += gridDim.x * 8) { const size_t row = (size_t)r4 * 4 + (lane >> 4);
              const float s1 = sum16(ssp[row * 16 + p16]); f32x4 f = *(const f32x4*)(ffp + (row * 16 + p16) * 4);
              f.x = sum16(f.x); f.y = sum16(f.y); f.z = sum16(f.z); f.w = sum16(f.w);
              const float rstd = 1.0f / sqrtf(s1 * (1.f / DM) + EPS);
              if (p16 < 4) { const float z = (p16 == 0 ? f.x : p16 == 1 ? f.y : p16 == 2 ? f.z : f.w) * rstd + (p16 == 0 ? bias.x : p16 == 1 ? bias.y : p16 == 2 ? bias.z : bias.w);
                  lf[row * 4 + p16] = fminf(z, 0.f) - log1pf(expf(-fabsf(z))); } } }
        pg8::EpiBf16RowScale E{(bf16_t*)(ws + WS_PROJ), NP, (const float*)(ws + WS_SSP), 1.f / DM, EPS};
        pg8::gemm_phase<pg8::EpiBf16RowScale, pg8::StaticOrder, true, true>(lds, g, S, E);
    } else {
        pg8::EpiBf16<0> E{(bf16_t*)(ws + WS_PROJ), NP, nullptr, 0, 0, 1.f};
        pg8::gemm_phase<pg8::EpiBf16<0>, pg8::StaticOrder, true, true>(lds, g, S, E);
    }
}
DI void kv_gemm(ldsp lds) {
    const int bid = blockIdx.x; if (bid >= 128) return;
    kargp P = kargs(); unsigned char* ws = P->ws; const int l2 = bid >> 6;
    pg8::Gemm g{(const bf16_t*)(ws + WS_MNB + l2 * MNB_BYTES), (const bf16_t*)(ws + WS_WKV + l2 * WKV_BYTES), NB * NMEM, 512, DM}; pg8::StaticOrder S; S.init(NB * NMEM, 512, 64, bid & 63);
    pg8::EpiBf16<0> E{(bf16_t*)(ws + WS_KVM + l2 * KVM_BYTES), 512, nullptr, 0, 0, 1.f};
    pg8::gemm_phase<pg8::EpiBf16<0>, pg8::StaticOrder, true, true>(lds, g, S, E);
}
DI void out_gemm(ldsp lds, int layer) {
    kargp P = kargs(); unsigned char* ws = P->ws;
    pg8::Gemm g{(const bf16_t*)(ws + WS_MIX), (const bf16_t*)(ws + WS_WOUT + layer * WOUT_BYTES), NTOK, DM, DMIX}; pg8::StaticOrder S; S.init(NTOK, DM, gridDim.x, blockIdx.x);
    if (EPI_NORM && layer == 0) { pg8::EpiResStats E{P->x, P->out, DM, (unsigned short*)(ws + WS_HB), (const float*)(ws + WS_GW), (float*)(ws + WS_SSP), (float*)(ws + WS_FFP)};
        pg8::gemm_phase<pg8::EpiResStats, pg8::StaticOrder, true, true>(lds, g, S, E); }
    else { pg8::EpiRes E{layer == 0 ? P->x : P->out, P->out, DM};
        pg8::gemm_phase<pg8::EpiRes, pg8::StaticOrder, true, true>(lds, g, S, E); }
    if (FUSE_NORM && layer + 1 < DEPTH) {
        const int tid = threadIdx.x, lane = tid & 63, wave = __builtin_amdgcn_readfirstlane(tid >> 6);
        __threadfence();
        __syncthreads();
        LAS int* todo = (LAS int*)(lds + 16384);
        if (tid == 0) { int cnt = 0; pg8::Unit u;
            for (int i = 0; S.next(i, u); ++i) { const unsigned old = atomicAdd((unsigned*)(kargs()->ws + WS_CTL) + 256 + u.pm, 1u); if (old == (unsigned)(DM / 256 - 1)) todo[1 + cnt++] = u.pm; }
            todo[0] = cnt; }
        __syncthreads();
        const int ncnt = __builtin_amdgcn_readfirstlane(todo[0]);
        int pms[4];
#pragma unroll
        for (int i = 0; i < 4; ++i) pms[i] = __builtin_amdgcn_readfirstlane(todo[1 + (i < ncnt ? i : 0)]);
        __threadfence();
        if (ncnt > 0) {
            kargp Q = kargs(); const int nl = layer + 1;
#pragma unroll 1
            for (int i = 0; i < ncnt; ++i) { const int pm = i == 0 ? pms[0] : i == 1 ? pms[1] : i == 2 ? pms[2] : pms[3];
                norm_phase(lds, Q->out, Q->norm_g + nl * DM, Q->w_in + (size_t)nl * DM * DIN, Q->fox_f_bias + nl * NH, (bf16_t*)(Q->ws + WS_HB), (float*)(Q->ws + WS_LF), pm * 256 + wave, 8, pm * 256 + 256, tid, lane); }
        }
    }
}
DI void do_norm(ldsp lds, int nl) {
    kargp P = kargs(); const int tid = threadIdx.x, lane = tid & 63, wave = __builtin_amdgcn_readfirstlane(tid >> 6);
    norm_phase(lds, nl ? P->out : P->x, P->norm_g + nl * DM, P->w_in + (size_t)nl * DM * DIN, P->fox_f_bias + nl * NH, (bf16_t*)(P->ws + WS_HB), (float*)(P->ws + WS_LF), blockIdx.x * 8 + wave, gridDim.x * 8, NTOK, tid, lane);
}
__global__ void __launch_bounds__(512, 2) hybrid_fwd(Params Parg) {
    extern __shared__ __attribute__((aligned(16))) unsigned char lds_raw[];
    ldsp lds = (ldsp)lds_raw;
    const int lo = kargs()->ph_lo, hi = kargs()->ph_hi;
    { volatile LAS unsigned* bst = (volatile LAS unsigned*)(lds + LDS_BYTES - 32);
      if (threadIdx.x < 2) bst[threadIdx.x] = 0u;
      __syncthreads();
      (void)xcd_barrier_post((unsigned*)(kargs()->ws + WS_CTL) + CW_XBAR, bst); }
#define IN(k) (lo <= (k) && (k) < hi)
#define SEAM(k) do { if (IN(k) && IN((k) + 1) && !(EPI_NORM && (k) == 4)) { if ((k) == 0) cg::this_grid().sync(); else seam_barrier(lds); } } while (0)
    if (IN(0)) {
        const int tid = threadIdx.x, lane = tid & 63, wave = __builtin_amdgcn_readfirstlane(tid >> 6);
        weights_phase(lds, blockIdx.x * 8 + wave, gridDim.x * 8, wave, lane);
        __syncthreads();
        memnorm_phase(blockIdx.x * 8 + wave, gridDim.x * 8, lane);
        do_norm(lds, 0);
    }
    SEAM(0);
    if (IN(1)) { in_gemm(lds, 0); kv_gemm(lds);
#if PROBE_PH & 2
        __syncthreads(); in_gemm(lds, 0);
#endif
    }
    SEAM(1);
    if (IN(2)) { mixer_phase(lds, 0, 0);
#if PROBE_PH & 4
        mixer_phase(lds, 0, 2);
#endif
    }
    SEAM(2);
    if (IN(3)) out_gemm(lds, 0);
    SEAM(3);
    if (IN(4) && !EPI_NORM) do_norm(lds, 1);
    SEAM(4);
    if (IN(5)) in_gemm(lds, 1);
    SEAM(5);
    if (IN(6)) mixer_phase(lds, 1, 1);
    SEAM(6);
    if (IN(7)) out_gemm(lds, 1);
#undef IN
#undef SEAM
}

extern "C" void kernel_launch(void* const* d_in, const int* in_sizes, int n_in, void* d_out, int out_size, void* d_ws, size_t ws_size, hipStream_t stream) {
    static int grid = 0;
    if (grid == 0) {
        if (n_in != 16 || in_sizes[0] != NTOK * DM || out_size != NTOK * DM || ws_size < WS_END) { fprintf(stderr, "kernel_launch: unexpected shapes (n_in %d, in0 %d, out %d, ws %zu)\n", n_in, n_in > 0 ? in_sizes[0] : -1, out_size, ws_size); grid = -1; return; }
        int dev = 0, cus = 0, per_cu = 0;
        (void)hipGetDevice(&dev); (void)hipDeviceGetAttribute(&cus, hipDeviceAttributeMultiprocessorCount, dev);
        if (hipFuncSetAttribute((const void*)hybrid_fwd, hipFuncAttributeMaxDynamicSharedMemorySize, LDS_BYTES) != hipSuccess) { fprintf(stderr, "kernel_launch: hipFuncSetAttribute failed\n"); grid = -1; return; }
        if (hipOccupancyMaxActiveBlocksPerMultiprocessor(&per_cu, (const void*)hybrid_fwd, 512, LDS_BYTES) != hipSuccess || per_cu < 1) { fprintf(stderr, "kernel_launch: occupancy query gave %d\n", per_cu); per_cu = 1; }
        (void)hipGetLastError();
        grid = cus * per_cu;
    }
    if (grid < 0) return;
    (void)hipMemsetAsync((char*)d_ws + WS_CTL, 0, CTL_ZERO_BYTES, stream);
    Params p{};
    p.x = (const float*)d_in[0]; p.mem = (const float*)d_in[1]; p.norm_g = (const float*)d_in[2]; p.w_in = (const float*)d_in[3]; p.fox_f_bias = (const float*)d_in[4];
    p.fox_q_norm = (const float*)d_in[5]; p.fox_k_norm = (const float*)d_in[6]; p.lb_logits = (const float*)d_in[7]; p.hgrn_out_norm = (const float*)d_in[8]; p.pool_w = (const float*)d_in[9];
    p.pool_scale = (const float*)d_in[10]; p.mem_norm_g = (const float*)d_in[11]; p.mem_w_kv = (const float*)d_in[12]; p.mem_q_norm = (const float*)d_in[13]; p.mem_k_norm = (const float*)d_in[14];
    p.w_out = (const float*)d_in[15]; p.out = (float*)d_out; p.ws = (unsigned char*)d_ws;
#if MK_SINGLE_LAUNCH
    p.ph_lo = 0; p.ph_hi = N_PHASES;
    void* args[] = {&p};
    const hipError_t e = hipLaunchCooperativeKernel((const void*)hybrid_fwd, dim3(grid), dim3(512), args, LDS_BYTES, stream);
    if (e != hipSuccess) fprintf(stderr, "kernel_launch: cooperative launch failed: %s (grid %d)\n", hipGetErrorString(e), grid);
#else
    for (int ph = 0; ph < N_PHASES; ++ph) { p.ph_lo = ph; p.ph_hi = ph + 1; hipLaunchKernelGGL(hybrid_fwd, dim3(grid), dim3(512), LDS_BYTES, stream, p); }
#endif
}
```

```cpp
#include <hip/hip_runtime.h>
#include <hip/hip_cooperative_groups.h>
#include <cstdio>
#include <cstdint>
namespace cg = cooperative_groups;
namespace pg8 {
#define PG8_LAS __attribute__((address_space(3)))
typedef unsigned short bf16_t;
typedef short bf16x8 __attribute__((ext_vector_type(8)));
typedef float f32x4 __attribute__((ext_vector_type(4)));
typedef unsigned u32x4 __attribute__((ext_vector_type(4)));
constexpr int BM = 256, BK = 64, HALF = 128, HTB = HALF * BK * 2  , STAGE_BYTES = 8 * HTB, NXCD = 8, WGM = 8;

__host__ __device__ __forceinline__ int lds_byte(int r, int c) { const int st = (r >> 4) * 2 + (c >> 5), rr = r & 15, cc = c & 31, ob = rr * 64 + cc * 2; return st * 1024 + (ob ^ (((ob >> 9) & 1) << 5)); }
__host__ __device__ __forceinline__ void stage_rc(int b, int& R, int& C) { const int st = b / 1024, sb = b % 1024, swz = sb ^ (((sb >> 9) & 1) << 5); R = (st >> 1) * 16 + swz / 64; C = (st & 1) * 32 + (swz % 64) / 2; }
__host__ __device__ __forceinline__ int perm32(int rho) { const int n = rho >> 4, i = rho & 15; return 8 * (i >> 2) + 4 * n + (i & 3); }

struct Unit { int pm, pn; };
struct Gemm { const bf16_t* A; const bf16_t* Bt; int M, N, K; };

struct StaticOrder {
    int nM, nN, nwg, G, c;
    __host__ __device__ void init(int M, int N, int G_, int c_) { nM = M / BM; nN = N / BM; nwg = nM * nN; G = G_; c = c_; }
    __host__ __device__ bool next(int i, Unit& u) const {
        const long L = (long)i * G + c; if (L >= nwg) return false;
        int wgid = (int)L; { const int q = nwg / NXCD, r = nwg % NXCD, xcd = wgid % NXCD, off = wgid / NXCD; wgid = (xcd < r ? xcd * (q + 1) : r * (q + 1) + (xcd - r) * q) + off; }
        const int nig = WGM * nN, gid = wgid / nig, fm = gid * WGM, gsz = (nM - fm) < WGM ? (nM - fm) : WGM;
        u.pm = fm + ((wgid % nig) % gsz); u.pn = (wgid % nig) / gsz; return true;
    }
    __device__ __forceinline__ void a_ready(const Unit&) const {}
    __device__ __forceinline__ void done(const Unit&) const {}
};

__device__ __forceinline__ unsigned cvt_pk_bf16(float lo, float hi) { unsigned r; asm volatile("v_cvt_pk_bf16_f32 %0, %1, %2" : "=v"(r) : "v"(lo), "v"(hi)); return r; }
typedef float f32x2 __attribute__((ext_vector_type(2)));
__device__ __forceinline__ f32x2 gelu_pk(f32x2 v) {
    const f32x2 av = __builtin_elementwise_abs(v), d = av * 0.2316418882f + 1.0f;
    f32x2 t; t.x = __builtin_amdgcn_rcpf(d.x); t.y = __builtin_amdgcn_rcpf(d.y);
    f32x2 q = t * 0.5307027145f + (-0.7265760135f); q = q * t + 0.7107068705f; q = q * t + (-0.142248368f); q = q * t + 0.127414796f; q = q * t;
    const f32x2 s = (v * v) * (-0.72134752044f);
    f32x2 e; e.x = __builtin_amdgcn_exp2f(s.x); e.y = __builtin_amdgcn_exp2f(s.y);
    const f32x2 m = v * (q * e), r = v - m;
    f32x2 o; o.x = v.x < 0.f ? m.x : r.x; o.y = v.y < 0.f ? m.y : r.y; return o;
}

template <int ACT  > struct EpiBf16 {
    static constexpr bool PERM = true, AFTER_DRAIN = false; static_assert(ACT == 0 || ACT == 1, "EpiBf16: ACT is 0 (none) or 1 (gelu_pk)");
    bf16_t* O; int ldc; const float* bias; int split_cols; size_t split_stride; float scale0;
    __device__ __forceinline__ void operator()(const f32x4 (&acc)[2][2][4][2], const Unit& u, int wr, int wc, int fr, int fq) const {
        const int row0 = u.pm * BM + wr * 64 + fr; int colt = u.pn * BM; bf16_t* base = O;
        float sc = 1.f; if (split_cols) { const int t = colt / split_cols; base += (size_t)t * split_stride; colt -= t * split_cols; if (t == 0) sc = scale0; }
        const int col0 = colt + wc * 32 + 8 * fq, bcol0 = u.pn * BM + wc * 32 + 8 * fq;
        f32x4 bv[2][2];
#pragma unroll
        for (int bj = 0; bj < 2; ++bj)
#pragma unroll
            for (int n = 0; n < 2; ++n) bv[bj][n] = bias ? *(const f32x4*)(bias + bcol0 + bj * HALF + 4 * n) : (f32x4){0.f, 0.f, 0.f, 0.f};
#pragma unroll
        for (int ai = 0; ai < 2; ++ai)
#pragma unroll
            for (int m = 0; m < 4; ++m) { bf16_t* rowp = base + (size_t)(row0 + ai * HALF + m * 16) * ldc + col0;
#pragma unroll
                for (int bj = 0; bj < 2; ++bj) { f32x4 v0 = acc[ai][bj][m][0] + bv[bj][0], v1 = acc[ai][bj][m][1] + bv[bj][1];
                    if (ACT == 1) { f32x2 a = gelu_pk((f32x2){v0[0], v0[1]}), b = gelu_pk((f32x2){v0[2], v0[3]}), c = gelu_pk((f32x2){v1[0], v1[1]}), d = gelu_pk((f32x2){v1[2], v1[3]});
                        v0 = (f32x4){a.x, a.y, b.x, b.y}; v1 = (f32x4){c.x, c.y, d.x, d.y}; }
                    v0 = v0 * sc; v1 = v1 * sc; u32x4 w; w.x = cvt_pk_bf16(v0[0], v0[1]); w.y = cvt_pk_bf16(v0[2], v0[3]); w.z = cvt_pk_bf16(v1[0], v1[1]); w.w = cvt_pk_bf16(v1[2], v1[3]);
                    *(u32x4*)(rowp + bj * HALF) = w; } }
    }
};

struct EpiRes {
    static constexpr bool PERM = false, AFTER_DRAIN = false;
    const float* base; float* out; int ldc;
    __device__ __forceinline__ void operator()(const f32x4 (&acc)[2][2][4][2], const Unit& u, int wr, int wc, int fr, int fq) const {
        const int col0 = u.pn * BM + wc * 32 + 4 * fq;
#pragma unroll
        for (int ai = 0; ai < 2; ++ai)
#pragma unroll
            for (int m = 0; m < 4; ++m) { const size_t off = (size_t)(u.pm * BM + ai * HALF + wr * 64 + m * 16 + fr) * ldc + col0;
#pragma unroll
                for (int bj = 0; bj < 2; ++bj)
#pragma unroll
                    for (int n = 0; n < 2; ++n) { const f32x4 bs = *(const f32x4*)(base + off + bj * HALF + n * 16); *(f32x4*)(out + off + bj * HALF + n * 16) = bs + acc[ai][bj][m][n]; } }
    }
};

struct EpiResStats {
    static constexpr bool PERM = false, AFTER_DRAIN = false;
    const float* base; float* out; int ldc; unsigned short* xb; const float* gw  ; float* ssp  ; float* ffp  ;
    __device__ __forceinline__ void operator()(const f32x4 (&acc)[2][2][4][2], const Unit& u, int wr, int wc, int fr, int fq) const {
        const int col0 = u.pn * BM + wc * 32 + 4 * fq;
#pragma unroll
        for (int ai = 0; ai < 2; ++ai)
#pragma unroll
            for (int m = 0; m < 4; ++m) {
                float ss = 0.f; f32x4 ff = {0.f, 0.f, 0.f, 0.f};
                const size_t rbase = (size_t)(u.pm * BM + ai * HALF + wr * 64 + m * 16 + fr);
#pragma unroll
                for (int bj = 0; bj < 2; ++bj)
#pragma unroll
                    for (int n = 0; n < 2; ++n) {
                        const int c = col0 + bj * HALF + n * 16; const size_t off = rbase * ldc + c;
                        const f32x4 o = *(const f32x4*)(base + off) + acc[ai][bj][m][n];
                        *(f32x4*)(out + off) = o;
                        typedef unsigned u32x2_ __attribute__((ext_vector_type(2)));
                        *(u32x2_*)(xb + off) = (u32x2_){cvt_pk_bf16(o[0], o[1]), cvt_pk_bf16(o[2], o[3])};
                        ss += (o[0] * o[0] + o[1] * o[1]) + (o[2] * o[2] + o[3] * o[3]);
                        ff += *(const f32x4*)(gw + 4 * (size_t)c) * o[0] + *(const f32x4*)(gw + 4 * (size_t)c + 4) * o[1] + *(const f32x4*)(gw + 4 * (size_t)c + 8) * o[2] + *(const f32x4*)(gw + 4 * (size_t)c + 12) * o[3]; }
                float v5[5] = {ss, ff[0], ff[1], ff[2], ff[3]};
#pragma unroll
                for (int q = 0; q < 5; ++q) { auto a_ = __builtin_amdgcn_permlane16_swap(__float_as_uint(v5[q]), __float_as_uint(v5[q]), false, false); const float s_ = __uint_as_float(a_[0]) + __uint_as_float(a_[1]);
                    auto b_ = __builtin_amdgcn_permlane32_swap(__float_as_uint(s_), __float_as_uint(s_), false, false); v5[q] = __uint_as_float(b_[0]) + __uint_as_float(b_[1]); }
                if (fq == 0) { const int slot = u.pn * 4 + wc; ssp[rbase * 16 + slot] = v5[0]; *(f32x4*)(ffp + (rbase * 16 + slot) * 4) = (f32x4){v5[1], v5[2], v5[3], v5[4]}; }
                asm volatile("" ::: "memory");
            }
    }
};
struct EpiBf16RowScale {
    static constexpr bool PERM = true, AFTER_DRAIN = false;
    bf16_t* O; int ldc; const float* ssp; float inv_k, eps;
    __device__ __forceinline__ void operator()(const f32x4 (&acc)[2][2][4][2], const Unit& u, int wr, int wc, int fr, int fq) const {
        const int row0 = u.pm * BM + wr * 64 + fr; const int col0 = u.pn * BM + wc * 32 + 8 * fq;
#pragma unroll
        for (int ai = 0; ai < 2; ++ai)
#pragma unroll
            for (int m = 0; m < 4; ++m) { const size_t row = (size_t)(row0 + ai * HALF + m * 16);
                const f32x4 a = *(const f32x4*)(ssp + row * 16), b = *(const f32x4*)(ssp + row * 16 + 4), c = *(const f32x4*)(ssp + row * 16 + 8), d = *(const f32x4*)(ssp + row * 16 + 12);
                const float tot = ((a[0] + a[1]) + (a[2] + a[3])) + ((b[0] + b[1]) + (b[2] + b[3])) + ((c[0] + c[1]) + (c[2] + c[3])) + ((d[0] + d[1]) + (d[2] + d[3]));
                const float sc = 1.0f / sqrtf(tot * inv_k + eps);
                bf16_t* rowp = O + row * ldc + col0;
#pragma unroll
                for (int bj = 0; bj < 2; ++bj) { const f32x4 v0 = acc[ai][bj][m][0] * sc, v1 = acc[ai][bj][m][1] * sc;
                    u32x4 w; w.x = cvt_pk_bf16(v0[0], v0[1]); w.y = cvt_pk_bf16(v0[2], v0[3]); w.z = cvt_pk_bf16(v1[0], v1[1]); w.w = cvt_pk_bf16(v1[2], v1[3]);
                    *(u32x4*)(rowp + bj * HALF) = w; } }
    }
};
template <class Epi, class Sched, bool ALIGN_EPI = false, bool SP2 = false>
__device__ __forceinline__ void gemm_phase(PG8_LAS unsigned char* lds, const Gemm g, const Sched& S, const Epi& E) {
    const int tid = threadIdx.x, wid = __builtin_amdgcn_readfirstlane(tid >> 6), lane = tid & 63, wr = wid >> 2, wc = wid & 3, fr = lane & 15, fq = lane >> 4;
    const int K = g.K, nt = K / BK;
    unsigned voffA[2], voffB[2];
#pragma unroll
    for (int i = 0; i < 2; ++i) { int R, C; stage_rc(tid * 16 + i * 8192, R, C); const int Rb = Epi::PERM ? ((R & ~31) + perm32(R & 31)) : R;
        voffA[i] = (unsigned)(R * K + C) * 2u; voffB[i] = (unsigned)(Rb * K + C) * 2u; }
    const size_t kstep = (size_t)(BK * 2);
    const size_t hstep = (size_t)HALF * K * 2;
    const size_t tstep = 2 * hstep;
    const unsigned ldsw = (unsigned)wid * 1024u;
    const int aoff = lds_byte(wr * 64 + fr, fq * 8), boff = lds_byte(wc * 32 + fr, fq * 8);
#define PG8_SA(b, h) (((b) * 2 + (h)) * HTB)
#define PG8_SB(b, h) ((4 + (b) * 2 + (h)) * HTB)
#define PG8_STAGE(bufoff, gbase, voff) do { _Pragma("unroll") for (int _i = 0; _i < 2; ++_i) \
        __builtin_amdgcn_global_load_lds((const unsigned*)((const char*)(gbase) + (voff)[_i]), (PG8_LAS unsigned*)(lds + (bufoff) + ldsw + _i * 8192), 16, 0, 0); } while (0)
#define PG8_LDA(dst, b, h) do { _Pragma("unroll") for (int m = 0; m < 4; ++m) _Pragma("unroll") for (int k = 0; k < 2; ++k) dst[m][k] = *(const PG8_LAS bf16x8*)(lds + PG8_SA(b, h) + aoff + m * 2048 + k * 1024); } while (0)
#define PG8_LDB(dst, b, h) do { _Pragma("unroll") for (int n = 0; n < 2; ++n) _Pragma("unroll") for (int k = 0; k < 2; ++k) dst[n][k] = *(const PG8_LAS bf16x8*)(lds + PG8_SB(b, h) + boff + n * 2048 + k * 1024); } while (0)
#define PG8_MMA(ai, bj, At, Bt) do { __builtin_amdgcn_s_setprio(1); _Pragma("unroll") for (int m = 0; m < 4; ++m) _Pragma("unroll") for (int n = 0; n < 2; ++n) _Pragma("unroll") for (int k = 0; k < 2; ++k) \
        acc[ai][bj][m][n] = __builtin_amdgcn_mfma_f32_16x16x32_bf16(Bt[n][k], At[m][k], acc[ai][bj][m][n], 0, 0, 0); __builtin_amdgcn_s_setprio(0); } while (0)
#define PG8_WAIT_V(n) asm volatile("s_waitcnt vmcnt(" #n ")" ::: "memory")
#define PG8_WAIT_L(n) asm volatile("s_waitcnt lgkmcnt(" #n ")" ::: "memory")
#define PG8_BAR __builtin_amdgcn_s_barrier()
#define PG8_SCHED __builtin_amdgcn_sched_barrier(0)
    Unit cur, nxt; int ui = 0;
    if (!S.next(0, cur)) return;
    f32x4 acc[2][2][4][2];
#pragma unroll
    for (int a = 0; a < 2; ++a)
#pragma unroll
        for (int b = 0; b < 2; ++b)
#pragma unroll
            for (int m = 0; m < 4; ++m)
#pragma unroll
                for (int n = 0; n < 2; ++n) acc[a][b][m][n] = (f32x4){0.f, 0.f, 0.f, 0.f};
    bf16x8 At[4][2], B0[2][2], B1[2][2];
    const char* cA = (const char*)g.A + (size_t)cur.pm * tstep; const char* cB = (const char*)g.Bt + (size_t)cur.pn * tstep;
    S.a_ready(cur);
    if constexpr (SP2) {
        PG8_STAGE(PG8_SB(0, 0), cB, voffB); PG8_STAGE(PG8_SB(0, 1), cB + hstep, voffB); PG8_STAGE(PG8_SA(0, 0), cA, voffA); PG8_STAGE(PG8_SA(0, 1), cA + hstep, voffA);
        if (wr == 1) PG8_BAR;
        PG8_WAIT_V(2); PG8_BAR;
        PG8_STAGE(PG8_SB(1, 0), cB + kstep, voffB); PG8_STAGE(PG8_SA(1, 0), cA + kstep, voffA); PG8_STAGE(PG8_SB(1, 1), cB + hstep + kstep, voffB);
        PG8_WAIT_V(6); PG8_BAR;
    } else {
        PG8_STAGE(PG8_SB(0, 0), cB, voffB); PG8_STAGE(PG8_SA(0, 0), cA, voffA); PG8_STAGE(PG8_SB(0, 1), cB + hstep, voffB); PG8_STAGE(PG8_SA(0, 1), cA + hstep, voffA);
        if (wr == 1) PG8_BAR;
        PG8_WAIT_V(4); PG8_BAR;
        PG8_STAGE(PG8_SB(1, 0), cB + kstep, voffB); PG8_STAGE(PG8_SA(1, 0), cA + kstep, voffA); PG8_STAGE(PG8_SB(1, 1), cB + hstep + kstep, voffB);
        PG8_WAIT_V(6); PG8_BAR;
    }
    for (;;) {
        const bool has_next = S.next(ui + 1, nxt);
        const char* nA = has_next ? (const char*)g.A + (size_t)nxt.pm * tstep : cA; const char* nB = has_next ? (const char*)g.Bt + (size_t)nxt.pn * tstep : cB;
        for (int t = 0; t < nt; t += 2) {
            const bool last = (t == nt - 2);
            const char* a1 = cA + (size_t)(t + 1) * kstep;
            const char* a2 = last ? nA : cA + (size_t)(t + 2) * kstep; const char* b2 = last ? nB : cB + (size_t)(t + 2) * kstep;
            const char* a3 = a2 + kstep; const char* b3 = b2 + kstep;
            if (last && has_next) S.a_ready(nxt);
            if constexpr (SP2) {
            PG8_LDB(B0, 0, 0); PG8_LDB(B1, 0, 1); PG8_SCHED; PG8_LDA(At, 0, 0); PG8_STAGE(PG8_SA(1, 1), a1 + hstep, voffA);
            PG8_WAIT_V(8); PG8_WAIT_L(0); PG8_BAR; PG8_MMA(0, 0, At, B0); PG8_MMA(0, 1, At, B1); PG8_BAR; PG8_SCHED;
            PG8_LDA(At, 0, 1); PG8_STAGE(PG8_SB(0, 0), b2, voffB); PG8_STAGE(PG8_SB(0, 1), b2 + hstep, voffB); PG8_STAGE(PG8_SA(0, 0), a2, voffA);
            PG8_WAIT_V(8); PG8_WAIT_L(0); PG8_BAR; PG8_MMA(1, 0, At, B0); PG8_MMA(1, 1, At, B1); PG8_BAR; PG8_SCHED;
            PG8_LDB(B0, 1, 0); PG8_LDB(B1, 1, 1); PG8_SCHED; PG8_LDA(At, 1, 0); PG8_STAGE(PG8_SA(0, 1), a2 + hstep, voffA);
            PG8_WAIT_V(8); PG8_WAIT_L(0); PG8_BAR; PG8_MMA(0, 0, At, B0); PG8_MMA(0, 1, At, B1); PG8_BAR; PG8_SCHED;
            PG8_LDA(At, 1, 1); PG8_STAGE(PG8_SB(1, 0), b3, voffB); PG8_STAGE(PG8_SB(1, 1), b3 + hstep, voffB); PG8_STAGE(PG8_SA(1, 0), a3, voffA);
            PG8_WAIT_V(8); PG8_WAIT_L(0); PG8_BAR; PG8_MMA(1, 0, At, B0); PG8_MMA(1, 1, At, B1); PG8_BAR; PG8_SCHED;
            } else {
            PG8_LDB(B0, 0, 0); PG8_SCHED; PG8_LDA(At, 0, 0); PG8_STAGE(PG8_SA(1, 1), a1 + hstep, voffA);
            PG8_WAIT_L(8); PG8_BAR; PG8_WAIT_L(0); PG8_MMA(0, 0, At, B0); PG8_BAR; PG8_SCHED;
            PG8_LDB(B1, 0, 1); PG8_STAGE(PG8_SB(0, 0), b2, voffB);
            PG8_BAR; PG8_WAIT_L(0); PG8_MMA(0, 1, At, B1); PG8_BAR;
            PG8_LDA(At, 0, 1); PG8_STAGE(PG8_SA(0, 0), a2, voffA);
            PG8_BAR; PG8_WAIT_L(0); PG8_MMA(1, 0, At, B0); PG8_BAR; PG8_SCHED;
            PG8_STAGE(PG8_SB(0, 1), b2 + hstep, voffB);
            PG8_WAIT_V(6); PG8_BAR; PG8_MMA(1, 1, At, B1); PG8_BAR;
            PG8_LDB(B0, 1, 0); PG8_SCHED; PG8_LDA(At, 1, 0); PG8_STAGE(PG8_SA(0, 1), a2 + hstep, voffA);
            PG8_WAIT_L(8); PG8_BAR; PG8_WAIT_L(0); PG8_MMA(0, 0, At, B0); PG8_BAR; PG8_SCHED;
            PG8_LDB(B1, 1, 1); PG8_STAGE(PG8_SB(1, 0), b3, voffB);
            PG8_BAR; PG8_WAIT_L(0); PG8_MMA(0, 1, At, B1); PG8_BAR;
            PG8_LDA(At, 1, 1); PG8_STAGE(PG8_SA(1, 0), a3, voffA);
            PG8_BAR; PG8_WAIT_L(0); PG8_MMA(1, 0, At, B0); PG8_BAR; PG8_SCHED;
            PG8_STAGE(PG8_SB(1, 1), b3 + hstep, voffB);
            PG8_WAIT_V(6); PG8_BAR; PG8_MMA(1, 1, At, B1); PG8_BAR;
            }
        }
        if constexpr (ALIGN_EPI) { if (wr == 0) PG8_BAR; }
        if constexpr (!Epi::AFTER_DRAIN) { E(acc, cur, wr, wc, fr, fq); S.done(cur); }
        if (!has_next) break;
#pragma unroll
        for (int a = 0; a < 2; ++a)
#pragma unroll
            for (int b = 0; b < 2; ++b)
#pragma unroll
                for (int m = 0; m < 4; ++m)
#pragma unroll
                    for (int n = 0; n < 2; ++n) acc[a][b][m][n] = (f32x4){0.f, 0.f, 0.f, 0.f};
        cur = nxt; cA = nA; cB = nB; ++ui;
        if constexpr (ALIGN_EPI) { if (wr == 1) PG8_BAR; }
    }
    PG8_WAIT_V(0);
    if constexpr (!ALIGN_EPI) { if (wr == 0) PG8_BAR; }
    PG8_BAR;
    if constexpr (Epi::AFTER_DRAIN) { E.fused(acc, cur, wr, wc, fr, fq, lds, wid, lane); S.done(cur); }
#undef PG8_SA
#undef PG8_SB
#undef PG8_STAGE
#undef PG8_LDA
#undef PG8_LDB
#undef PG8_MMA
#undef PG8_WAIT_V
#undef PG8_WAIT_L
#undef PG8_BAR
#undef PG8_SCHED
}
}
#ifndef EPI_NORM
#define EPI_NORM 0
#endif

#ifndef PROBE_PH
#define PROBE_PH 0
#endif
#ifndef PROBE_UNIT
#define PROBE_UNIT 0
#endif
#ifndef PROBE_SUB
#define PROBE_SUB 0
#endif
#ifndef MK_SINGLE_LAUNCH
#define MK_SINGLE_LAUNCH 1
#endif

constexpr int DM = 1024, NB = 32, SEQ = 2048, NTOK = NB * SEQ, NMEM = 256, DIN = 4100, NP = 4096, DMIX = 1280, NH = 4, HD = 64, DEPTH = 2;
constexpr float EPS = 1e-6f, LOG2E = 1.4426950408889634f;
constexpr int C_FQ = 0, C_FK = 256, C_FV = 512, C_FG = 768, C_SQ = 1024, C_SK = 1280, C_SV = 1536, C_SG = 1792, C_HQ = 2048, C_HF = 2304, C_HI = 2560, C_HG = 2816, C_PV = 3072, C_PG = 3328, C_MQ = 3584, C_MG = 3840;
constexpr int O_FOX = 0, O_SB = 256, O_HG = 512, O_POOL = 768, O_MEM = 1024;

constexpr size_t MiB = 1u << 20;
constexpr size_t WS_CTL = 0, CTL_ZERO_BYTES = 32768;
constexpr size_t WS_WIN = 2 * MiB, WIN_BYTES = (size_t)NP * DM * 2;
constexpr size_t WS_WOUT = 18 * MiB, WOUT_BYTES = (size_t)DM * DMIX * 2;
constexpr size_t WS_WKV = 24 * MiB, WKV_BYTES = (size_t)512 * DM * 2;
constexpr size_t WS_WPOOL = 27 * MiB, WPOOL_BYTES = 4 * 64 * 64 * 2;
constexpr size_t WS_LF = 26 * MiB;
constexpr size_t WS_MNB = 28 * MiB, MNB_BYTES = (size_t)NB * NMEM * DM * 2;
constexpr size_t WS_KVM = 60 * MiB, KVM_BYTES = (size_t)NB * NMEM * 512 * 2;
constexpr size_t WS_HB = 76 * MiB;
constexpr size_t WS_MIX = 204 * MiB;
constexpr size_t WS_PROJ = 364 * MiB;
constexpr size_t WS_C2 = 876 * MiB;
constexpr size_t WS_SSP = 877 * MiB;
constexpr size_t WS_FFP = 881 * MiB;
constexpr size_t WS_GW = 897 * MiB;
constexpr size_t WS_END = 898 * MiB;

constexpr int LDS_BYTES = 147456;
constexpr int LDS_SLOT = LDS_BYTES - 64;

#define LAS __attribute__((address_space(3)))
typedef LAS unsigned char* ldsp;
typedef unsigned short bf16_t;
typedef short bf16x8 __attribute__((ext_vector_type(8)));
typedef short s16x4 __attribute__((ext_vector_type(4)));
typedef float f32x16 __attribute__((ext_vector_type(16)));
typedef float f32x4 __attribute__((ext_vector_type(4)));
typedef float f32x2 __attribute__((ext_vector_type(2)));
typedef unsigned u32x4 __attribute__((ext_vector_type(4)));
typedef unsigned u32x2 __attribute__((ext_vector_type(2)));
typedef __bf16 bf16x2_t __attribute__((ext_vector_type(2)));

#define DI __device__ __forceinline__
DI float bf_lo(unsigned u) { return __uint_as_float(u << 16); }
DI float bf_hi(unsigned u) { return __uint_as_float(u & 0xffff0000u); }
DI unsigned pk2(float lo, float hi) { f32x2 v = {lo, hi}; bf16x2_t b = __builtin_convertvector(v, bf16x2_t); return __builtin_bit_cast(unsigned, b); }
DI float ex2(float x) { return __builtin_amdgcn_exp2f(x); }
DI float rcpf_(float x) { return __builtin_amdgcn_rcpf(x); }
DI float silu_f(float x) { return x * rcpf_(1.f + ex2(-x * LOG2E)); }
template <int CTRL> DI float dppf(float v) { return __uint_as_float((unsigned)__builtin_amdgcn_update_dpp(0, (int)__float_as_uint(v), CTRL, 0xF, 0xF, true)); }
DI float sum8(float v) { v += dppf<0xB1>(v); v += dppf<0x4E>(v); v += dppf<0x141>(v); return v; }
DI float sum16(float v) { v = sum8(v); v += dppf<0x140>(v); return v; }
DI float wave_sum(float v) { v = sum16(v);
    return (__int_as_float(__builtin_amdgcn_readlane(__float_as_int(v), 0)) + __int_as_float(__builtin_amdgcn_readlane(__float_as_int(v), 16))) +
           (__int_as_float(__builtin_amdgcn_readlane(__float_as_int(v), 32)) + __int_as_float(__builtin_amdgcn_readlane(__float_as_int(v), 48))); }
DI void halves(float x, float& lo, float& hi) { auto rr = __builtin_amdgcn_permlane32_swap(__float_as_uint(x), __float_as_uint(x), false, false); lo = __uint_as_float(rr[0]); hi = __uint_as_float(rr[1]); }
template <class T> DI T* launder(T* p) { asm volatile("" : "+s"(p)); return p; }
#define MFMA32(a, b, c) __builtin_amdgcn_mfma_f32_32x32x16_bf16((a), (b), (c), 0, 0, 0)

struct Params {
    const float *x, *mem, *norm_g, *w_in, *fox_f_bias, *fox_q_norm, *fox_k_norm, *lb_logits, *hgrn_out_norm, *pool_w, *pool_scale, *mem_norm_g, *mem_w_kv, *mem_q_norm, *mem_k_norm, *w_out;
    float* out; unsigned char* ws; int ph_lo, ph_hi;
};
typedef const __attribute__((address_space(4))) Params* kargp;
DI kargp kargs() { kargp p = (kargp)__builtin_amdgcn_kernarg_segment_ptr(); asm volatile("" : "+s"(p)); return p; }

DI void transpose_item(const float* W, int K, int ldw, bf16_t* WT, int k0, int src_n0, int dst_n0, LAS float* scr, int lane, const float* kscale = nullptr) {
#pragma unroll 8
    for (int i = 0; i < 32; ++i) { const int kk = 2 * i + (lane >> 5); scr[kk * 33 + (lane & 31)] = W[(size_t)(k0 + kk) * ldw + src_n0 + (lane & 31)] * (kscale ? kscale[k0 + kk] : 1.f); }
    asm volatile("s_waitcnt lgkmcnt(0)" ::: "memory");
    const int c = lane & 7;
#pragma unroll
    for (int j = 0; j < 4; ++j) { const int n = (lane >> 3) + 8 * j; const LAS float* s = scr + (8 * c) * 33 + n;
        u32x4 o; o.x = pk2(s[0 * 33], s[1 * 33]); o.y = pk2(s[2 * 33], s[3 * 33]); o.z = pk2(s[4 * 33], s[5 * 33]); o.w = pk2(s[6 * 33], s[7 * 33]);
        *(u32x4*)(WT + (size_t)(dst_n0 + n) * K + k0 + 8 * c) = o; }
    asm volatile("s_waitcnt lgkmcnt(0)" ::: "memory");
}

DI void weights_phase(ldsp lds, int gw, int NGW, int wave, int lane) {
    if (EPI_NORM) { kargp P = kargs(); float* gwt = (float*)(P->ws + WS_GW);
      for (int i = gw * 64 + lane; i < DM * 4; i += NGW * 64) { const int c = i >> 2, j = i & 3; gwt[i] = P->norm_g[DM + c] * P->w_in[(size_t)DM * DIN + (size_t)c * DIN + 1024 + j]; } }
    { kargp P = kargs(); const float* pw = P->pool_w; bf16_t* wt = (bf16_t*)(P->ws + WS_WPOOL);
      for (int i = gw * 64 + lane; i < DEPTH * 4 * 64 * 64; i += NGW * 64) { const int lg = i >> 12, c = (i >> 6) & 63, d = i & 63; wt[(lg * 64 + d) * 64 + c] = (bf16_t)(pk2(pw[i], 0.f) & 0xffffu); } }
    LAS float* scr = (LAS float*)(lds + wave * 16384);
    constexpr int I_IN = (DM / 64) * (NP / 32), I_OUT = (DMIX / 64) * (DM / 32), I_KV = (DM / 64) * (512 / 32), I_L = I_IN + I_OUT + I_KV;
    for (int it = gw; it < DEPTH * I_L; it += NGW) {
        const int l = it / I_L; int r = it % I_L; kargp P = kargs();
        if (r < I_IN) { const int nblk = NP / 32, kb = r / nblk, nb = r % nblk, n0 = 32 * nb;
            transpose_item(P->w_in + (size_t)l * DM * DIN, DM, DIN, (bf16_t*)(P->ws + WS_WIN + l * WIN_BYTES), 64 * kb, n0 + (n0 >= 1024 ? 4 : 0), n0, scr, lane, (EPI_NORM && l == 1) ? P->norm_g + DM : nullptr); continue; }
        r -= I_IN;
        if (r < I_OUT) { const int nblk = DM / 32, kb = r / nblk, nb = r % nblk;
            transpose_item(P->w_out + (size_t)l * DMIX * DM, DMIX, DM, (bf16_t*)(P->ws + WS_WOUT + l * WOUT_BYTES), 64 * kb, 32 * nb, 32 * nb, scr, lane); continue; }
        r -= I_OUT;
        { const int nblk = 512 / 32, kb = r / nblk, nb = r % nblk;
            transpose_item(P->mem_w_kv + (size_t)l * DM * 512, DM, 512, (bf16_t*)(P->ws + WS_WKV + l * WKV_BYTES), 64 * kb, 32 * nb, 32 * nb, scr, lane); }
    }
}

DI void memnorm_phase(int gw, int NGW, int lane) {
    kargp P = kargs(); const float* mng = P->mem_norm_g; const float* memp = P->mem; unsigned char* ws = P->ws;
    f32x4 g0[4], g1[4];
#pragma unroll
    for (int j = 0; j < 4; ++j) { g0[j] = ((const f32x4*)mng)[64 * j + lane]; g1[j] = ((const f32x4*)(mng + DM))[64 * j + lane]; }
    for (int m = gw; m < NB * NMEM; m += NGW) {
        const f32x4* xr = (const f32x4*)(memp + (size_t)m * DM) + lane;
        f32x4 v[4]; float s = 0.f;
#pragma unroll
        for (int j = 0; j < 4; ++j) { v[j] = xr[64 * j]; s += (v[j].x * v[j].x + v[j].y * v[j].y) + (v[j].z * v[j].z + v[j].w * v[j].w); }
        const float rstd = __builtin_amdgcn_rsqf(wave_sum(s) * (1.f / DM) + EPS);
        u32x2* o0 = (u32x2*)(ws + WS_MNB + (size_t)m * DM * 2) + lane; u32x2* o1 = (u32x2*)(ws + WS_MNB + MNB_BYTES + (size_t)m * DM * 2) + lane;
#pragma unroll
        for (int j = 0; j < 4; ++j) { const f32x4 y = v[j] * rstd; const f32x4 a = y * g0[j], b = y * g1[j];
            o0[64 * j] = (u32x2){pk2(a.x, a.y), pk2(a.z, a.w)}; o1[64 * j] = (u32x2){pk2(b.x, b.y), pk2(b.z, b.w)}; }
    }
}

DI void norm_phase(ldsp lds, const float* x, const float* g, const float* w_in_l, const float* fbias, bf16_t* hb, float* lf, int gw, int NGW, int mend, int tid, int lane) {
    for (int k = tid; k < DM; k += 512) { const int j = k >> 8, ln = (k & 255) >> 2, i = k & 3;
        *(LAS f32x4*)(lds + 16 * ((j * 4 + i) * 64 + ln)) = *(const f32x4*)(w_in_l + (size_t)k * DIN + 1024); }
    __syncthreads();
    f32x4 gv[4];
#pragma unroll
    for (int j = 0; j < 4; ++j) gv[j] = ((const f32x4*)g)[64 * j + lane];
    const float mybias = fbias[lane & 3];
    f32x4 nv[4], nv2[4];
    if (gw < mend) { const f32x4* xr = (const f32x4*)(x + (size_t)gw * DM) + lane;
#pragma unroll
        for (int j = 0; j < 4; ++j) nv[j] = __builtin_nontemporal_load(xr + 64 * j); }
    if (gw + NGW < mend) { const f32x4* xr = (const f32x4*)(x + (size_t)(gw + NGW) * DM) + lane;
#pragma unroll
        for (int j = 0; j < 4; ++j) nv2[j] = __builtin_nontemporal_load(xr + 64 * j); }
    for (int m = gw; m < mend; m += NGW) {
        f32x4 v[4]; float s = 0.f;
#pragma unroll
        for (int j = 0; j < 4; ++j) { v[j] = nv[j]; nv[j] = nv2[j]; }
        if (m + 2 * NGW < mend) { const f32x4* xn = (const f32x4*)(x + (size_t)(m + 2 * NGW) * DM) + lane;
#pragma unroll
            for (int j = 0; j < 4; ++j) nv2[j] = __builtin_nontemporal_load(xn + 64 * j); }
#pragma unroll
        for (int j = 0; j < 4; ++j) s += (v[j].x * v[j].x + v[j].y * v[j].y) + (v[j].z * v[j].z + v[j].w * v[j].w);
        const float rstd = __builtin_amdgcn_rsqf(wave_sum(s) * (1.f / DM) + EPS);
        u32x2* o8 = (u32x2*)(hb + (size_t)m * DM) + lane;
        f32x4 ff = {0.f, 0.f, 0.f, 0.f};
#pragma unroll
        for (int j = 0; j < 4; ++j) { const f32x4 y = (v[j] * rstd) * gv[j];
            o8[64 * j] = (u32x2){pk2(y.x, y.y), pk2(y.z, y.w)};
#pragma unroll
            for (int i = 0; i < 4; ++i) { const f32x4 w = *(LAS f32x4*)(lds + 16 * ((j * 4 + i) * 64 + lane)); ff += w * y[i]; } }
        ff.x = wave_sum(ff.x); ff.y = wave_sum(ff.y); ff.z = wave_sum(ff.z); ff.w = wave_sum(ff.w);
        if (lane < 4) { const float z = (lane == 0 ? ff.x : lane == 1 ? ff.y : lane == 2 ? ff.z : ff.w) + mybias;
            lf[(size_t)m * 4 + lane] = fminf(z, 0.f) - 0.6931471805599453f * __builtin_amdgcn_logf(1.f + ex2(-fabsf(z) * LOG2E)); }
    }
    __syncthreads();
}

DI void knorm_rows(bf16_t* base, int nrows4  , int stride, const float* kw, int gw, int NGW, int lane) {
    const f32x4 w0 = *(const f32x4*)(kw + 8 * (lane & 7)), w1 = *(const f32x4*)(kw + 8 * (lane & 7) + 4);
    for (int r8 = gw; r8 < nrows4 / 8; r8 += NGW) { const int rid = r8 * 8 + (lane >> 3);
        u32x4* p = (u32x4*)(base + (size_t)(rid >> 2) * stride + (rid & 3) * HD + 8 * (lane & 7));
        const u32x4 kr = *p;
        const float f[8] = {bf_lo(kr.x), bf_hi(kr.x), bf_lo(kr.y), bf_hi(kr.y), bf_lo(kr.z), bf_hi(kr.z), bf_lo(kr.w), bf_hi(kr.w)};
        float ss = 0.f;
#pragma unroll
        for (int j = 0; j < 8; ++j) ss += f[j] * f[j];
        ss = sum8(ss);
        const float rstd = __builtin_amdgcn_rsqf(ss * (1.f / HD) + EPS);
        *p = (u32x4){pk2(f[0] * rstd * w0.x, f[1] * rstd * w0.y), pk2(f[2] * rstd * w0.z, f[3] * rstd * w0.w), pk2(f[4] * rstd * w1.x, f[5] * rstd * w1.y), pk2(f[6] * rstd * w1.z, f[7] * rstd * w1.w)}; }
}
DI void kprep_phase(ldsp lds, int layer) {
    kargp P = kargs(); const int tid = threadIdx.x, lane = tid & 63, wave = __builtin_amdgcn_readfirstlane(tid >> 6), gw = blockIdx.x * 8 + wave, NGW = gridDim.x * 8;
    knorm_rows((bf16_t*)(P->ws + WS_PROJ) + C_FK, NTOK * 4, NP, P->fox_k_norm + layer * HD, gw, NGW, lane);
    knorm_rows((bf16_t*)(P->ws + WS_KVM + layer * KVM_BYTES), NB * NMEM * 4, 512, P->mem_k_norm + layer * HD, gw, NGW, lane);
    if (blockIdx.x < NB * NH) {
        const int b = blockIdx.x >> 2, h = blockIdx.x & 3;
        const float* lfp = (const float*)(P->ws + WS_LF) + (size_t)b * SEQ * 4 + h;
        float a[4];
#pragma unroll
        for (int j = 0; j < 4; ++j) a[j] = lfp[(size_t)(4 * tid + j) * 4];
        const float s0 = a[0], s1 = s0 + a[1], s2 = s1 + a[2], s3 = s2 + a[3];
        float inc = s3;
#pragma unroll
        for (int off = 1; off < 64; off <<= 1) { const float v = __shfl_up(inc, off); if (lane >= off) inc += v; }
        LAS float* wsum = (LAS float*)lds;
        if (lane == 63) wsum[wave] = inc;
        __syncthreads();
        float offs = 0.f;
        for (int w = 0; w < wave; ++w) offs += wsum[w];
        const float pre = offs + inc - s3;
        *(f32x4*)((float*)(P->ws + WS_C2) + (size_t)blockIdx.x * SEQ + 4 * tid) = (f32x4){(pre + s0) * LOG2E, (pre + s1) * LOG2E, (pre + s2) * LOG2E, (pre + s3) * LOG2E};
        __syncthreads();
    }
}

constexpr int ATT_SLOT = 16384, ATT_NSLOT = 5, ATT_NRES = 6, ATT_CS = ATT_NRES * ATT_SLOT, ATT_FLAG = ATT_CS + 8192, ATT_RK = ATT_FLAG + 128, ATT_WT = ATT_RK + ATT_NRES * 256, ATT_Q = ATT_WT + 64, ATT_END = ATT_Q + 32768;
static_assert(ATT_END <= 147392, "attention LDS map");
#ifndef FUSE_NORM
#define FUSE_NORM 0
#endif
#ifndef ATT_STAGGER
#define ATT_STAGGER 0
#endif
#ifndef ATT_TILE_SKIP
#define ATT_TILE_SKIP 1
#endif
DI int crow(int reg, int h) { return (reg & 3) + 8 * (reg >> 2) + 4 * h; }
DI int swz8(int row) { const int x = (row >> 1) & 7; return ((x & 1) << 2) | (x >> 1); }
DI u32x4 pack8(const f32x16& p, int s) { return (u32x4){pk2(p[8 * s], p[8 * s + 1]), pk2(p[8 * s + 2], p[8 * s + 3]), pk2(p[8 * s + 4], p[8 * s + 5]), pk2(p[8 * s + 6], p[8 * s + 7])}; }
DI s16x4 tr_rd(ldsp p) { typedef short v4i16_t __attribute__((ext_vector_type(4))); return __builtin_bit_cast(s16x4, __builtin_amdgcn_ds_read_tr16_b64_v4i16((LAS v4i16_t*)p)); }
DI void att_zero(f32x16& p0, f32x16& p1) {
#pragma unroll
    for (int i = 0; i < 16; ++i) { p0[i] = 0.f; p1[i] = 0.f; }
}
template <int MODE> DI void att_bias(f32x16& p0, f32x16& p1, ldsp lds, int slot, int kt, int hh) {
    if (MODE == 1) return;
#pragma unroll
    for (int g = 0; g < 4; ++g) {
        const f32x4 r0 = *(LAS f32x4*)(lds + ATT_RK + 4 * (64 * slot + 8 * g + 4 * hh)), r1 = *(LAS f32x4*)(lds + ATT_RK + 4 * (64 * slot + 32 + 8 * g + 4 * hh));
        if (MODE == 0) { const f32x4 c0 = *(LAS f32x4*)(lds + ATT_CS + 4 * (64 * kt + 8 * g + 4 * hh)), c1 = *(LAS f32x4*)(lds + ATT_CS + 4 * (64 * kt + 32 + 8 * g + 4 * hh));
#pragma unroll
            for (int j = 0; j < 4; ++j) { p0[4 * g + j] = p0[4 * g + j] * r0[j] + c0[j]; p1[4 * g + j] = p1[4 * g + j] * r1[j] + c1[j]; } }
        else {
#pragma unroll
            for (int j = 0; j < 4; ++j) { p0[4 * g + j] *= r0[j]; p1[4 * g + j] *= r1[j]; } }
    }
}
template <int MODE> DI void att_prep(ldsp lds, int slot, int kt, const float* lfp, int tid, int lane, int wid) {
    if (MODE == 1) return;
    { const int row = tid >> 3, sc = tid & 7;
      const u32x4 kr = *(LAS u32x4*)(lds + slot * ATT_SLOT + row * 128 + ((sc ^ swz8(row)) << 4));
      const float f[8] = {bf_lo(kr.x), bf_hi(kr.x), bf_lo(kr.y), bf_hi(kr.y), bf_lo(kr.z), bf_hi(kr.z), bf_lo(kr.w), bf_hi(kr.w)};
      float ss = 0.f;
#pragma unroll
      for (int j = 0; j < 8; ++j) ss += f[j] * f[j];
      ss = sum8(ss);
      if (sc == 0) *(LAS float*)(lds + ATT_RK + 4 * (64 * slot + row)) = __builtin_amdgcn_rsqf(ss * (1.f / HD) + EPS); }
    if (MODE == 0 && wid == 0) {
        const float a = lfp[(size_t)(64 * kt + lane) * 4] * LOG2E;
        float suf = a;
#pragma unroll
        for (int off = 1; off < 64; off <<= 1) { const float v = __shfl_down(suf, off); if (lane + off < 64) suf += v; }
        const float E = *(LAS float*)(lds + ATT_WT + 32);
        *(LAS float*)(lds + ATT_CS + 4 * (64 * kt + lane)) = E + suf - a;
        if (lane == 0) *(LAS float*)(lds + ATT_WT + 32) = E + suf;
    }
}
DI void att_qk(f32x16& p0, f32x16& p1, ldsp Kb, ldsp Qb  , int r, int hh) {
    const int sw = swz8(r);
#pragma unroll
    for (int ks = 0; ks < 4; ++ks) {
        const int co = ((2 * ks + hh) ^ sw) << 4;
        const bf16x8 k0 = *(LAS bf16x8*)(Kb + r * 128 + co);
        const bf16x8 k1 = *(LAS bf16x8*)(Kb + (32 + r) * 128 + co);
        const bf16x8 qv = *(LAS bf16x8*)(Qb + 1024 * ks);
        p0 = MFMA32(k0, qv, p0); p1 = MFMA32(k1, qv, p1); }
}
DI void att_pv(f32x16& o0, f32x16& o1, ldsp Vb, const f32x16& p0, const f32x16& p1, int hh, int q4, int p4, int blk) {
    const int rl = 4 * hh + q4, sl = swz8(rl), sh = swz8(rl + 8), cb = 2 * blk + (p4 >> 1), in8 = 8 * (p4 & 1);
    const int ol0 = rl * 128 + ((cb ^ sl) << 4) + in8, ol1 = rl * 128 + (((4 + cb) ^ sl) << 4) + in8;
    const int oh0 = (rl + 8) * 128 + ((cb ^ sh) << 4) + in8, oh1 = (rl + 8) * 128 + (((4 + cb) ^ sh) << 4) + in8;
#pragma unroll
    for (int sb = 0; sb < 2; ++sb)
#pragma unroll
        for (int s = 0; s < 2; ++s) {
            const bf16x8 pf = __builtin_bit_cast(bf16x8, pack8(sb ? p1 : p0, s));
            ldsp a = Vb + (32 * sb + 16 * s) * 128;
            const s16x4 l0 = tr_rd(a + ol0), h0 = tr_rd(a + oh0), l1 = tr_rd(a + ol1), h1 = tr_rd(a + oh1);
            const bf16x8 v0 = __builtin_shufflevector(l0, h0, 0, 1, 2, 3, 4, 5, 6, 7), v1 = __builtin_shufflevector(l1, h1, 0, 1, 2, 3, 4, 5, 6, 7);
            o0 = MFMA32(v0, pf, o0); o1 = MFMA32(v1, pf, o1);
        }
}
DI void att_softmax(f32x16& p0, f32x16& p1, float& m_run, float& l_run, f32x16& o0, f32x16& o1) {
    float tm = fmaxf(p0[0], p1[0]);
#pragma unroll
    for (int i = 1; i < 16; ++i) tm = fmaxf(tm, fmaxf(p0[i], p1[i]));
    { float lo_, hi_; halves(tm, lo_, hi_); tm = fmaxf(lo_, hi_); }
    const float mn = fmaxf(m_run, tm);
    if (__any(mn > m_run)) { const float alpha = ex2(m_run - mn); l_run *= alpha;
#pragma unroll
        for (int i = 0; i < 16; ++i) { o0[i] *= alpha; o1[i] *= alpha; } }
    m_run = mn;
    float rs = 0.f;
#pragma unroll
    for (int i = 0; i < 16; ++i) { p0[i] = ex2(p0[i] - mn); p1[i] = ex2(p1[i] - mn); rs += p0[i] + p1[i]; }
    l_run += rs;
}
DI float mul_s(float a, float b) { return a * b; }
template <bool BAND> DI void att_sb(f32x16& p0, f32x16& p1, float& R, int jrel, int qrel, int hh) {
#pragma unroll
    for (int sb = 1; sb >= 0; --sb) {
#pragma unroll
        for (int g = 3; g >= 0; --g) {
            float omb[4], be[4];
#pragma unroll
            for (int j = 0; j < 4; ++j) { const float z = sb ? p1[4 * g + j] : p0[4 * g + j];
                float e = ex2(z);
                if (BAND) { const int kv = 64 * jrel + 32 * sb + 8 * g + 4 * hh + j; if (kv >= qrel) e = 0.f; }
                omb[j] = rcpf_(1.f + e); be[j] = 1.f - omb[j]; }
            const float t2 = omb[3], t1 = mul_s(t2, omb[2]), t0 = mul_s(t1, omb[1]), my4 = mul_s(t0, omb[0]);
            float lo_, hi_; halves(my4, lo_, hi_);
            const float base = hh ? R : mul_s(R, hi_);
            const float w3 = mul_s(be[3], base), w2 = mul_s(be[2], mul_s(base, t2)), w1 = mul_s(be[1], mul_s(base, t1)), w0 = mul_s(be[0], mul_s(base, t0));
            R = mul_s(R, mul_s(lo_, hi_));
            if (sb) { p1[4 * g] = w0; p1[4 * g + 1] = w1; p1[4 * g + 2] = w2; p1[4 * g + 3] = w3; }
            else { p0[4 * g] = w0; p0[4 * g + 1] = w1; p0[4 * g + 2] = w2; p0[4 * g + 3] = w3; }
        }
    }
}
DI void glds16(const void* gsrc, unsigned lds_dst) { unsigned keep;
    asm volatile("s_mov_b32 %0, m0\n\ts_mov_b32 m0, %2\n\ts_nop 0\n\tglobal_load_lds_dwordx4 %1, off\n\ts_mov_b32 m0, %0" : "=&s"(keep) : "v"(gsrc), "s"(lds_dst) : "memory"); }
#define ATT_WAITBAR(N) asm volatile("s_waitcnt vmcnt(" #N ") lgkmcnt(0)\n\ts_barrier" ::: "memory")

template <int MODE>
DI void attn_unit(ldsp lds, const bf16_t* Qp, const bf16_t* Kp, const bf16_t* Vp, int kvstride, const bf16_t* Gp, bf16_t* Op, const float* lfp  , const float* qnw, const float* knw, int qt, int nq) {
    int tid_ = threadIdx.x; asm volatile("" : "+v"(tid_));
    const int tid = tid_, lane = tid & 63, wid = __builtin_amdgcn_readfirstlane(tid >> 6), r = lane & 31, hh = lane >> 5;
    qnw = launder(qnw); lfp = launder(lfp); knw = launder(knw);
    const int NT = (MODE == 2) ? 4 : 4 * qt + 4;
    const int NRES = NT < ATT_NRES ? NT : ATT_NRES;
#define ATT_KT(i) ((MODE == 2) ? (i) : NT - 1 - (i))
    const int drow = 8 * wid + (lane >> 3);
    const size_t dma_off = (size_t)drow * kvstride + 8 * ((lane & 7) ^ swz8(drow));
    const unsigned lds0 = (unsigned)(uintptr_t)lds;
#define ATT_DMA_TO(i, slot) do { const size_t to_ = (size_t)ATT_KT(i) * 64 * kvstride + dma_off; const unsigned sl_ = __builtin_amdgcn_readfirstlane(lds0 + (slot) * ATT_SLOT + wid * 1024); \
        glds16(Kp + to_, sl_); glds16(Vp + to_, sl_ + 8192); } while (0)
#define ATT_DMA(i) ATT_DMA_TO(i, (i) % ATT_NSLOT)
    u32x4 qraw[4];
    { const bf16_t* qrow = Qp + (size_t)(qt * 256 + wid * 32 + r) * NP + 8 * hh;
#pragma unroll
      for (int ks = 0; ks < 4; ++ks) qraw[ks] = *(const u32x4*)(qrow + 16 * ks); }
#pragma unroll 1
    for (int i = 0; i < NRES; ++i) ATT_DMA_TO(i, i);
    if (tid < 24) *(LAS unsigned*)(lds + ATT_FLAG + 4 * tid) = 0u;
    float sufv = 0.f, av = 0.f; const int klo = 64 * (NT - NRES), kcnt = 64 * NRES;
    if (MODE == 0) {
        if (tid < kcnt) av = lfp[(size_t)(klo + tid) * 4] * LOG2E;
        sufv = av;
#pragma unroll
        for (int off = 1; off < 64; off <<= 1) { const float v = __shfl_down(sufv, off); if (lane + off < 64) sufv += v; }
        if (lane == 0) *(LAS float*)(lds + ATT_WT + 4 * wid) = sufv;
    }
    ATT_WAITBAR(0);
#pragma unroll 1
    for (int i = 0; i < NRES; ++i) att_prep<(MODE == 0) ? 2 : MODE>(lds, i, 0, nullptr, tid, lane, wid);
    if (MODE == 0) { float offs = 0.f;
#pragma unroll
        for (int w = 0; w < 8; ++w) { const float x = *(LAS float*)(lds + ATT_WT + 4 * w); if (w > wid) offs += x; }
        if (tid < kcnt) *(LAS float*)(lds + ATT_CS + 4 * (klo + tid)) = offs + sufv - av;
        if (tid == 0) *(LAS float*)(lds + ATT_WT + 32) = offs + sufv; }
    asm volatile("s_waitcnt lgkmcnt(0)\n\ts_barrier" ::: "memory");
    const int qrel = 32 * wid + r;
    const int q4 = (lane & 15) >> 2, p4 = lane & 3, blk = (lane >> 4) & 1;
    ldsp Qb = lds + ATT_Q + wid * 4096 + lane * 16;
#pragma unroll 1
    for (int qq = 0; qq < nq; ++qq) {
        const int q0 = (qt + qq) * 256;
        float qn2 = 0.f;
        { float v[4][8]; float ss = 0.f;
#pragma unroll
          for (int ks = 0; ks < 4; ++ks) { const u32x4 raw = qraw[ks];
              v[ks][0] = bf_lo(raw.x); v[ks][1] = bf_hi(raw.x); v[ks][2] = bf_lo(raw.y); v[ks][3] = bf_hi(raw.y); v[ks][4] = bf_lo(raw.z); v[ks][5] = bf_hi(raw.z); v[ks][6] = bf_lo(raw.w); v[ks][7] = bf_hi(raw.w);
#pragma unroll
              for (int j = 0; j < 8; ++j) ss += v[ks][j] * v[ks][j]; }
          float sc_all = 0.125f * LOG2E;
          if (MODE != 1) { float lo_, hi_; halves(ss, lo_, hi_); sc_all *= __builtin_amdgcn_rsqf((lo_ + hi_) * (1.f / HD) + EPS); }
#pragma unroll
          for (int ks = 0; ks < 4; ++ks) {
              float w[8];
#pragma unroll
              for (int j = 0; j < 8; ++j) w[j] = (MODE != 1) ? qnw[16 * ks + 8 * hh + j] * knw[16 * ks + 8 * hh + j] : 1.f;
              u32x4 pk; pk.x = pk2(v[ks][0] * sc_all * w[0], v[ks][1] * sc_all * w[1]); pk.y = pk2(v[ks][2] * sc_all * w[2], v[ks][3] * sc_all * w[3]);
              pk.z = pk2(v[ks][4] * sc_all * w[4], v[ks][5] * sc_all * w[5]); pk.w = pk2(v[ks][6] * sc_all * w[6], v[ks][7] * sc_all * w[7]);
              *(LAS u32x4*)(Qb + ks * 1024) = pk;
              if (MODE == 0) {
#pragma unroll
                  for (int j = 0; j < 8; ++j) { const float t_ = v[ks][j] * sc_all * w[j]; qn2 += t_ * t_; } } } }
        if (qq + 1 < nq) { const bf16_t* qrow = Qp + (size_t)(q0 + 256 + wid * 32 + r) * NP + 8 * hh;
#pragma unroll
            for (int ks = 0; ks < 4; ++ks) qraw[ks] = *(const u32x4*)(qrow + 16 * ks); }
        u32x2 graw[8];
#pragma unroll
        for (int e = 0; e < 8; ++e) graw[e] = *(const u32x2*)(Gp + (size_t)(q0 + wid * 32 + r) * NP + 32 * (e >> 2) + 8 * (e & 3) + 4 * hh);
        float smax = 0.f;
        if (MODE == 0) { float lo_, hi_; halves(qn2, lo_, hi_); smax = sqrtf(lo_ + hi_) * 8.f * 1.02f; }

        float m_run = -INFINITY, l_run = 0.f, R = 1.f;
        f32x16 o0, o1, p0, p1;
#pragma unroll
        for (int i = 0; i < 16; ++i) { o0[i] = 0.f; o1[i] = 0.f; }
        bool done = false;
#pragma unroll 1
        for (int it = (MODE == 2) ? 0 : 3 - ((32 * wid + 31) >> 6); it < NRES; ++it) {
            const bool band = (MODE != 2) && it < 4;
            const int jrel = 3 - it;
#if ATT_TILE_SKIP
            if (MODE != 2 && !band) {
                bool sk;
                if (MODE == 0) { const float nmax = *(LAS float*)(lds + ATT_CS + 4 * (64 * ATT_KT(it) + 63));
                    sk = !__any(nmax + smax >= m_run - 48.f); }
                else sk = !__any(R >= 0x1p-48f);
                if (sk) { done = true; break; }
            }
#endif
            ldsp Kb = lds + it * ATT_SLOT;
            att_zero(p0, p1);
            att_qk(p0, p1, Kb, Qb, r, hh);
            att_bias<MODE>(p0, p1, lds, it, ATT_KT(it), hh);
            if (MODE == 1) { if (band) att_sb<true>(p0, p1, R, jrel, qrel, hh); else att_sb<false>(p0, p1, R, -1, qrel, hh); }
            else {
                if (MODE == 0 && band) {
#pragma unroll
                    for (int e = 0; e < 16; ++e) { const int kv = 64 * jrel + crow(e, hh); if (kv > qrel) p0[e] = -INFINITY; if (kv + 32 > qrel) p1[e] = -INFINITY; } }
                att_softmax(p0, p1, m_run, l_run, o0, o1);
            }
            att_pv(o0, o1, Kb + 8192, p0, p1, hh, q4, p4, blk);
        }
        if (MODE != 2 && NRES < NT) {
            if (lane == 0) *(LAS unsigned*)(lds + ATT_FLAG + 64 + 4 * wid) = done ? 0u : 1u;
            asm volatile("s_waitcnt lgkmcnt(0)\n\ts_barrier" ::: "memory");
            const u32x4 n0 = *(LAS u32x4*)(lds + ATT_FLAG + 64), n1 = *(LAS u32x4*)(lds + ATT_FLAG + 80);
            if (__builtin_amdgcn_readfirstlane((n0.x | n0.y) | (n0.z | n0.w) | (n1.x | n1.y) | (n1.z | n1.w)) != 0u) {
                const int it0 = NRES;
                ATT_DMA(it0); if (it0 + 1 < NT) ATT_DMA(it0 + 1); if (it0 + 2 < NT) ATT_DMA(it0 + 2);
                ATT_WAITBAR(0);
#pragma unroll 1
                for (int k = 0; k < 3; ++k) if (it0 + k < NT) att_prep<MODE>(lds, (it0 + k) % ATT_NSLOT, ATT_KT(it0 + k), lfp, tid, lane, wid);
                asm volatile("s_waitcnt lgkmcnt(0)\n\ts_barrier" ::: "memory");
                bool skipcur = false;
#pragma unroll 1
                for (int s2 = 2 * it0; s2 < 2 * NT; ++s2) {
                    const int i = s2 >> 1;
#if ATT_TILE_SKIP
                    if ((s2 & 1) == 0 && i > it0) {
                        const u32x4 f0 = *(LAS u32x4*)(lds + ATT_FLAG + 32 * ((i - 1) & 1)), f1 = *(LAS u32x4*)(lds + ATT_FLAG + 32 * ((i - 1) & 1) + 16);
                        if (__builtin_amdgcn_readfirstlane((f0.x & f0.y) & (f0.z & f0.w) & (f1.x & f1.y) & (f1.z & f1.w)) != 0u) break; }
#endif
                    if ((s2 & 1) == 0 && i + 3 < NT) ATT_DMA(i + 3);
                    ldsp Kb = lds + (i % ATT_NSLOT) * ATT_SLOT;
                    if ((s2 & 1) == 0) {
                        skipcur = done;
#if ATT_TILE_SKIP
                        if (!skipcur) {
                            if (MODE == 0) { const float nmax = *(LAS float*)(lds + ATT_CS + 4 * (64 * ATT_KT(i) + 63)); skipcur = !__any(nmax + smax >= m_run - 48.f); }
                            else skipcur = !__any(R >= 0x1p-48f);
                            if (skipcur) done = true; }
                        if (skipcur && lane == 0) *(LAS unsigned*)(lds + ATT_FLAG + 32 * (i & 1) + 4 * wid) = 1u;
#endif
                        if (!skipcur) { att_zero(p0, p1); att_qk(p0, p1, Kb, Qb, r, hh); att_bias<MODE>(p0, p1, lds, i % ATT_NSLOT, ATT_KT(i), hh); }
                    } else {
                        if (!skipcur) {
                            if (MODE == 1) att_sb<false>(p0, p1, R, -1, qrel, hh); else att_softmax(p0, p1, m_run, l_run, o0, o1);
                            att_pv(o0, o1, Kb + 8192, p0, p1, hh, q4, p4, blk); }
                        ATT_WAITBAR(0);
                        if (i + 3 < NT) att_prep<MODE>(lds, (i + 3) % ATT_NSLOT, ATT_KT(i + 3), lfp, tid, lane, wid);
                        asm volatile("s_waitcnt lgkmcnt(0)\n\ts_barrier" ::: "memory");
                    }
                }
                ATT_WAITBAR(0);
            }
        }
        float inv = 1.f;
        if (MODE != 1) { float lo_, hi_; halves(l_run, lo_, hi_); inv = 1.0f / (lo_ + hi_); }
        const size_t row = (size_t)(q0 + wid * 32 + r);
#pragma unroll
        for (int dt = 0; dt < 2; ++dt)
#pragma unroll
            for (int g = 0; g < 4; ++g) { const int d = 32 * dt + 8 * g + 4 * hh;
                const u32x2 gr = graw[4 * dt + g];
                const float g0 = silu_f(bf_lo(gr.x)), g1 = silu_f(bf_hi(gr.x)), g2 = silu_f(bf_lo(gr.y)), g3 = silu_f(bf_hi(gr.y));
                const float a0 = dt ? o1[4 * g] : o0[4 * g], a1 = dt ? o1[4 * g + 1] : o0[4 * g + 1], a2 = dt ? o1[4 * g + 2] : o0[4 * g + 2], a3 = dt ? o1[4 * g + 3] : o0[4 * g + 3];
                *(u32x2*)(Op + row * DMIX + d) = (u32x2){pk2(a0 * inv * g0, a1 * inv * g1), pk2(a2 * inv * g2, a3 * inv * g3)}; }
    }
    asm volatile("s_waitcnt lgkmcnt(0)\n\ts_barrier" ::: "memory");
#undef ATT_KT
#undef ATT_DMA
#undef ATT_DMA_TO
}

constexpr int HG_Q = 0, HG_F = 8192, HG_V = 16384, HG_O = 24576;
DI void hgrn_unit_valu(ldsp lds, const bf16_t* pj  , bf16_t* mx  , int h, int layer, const float* lb_logits, const float* onorm) {
    int tid_ = threadIdx.x; asm volatile("" : "+v"(tid_));
    const int tid = tid_, lane = tid & 63, wid = __builtin_amdgcn_readfirstlane(tid >> 6);
    lb_logits = launder(lb_logits); onorm = launder(onorm);
    const int tt = tid >> 4, c4 = (tid & 15) * 4;
    float oml[4], onw[4];
#pragma unroll
    for (int j = 0; j < 4; ++j) { const int c = h * HD + c4 + j;
        float lbv = 0.f;
        if (layer == 1) { const float l0 = lb_logits[c], l1 = lb_logits[256 + c], mx_ = fmaxf(l0, l1), e0 = expf(l0 - mx_), e1 = expf(l1 - mx_), p0 = e0 / (e0 + e1), p1 = e1 / (e0 + e1);
            lbv = fminf(fmaxf((p0 + p1) - p0, 0.f), 1.0f - 1e-6f); }
        oml[j] = 1.f - lbv; onw[j] = onorm[c]; }
    f32x2 S2[4];
#pragma unroll
    for (int i = 0; i < 4; ++i) S2[i] = (f32x2){0.f, 0.f};
    const bf16_t* base = pj + (size_t)tt * NP + h * HD + c4;
    u32x2 rq = *(const u32x2*)(base + C_HQ), rf = *(const u32x2*)(base + C_HF), ri = *(const u32x2*)(base + C_HI);
#pragma unroll 1
    for (int ch = 0; ch < SEQ / 32; ++ch) {
        { const float hq[4] = {bf_lo(rq.x), bf_hi(rq.x), bf_lo(rq.y), bf_hi(rq.y)}, hf[4] = {bf_lo(rf.x), bf_hi(rf.x), bf_lo(rf.y), bf_hi(rf.y)};
          f32x4 q, f;
#pragma unroll
          for (int j = 0; j < 4; ++j) { q[j] = silu_f(hq[j]); const float sg = rcpf_(1.f + ex2(hf[j] * LOG2E)); f[j] = 1.f - oml[j] * sg; }
          *(LAS f32x4*)(lds + HG_Q + 4 * (tt * 64 + c4)) = q; *(LAS f32x4*)(lds + HG_F + 4 * (tt * 64 + c4)) = f;
          *(LAS f32x4*)(lds + HG_V + 4 * (tt * 64 + c4)) = (f32x4){bf_lo(ri.x), bf_hi(ri.x), bf_lo(ri.y), bf_hi(ri.y)}; }
        __syncthreads();
        if (ch + 1 < SEQ / 32) { const bf16_t* nb = base + (size_t)(ch + 1) * 32 * NP; rq = *(const u32x2*)(nb + C_HQ); rf = *(const u32x2*)(nb + C_HF); ri = *(const u32x2*)(nb + C_HI); }
        const u32x2 gr = *(const u32x2*)(base + (size_t)ch * 32 * NP + C_HG);
        float acc[32];
#pragma unroll
        for (int t = 0; t < 32; ++t) {
            const f32x4 qa = *(LAS f32x4*)(lds + HG_Q + 4 * (t * 64 + 8 * wid)), qb = *(LAS f32x4*)(lds + HG_Q + 4 * (t * 64 + 8 * wid + 4));
            const f32x4 fa = *(LAS f32x4*)(lds + HG_F + 4 * (t * 64 + 8 * wid)), fb = *(LAS f32x4*)(lds + HG_F + 4 * (t * 64 + 8 * wid + 4));
            const float v = *(LAS float*)(lds + HG_V + 4 * (t * 64 + lane));
            const f32x2 v2 = {v, v};
            S2[0] = (f32x2){fa.x, fa.y} * (S2[0] - v2) + v2; S2[1] = (f32x2){fa.z, fa.w} * (S2[1] - v2) + v2;
            S2[2] = (f32x2){fb.x, fb.y} * (S2[2] - v2) + v2; S2[3] = (f32x2){fb.z, fb.w} * (S2[3] - v2) + v2;
            f32x2 a2 = S2[0] * (f32x2){qa.x, qa.y}, b2 = S2[1] * (f32x2){qa.z, qa.w};
            a2 += S2[2] * (f32x2){qb.x, qb.y}; b2 += S2[3] * (f32x2){qb.z, qb.w};
            a2 += b2; acc[t] = a2.x + a2.y;
        }
#pragma unroll
        for (int t = 0; t < 32; ++t) *(LAS float*)(lds + HG_O + 4 * ((wid * 32 + t) * 64 + lane)) = acc[t];
        __syncthreads();
        f32x4 o = *(LAS f32x4*)(lds + HG_O + 4 * (tt * 64 + c4));
#pragma unroll
        for (int w = 1; w < 8; ++w) o += *(LAS f32x4*)(lds + HG_O + 4 * ((w * 32 + tt) * 64 + c4));
        float ss = (o.x * o.x + o.y * o.y) + (o.z * o.z + o.w * o.w);
        ss = sum16(ss);
        const float rstd = 1.0f / sqrtf(ss * (1.f / HD) + EPS);
        const float g0 = silu_f(bf_lo(gr.x)), g1 = silu_f(bf_hi(gr.x)), g2 = silu_f(bf_lo(gr.y)), g3 = silu_f(bf_hi(gr.y));
        *(u32x2*)(mx + (size_t)(ch * 32 + tt) * DMIX + O_HG + h * HD + c4) = (u32x2){pk2(o.x * rstd * onw[0] * g0, o.y * rstd * onw[1] * g1), pk2(o.z * rstd * onw[2] * g2, o.w * rstd * onw[3] * g3)};
    }
    __syncthreads();
}

typedef short s16x4v __attribute__((ext_vector_type(4)));
#define MFMA16(a, b, c) __builtin_amdgcn_mfma_f32_16x16x16bf16_1k((a), (b), (c), 0, 0, 0)
constexpr int HM_QS = 0, HM_QM = 16 * 136, HM_KM = 2 * 16 * 136, HM_KET = 3 * 16 * 136, HM_VT = HM_KET + 64 * 40, HM_DEC = HM_VT + 64 * 40, HM_SLOT = HM_DEC + 256, HM_NS = 4, HM_OB = HM_NS * HM_SLOT, HM_OSTR = 272;
constexpr int HM_RAW = HM_OB + 2 * 16 * HM_OSTR, HM_RSLOT = 8192, HM_NR = 8;
static_assert(HM_SLOT % 16 == 0 && HM_RAW % 16 == 0 && HM_RAW + HM_NR * HM_RSLOT <= 147392, "HGRN LDS map");
DI s16x4v pack4(const f32x4 v) { u32x2 p = {pk2(v.x, v.y), pk2(v.z, v.w)}; return __builtin_bit_cast(s16x4v, p); }
DI void hgrn_unit(ldsp lds, const bf16_t* pj  , bf16_t* mx  , int h, int layer, const float* lb_logits, const float* onorm) {
    int tid_ = threadIdx.x; asm volatile("" : "+v"(tid_));
    const int tid = tid_, lane = tid & 63, wid = __builtin_amdgcn_readfirstlane(tid >> 6);
    lb_logits = launder(lb_logits); onorm = launder(onorm);
    const bool cons = wid < 4;
    const int fr = lane & 15, fq = lane >> 4;
    constexpr int NBLK = SEQ / 16;
    const int dl = lane >> 2, tq = lane & 3;
    const int pd = 16 * (wid & 3) + dl;
    float oml = 1.f;
    if (layer == 1) { const float l0 = lb_logits[h * HD + pd], l1 = lb_logits[256 + h * HD + pd], mx_ = fmaxf(l0, l1), e0 = expf(l0 - mx_), e1 = expf(l1 - mx_), p0 = e0 / (e0 + e1), p1 = e1 / (e0 + e1);
        oml = 1.f - fminf(fmaxf((p0 + p1) - p0, 0.f), 1.0f - 1e-6f); }
    f32x4 Sacc[4];
#pragma unroll
    for (int i = 0; i < 4; ++i) Sacc[i] = (f32x4){0.f, 0.f, 0.f, 0.f};
    const int e4 = 4 * fr, trow = 4 * wid + fq;
    const f32x4 onw = *(const f32x4*)(onorm + h * HD + e4);
    const unsigned lds0 = (unsigned)(uintptr_t)lds;
    const int pseg = (wid & 3);
    const bf16_t* dsrc = pj + (size_t)(lane >> 3) * NP + (pseg == 0 ? C_HQ : pseg == 1 ? C_HF : pseg == 2 ? C_HI : C_HG) + h * HD + 8 * (lane & 7);
#define HM_DMA(blk) do { const unsigned d_ = __builtin_amdgcn_readfirstlane(lds0 + HM_RAW + ((blk) & (HM_NR - 1)) * HM_RSLOT + pseg * 2048); \
        glds16(dsrc + (size_t)(blk) * 16 * NP, d_); glds16(dsrc + (size_t)((blk) * 16 + 8) * NP, d_ + 1024); } while (0)
    if (!cons) { HM_DMA(0); HM_DMA(1); HM_DMA(2); HM_DMA(3); asm volatile("s_waitcnt vmcnt(6)" ::: "memory"); }
    asm volatile("s_waitcnt lgkmcnt(0)\n\ts_barrier" ::: "memory");
#pragma unroll 1
    for (int n = -2; n <= NBLK; ++n) {
        if (!cons) {
            const int nb = n + 2;
            if (n + 6 < NBLK) HM_DMA(n + 6);
            if (nb < NBLK) {
                ldsp sb = lds + (nb & 3) * HM_SLOT;
                ldsp rw = lds + HM_RAW + (nb & (HM_NR - 1)) * HM_RSLOT + (4 * tq) * 128 + 2 * pd;
                float q[4], k[4], c[4], v[4];
#pragma unroll
                for (int i = 0; i < 4; ++i) { const float hq = __uint_as_float((unsigned)*(LAS bf16_t*)(rw + i * 128) << 16), hf = __uint_as_float((unsigned)*(LAS bf16_t*)(rw + 2048 + i * 128) << 16);
                    v[i] = __uint_as_float((unsigned)*(LAS bf16_t*)(rw + 4096 + i * 128) << 16);
                    q[i] = silu_f(hq); k[i] = oml * rcpf_(1.f + ex2(hf * LOG2E));
                    c[i] = fmaxf(__builtin_amdgcn_logf(1.f - k[i]), -15.f); }
                c[1] += c[0]; c[2] += c[1]; c[3] += c[2];
                float inc = c[3];
                { const float u1 = dppf<0x90>(inc); if (tq >= 1) inc += u1; const float u2 = dppf<0x44>(inc); if (tq >= 2) inc += u2; }
                const float exc = inc - c[3];
                const float Bm = dppf<0x55>(inc), Be = dppf<0xFF>(inc);
                s16x4v ket, vt; bf16_t* ketp = (bf16_t*)&ket; bf16_t* vtp = (bf16_t*)&vt;
#pragma unroll
                for (int i = 0; i < 4; ++i) { const float B = exc + c[i]; const int t = 4 * tq + i;
                    *(LAS bf16_t*)(sb + HM_QS + t * 136 + 2 * pd) = (bf16_t)(pk2(q[i] * ex2(B), 0.f) & 0xffffu);
                    *(LAS bf16_t*)(sb + HM_QM + t * 136 + 2 * pd) = (bf16_t)(pk2(q[i] * ex2(B - Bm), 0.f) & 0xffffu);
                    *(LAS bf16_t*)(sb + HM_KM + t * 136 + 2 * pd) = (bf16_t)(pk2(k[i] * ex2(Bm - B), 0.f) & 0xffffu);
                    ketp[i] = (bf16_t)(pk2(k[i] * ex2(Be - B), 0.f) & 0xffffu); vtp[i] = (bf16_t)(pk2(v[i], 0.f) & 0xffffu); }
                *(LAS s16x4v*)(sb + HM_KET + pd * 40 + 8 * tq) = ket;
                *(LAS s16x4v*)(sb + HM_VT + pd * 40 + 8 * tq) = vt;
                if (tq == 3) *(LAS float*)(sb + HM_DEC + 4 * pd) = ex2(Be);
            }
            { const int ahead = (n + 6 < NBLK ? n + 6 : NBLK - 1) - (n + 3);
              if (ahead >= 3) asm volatile("s_waitcnt vmcnt(6)" ::: "memory"); else if (ahead == 2) asm volatile("s_waitcnt vmcnt(4)" ::: "memory");
              else if (ahead == 1) asm volatile("s_waitcnt vmcnt(2)" ::: "memory"); else asm volatile("s_waitcnt vmcnt(0)" ::: "memory"); }
        } else {
            if (n >= 1) {
                const f32x4 o = *(LAS f32x4*)(lds + HM_OB + ((n - 1) & 1) * 16 * HM_OSTR + trow * HM_OSTR + 4 * e4);
                const u32x2 gv = *(LAS u32x2*)(lds + HM_RAW + ((n - 1) & (HM_NR - 1)) * HM_RSLOT + 3 * 2048 + trow * 128 + 2 * e4);
                const float ss = sum16((o.x * o.x + o.y * o.y) + (o.z * o.z + o.w * o.w));
                const float rstd = __builtin_amdgcn_rsqf(ss * (1.f / HD) + EPS);
                const float g0 = silu_f(bf_lo(gv.x)), g1 = silu_f(bf_hi(gv.x)), g2 = silu_f(bf_lo(gv.y)), g3 = silu_f(bf_hi(gv.y));
                *(u32x2*)(mx + (size_t)(16 * (n - 1) + trow) * DMIX + O_HG + h * HD + e4) = (u32x2){pk2(o.x * rstd * onw.x * g0, o.y * rstd * onw.y * g1), pk2(o.z * rstd * onw.z * g2, o.w * rstd * onw.w * g3)};
            }
            if (n >= 0 && n < NBLK) {
                ldsp sb = lds + (n & 3) * HM_SLOT;
                s16x4v qm[4], qs[4], km[4];
#pragma unroll
                for (int dt = 0; dt < 4; ++dt) { const int co = fr * 136 + (16 * dt + 4 * fq) * 2;
                    qm[dt] = *(LAS s16x4v*)(sb + HM_QM + co); qs[dt] = *(LAS s16x4v*)(sb + HM_QS + co); km[dt] = *(LAS s16x4v*)(sb + HM_KM + co); }
                const s16x4v vt = *(LAS s16x4v*)(sb + HM_VT + (16 * wid + fr) * 40 + 8 * fq);
                f32x4 pt = {0.f, 0.f, 0.f, 0.f};
#pragma unroll
                for (int dt = 0; dt < 4; ++dt) pt = MFMA16(km[dt], qm[dt], pt);
#pragma unroll
                for (int i = 0; i < 4; ++i) if (4 * fq + i > fr) pt[i] = 0.f;
                f32x4 ot = {0.f, 0.f, 0.f, 0.f};
#pragma unroll
                for (int dt = 0; dt < 4; ++dt) ot = MFMA16(pack4(Sacc[dt]), qs[dt], ot);
                ot = MFMA16(vt, pack4(pt), ot);
                *(LAS f32x4*)(lds + HM_OB + (n & 1) * 16 * HM_OSTR + fr * HM_OSTR + 4 * (16 * wid + 4 * fq)) = ot;
#pragma unroll
                for (int dt = 0; dt < 4; ++dt) { const f32x4 dc = *(LAS f32x4*)(sb + HM_DEC + 4 * (16 * dt + 4 * fq));
                    const s16x4v ke = *(LAS s16x4v*)(sb + HM_KET + (16 * dt + fr) * 40 + 8 * fq);
                    Sacc[dt] = MFMA16(ke, vt, Sacc[dt] * dc); }
            }
        }
        asm volatile("s_waitcnt lgkmcnt(0)\n\ts_barrier" ::: "memory");
    }
#undef HM_DMA
}

constexpr int PL_U = 0, PL_D = 79 * 512, PL_DSTR = 528, PL_Y = PL_D + 64 * PL_DSTR, PL_YSTR = 272;
static_assert(PL_Y + 8 * 32 * PL_YSTR <= 147392, "pooling LDS map");
DI void pool_unit(ldsp lds, const bf16_t* pj, bf16_t* mx, int t0, const bf16_t* wt  , const float* pscale) {
    wt = launder(wt); pscale = launder(pscale);
    int tid_ = threadIdx.x; asm volatile("" : "+v"(tid_));
    const int tid = tid_, lane = tid & 63, wid = __builtin_amdgcn_readfirstlane(tid >> 6), r = lane & 31, hh = lane >> 5;
    for (int idx = tid; idx < 79 * 32; idx += 512) { const int rr = idx >> 5, c16 = idx & 31, tok = t0 - 15 + rr;
        u32x4 v = {0u, 0u, 0u, 0u};
        if (tok >= 0) v = *(const u32x4*)(pj + (size_t)tok * NP + C_PV + 8 * c16);
        *(LAS u32x4*)(lds + PL_U + rr * 512 + 16 * c16) = v; }
    const int g = wid >> 1, th = wid & 1;
    bf16x8 bw[2][4];
#pragma unroll
    for (int nt = 0; nt < 2; ++nt)
#pragma unroll
        for (int ks = 0; ks < 4; ++ks) bw[nt][ks] = *(const bf16x8*)(wt + (size_t)(g * 64 + 32 * nt + r) * 64 + 16 * ks + 8 * hh);
    __syncthreads();
    { const int vec = lane & 7, run = lane >> 3, win = 2 << g, tl0 = 32 * th + 4 * run;
      ldsp ub = lds + PL_U + (15 + tl0) * 512 + g * 128 + vec * 16;
      float acc[8];
#pragma unroll
      for (int j = 0; j < 8; ++j) acc[j] = 0.f;
      for (int j = 0; j < win; ++j) { const u32x4 v = *(LAS u32x4*)(ub - j * 512);
          acc[0] += bf_lo(v.x); acc[1] += bf_hi(v.x); acc[2] += bf_lo(v.y); acc[3] += bf_hi(v.y); acc[4] += bf_lo(v.z); acc[5] += bf_hi(v.z); acc[6] += bf_lo(v.w); acc[7] += bf_hi(v.w); }
#pragma unroll
      for (int k = 0; k < 4; ++k) {
          const u32x4 u = *(LAS u32x4*)(ub + k * 512);
          const float us[8] = {bf_lo(u.x), bf_hi(u.x), bf_lo(u.y), bf_hi(u.y), bf_lo(u.z), bf_hi(u.z), bf_lo(u.w), bf_hi(u.w)};
          if (k > 0) { const u32x4 o = *(LAS u32x4*)(ub + (k - win) * 512);
              const float os[8] = {bf_lo(o.x), bf_hi(o.x), bf_lo(o.y), bf_hi(o.y), bf_lo(o.z), bf_hi(o.z), bf_lo(o.w), bf_hi(o.w)};
#pragma unroll
              for (int j = 0; j < 8; ++j) acc[j] += us[j] - os[j]; }
          const int t = t0 + tl0 + k, cnt = (t + 1 < win) ? t + 1 : win;
          const float icnt = 1.0f / (float)cnt;
          *(LAS u32x4*)(lds + PL_D + (tl0 + k) * PL_DSTR + g * 128 + vec * 16) = (u32x4){pk2(acc[0] * icnt - us[0], acc[1] * icnt - us[1]), pk2(acc[2] * icnt - us[2], acc[3] * icnt - us[3]),
                                                                                      pk2(acc[4] * icnt - us[4], acc[5] * icnt - us[5]), pk2(acc[6] * icnt - us[6], acc[7] * icnt - us[7])};
      } }
    { f32x16 y0, y1;
#pragma unroll
      for (int i = 0; i < 16; ++i) { y0[i] = 0.f; y1[i] = 0.f; }
#pragma unroll
      for (int ks = 0; ks < 4; ++ks) { const bf16x8 a = *(LAS bf16x8*)(lds + PL_D + (32 * th + r) * PL_DSTR + (64 * g + 16 * ks + 8 * hh) * 2);
          y0 = MFMA32(a, bw[0][ks], y0); y1 = MFMA32(a, bw[1][ks], y1); }
      const float sc0 = pscale[64 * g + r], sc1 = pscale[64 * g + 32 + r];
      ldsp ys = lds + PL_Y + wid * 32 * PL_YSTR;
#pragma unroll
      for (int i = 0; i < 16; ++i) { *(LAS float*)(ys + crow(i, hh) * PL_YSTR + 4 * r) = y0[i] * sc0; *(LAS float*)(ys + crow(i, hh) * PL_YSTR + 4 * (32 + r)) = y1[i] * sc1; }
      const int tok = lane >> 1, hf = lane & 1;
      const size_t trow = (size_t)(t0 + 32 * th + tok);
#pragma unroll
      for (int k = 0; k < 4; ++k) {
          const u32x4 gv = *(const u32x4*)(pj + trow * NP + C_PG + 64 * g + 32 * hf + 8 * k);
          const f32x4 ya = *(LAS f32x4*)(ys + tok * PL_YSTR + 4 * (32 * hf + 8 * k)), yb = *(LAS f32x4*)(ys + tok * PL_YSTR + 4 * (32 * hf + 8 * k + 4));
          *(u32x4*)(mx + trow * DMIX + O_POOL + 64 * g + 32 * hf + 8 * k) = (u32x4){pk2(ya.x * silu_f(bf_lo(gv.x)), ya.y * silu_f(bf_hi(gv.x))), pk2(ya.z * silu_f(bf_lo(gv.y)), ya.w * silu_f(bf_hi(gv.y))),
                                                                                  pk2(yb.x * silu_f(bf_lo(gv.z)), yb.y * silu_f(bf_hi(gv.z))), pk2(yb.z * silu_f(bf_lo(gv.w)), yb.w * silu_f(bf_hi(gv.w)))}; } }
    __syncthreads();
}

constexpr int U_HG = 128, U_AT = 1024, U_PL = 1024;
constexpr int U_ME = 256;
constexpr int U0_ME = U_HG, U0_SB = U0_ME + U_ME, U0_FX = U0_SB + U_AT, U0_PL = U0_FX + U_AT, U_TOTAL = U0_PL + U_PL;
DI void mixer_phase(ldsp lds, int layer, int cslot) {
    LAS int* slot = (LAS int*)(lds + LDS_SLOT);
    for (;;) {
        __syncthreads();
        if (threadIdx.x == 0) *slot = (int)atomicAdd((unsigned*)(kargs()->ws + WS_CTL) + 64 * cslot, 1u);
        __syncthreads();
        const int u = __builtin_amdgcn_readfirstlane(*slot);
        if (u >= U_TOTAL) break;
        kargp P = kargs();
        const bf16_t* proj = (const bf16_t*)(P->ws + WS_PROJ); bf16_t* mixed = (bf16_t*)(P->ws + WS_MIX);
        if (u < U0_ME) {
#ifndef NO_HGRN
            const int b = u >> 2, h = u & 3;
#pragma unroll 1
            for (int rep = 0; rep < ((PROBE_UNIT & 1) ? 2 : 1); ++rep)
            hgrn_unit(lds, proj + (size_t)b * SEQ * NP, mixed + (size_t)b * SEQ * DMIX, h, layer, P->lb_logits, P->hgrn_out_norm + layer * 256);
#endif
        } else if (u < U0_SB) {
#ifndef NO_MEM
            const int i = u - U0_ME, qt = 4 * (i >> 7), bh = i & 127, b = bh >> 2, h = bh & 3;
            const bf16_t* pb = proj + (size_t)b * SEQ * NP + h * HD; bf16_t* ob = mixed + (size_t)b * SEQ * DMIX + O_MEM + h * HD;
            const bf16_t* kb = (const bf16_t*)(P->ws + WS_KVM + layer * KVM_BYTES) + (size_t)b * NMEM * 512 + h * HD;
#pragma unroll 1
            for (int rep = 0; rep < ((PROBE_UNIT & 8) ? 2 : 1); ++rep)
            attn_unit<2>(lds, pb + C_MQ, kb, kb + 256, 512, pb + C_MG, ob, nullptr, P->mem_q_norm + layer * HD, P->mem_k_norm + layer * HD, qt, 4);
#endif
        } else if (u < U0_FX) {
#ifndef NO_SB
            const int i = u - U0_SB, qt = 7 - (i >> 7), bh = i & 127, b = bh >> 2, h = bh & 3;
            const bf16_t* pb = proj + (size_t)b * SEQ * NP + h * HD; bf16_t* ob = mixed + (size_t)b * SEQ * DMIX + O_SB + h * HD;
#pragma unroll 1
            for (int rep = 0; rep < ((PROBE_UNIT & 2) ? 2 : 1); ++rep)
            attn_unit<1>(lds, pb + C_SQ, pb + C_SK, pb + C_SV, NP, pb + C_SG, ob, nullptr, nullptr, nullptr, qt, 1);
#endif
        } else if (u < U0_PL) {
#ifndef NO_FOX
            const int i = u - U0_FX, qt = 7 - (i >> 7), bh = i & 127, b = bh >> 2, h = bh & 3;
            const bf16_t* pb = proj + (size_t)b * SEQ * NP + h * HD; bf16_t* ob = mixed + (size_t)b * SEQ * DMIX + O_FOX + h * HD;
            const float* lfp = (const float*)(P->ws + WS_LF) + (size_t)b * SEQ * 4 + h;
#pragma unroll 1
            for (int rep = 0; rep < ((PROBE_UNIT & 4) ? 2 : 1); ++rep)
            attn_unit<0>(lds, pb + C_FQ, pb + C_FK, pb + C_FV, NP, pb + C_FG, ob, lfp, P->fox_q_norm + layer * HD, P->fox_k_norm + layer * HD, qt, 1);
#endif
        } else {
#ifndef NO_POOL
            const int i = u - U0_PL, b = i >> 5, t0 = (i & 31) * 64;
#pragma unroll 1
            for (int rep = 0; rep < ((PROBE_UNIT & 16) ? 2 : 1); ++rep)
            pool_unit(lds, proj + (size_t)b * SEQ * NP, mixed + (size_t)b * SEQ * DMIX, t0, (const bf16_t*)(P->ws + WS_WPOOL + layer * WPOOL_BYTES), P->pool_scale + layer * 256);
#endif
        }
    }
}

#define XB_TMO      128
#define XB_XCNT(j)  (256  + 64 * (j))
#define XB_XSUB(j)  (1280 + 64 * (j))
#define XB_XGEN(j)  (2304 + 64 * (j))
#define XB_TOP      3328
#define XB_TOPGEN   3392
#define XCD_BAR_WORDS 3456
#define XB_SPIN_CAP (1u << 18)

__device__ __forceinline__ unsigned xb_ld(unsigned* p)              { return __hip_atomic_load(p, __ATOMIC_RELAXED, __HIP_MEMORY_SCOPE_AGENT); }
__device__ __forceinline__ unsigned xb_add(unsigned* p, unsigned v) { return __hip_atomic_fetch_add(p, v, __ATOMIC_RELAXED, __HIP_MEMORY_SCOPE_AGENT); }
__device__ __forceinline__ unsigned xb_xcc_id() { return (unsigned)__builtin_amdgcn_s_getreg((3 << 11) | 20) & 0xFu; }
#define XB_SPIN(cond, bar) do { unsigned _sp = 0; while (cond) { __builtin_amdgcn_s_sleep(1); \
    if ((++_sp & 255u) == 0u) { if (xb_ld(&(bar)[XB_TMO])) break; if (_sp > XB_SPIN_CAP) { atomicAdd(&(bar)[XB_TMO], 1u); break; } } } } while (0)

struct XcdBarrier {
    unsigned* bar; unsigned x;
    volatile LAS unsigned* st;
};

__device__ __forceinline__ XcdBarrier xcd_barrier_post(unsigned* bar, volatile LAS unsigned* st) {
    XcdBarrier b; b.bar = bar; b.x = xb_xcc_id(); b.st = st;
    if (threadIdx.x == 0) (void)xb_add(&bar[XB_XCNT(b.x)], 1u);
    return b;
}
__device__ __forceinline__ void xcd_barrier_complete(unsigned* bar, unsigned x, unsigned& nloc, unsigned& nx) {
    const unsigned G = gridDim.x * gridDim.y * gridDim.z;
    unsigned sum, cnt, mine, sp = 0u;
    for (;;) {
        sum = 0u; cnt = 0u; mine = 0u;
#pragma unroll
        for (unsigned j = 0; j < 16; ++j) { const unsigned c = xb_ld(&bar[XB_XCNT(j)]); sum += c; cnt += (c > 0u) ? 1u : 0u; mine = (j == x) ? c : mine; }
        if (sum == G) break;
        __builtin_amdgcn_s_sleep(1);
        if ((++sp & 255u) == 0u) { if (xb_ld(&bar[XB_TMO])) break; if (sp > XB_SPIN_CAP) { atomicAdd(&bar[XB_TMO], 1u); break; } }
    }
    nloc = mine > 0u ? mine : 1u; nx = cnt > 0u ? cnt : 1u;
}

__device__ __forceinline__ void xcd_barrier(const XcdBarrier& b) {
    asm volatile("s_waitcnt vmcnt(0)" ::: "memory");
    __syncthreads();
    if (threadIdx.x == 0) {
        unsigned* bar = b.bar;
        __builtin_amdgcn_s_waitcnt(0);
        unsigned nloc = b.st[0], nx = b.st[1];
        if (nloc == 0u) { xcd_barrier_complete(bar, b.x, nloc, nx); b.st[0] = nloc; b.st[1] = nx; }
        const unsigned old = xb_add(&bar[XB_XSUB(b.x)], 1u);
        const unsigned gen = old / nloc;
        if (old + 1u == (gen + 1u) * nloc) {
            __builtin_amdgcn_fence(__ATOMIC_RELEASE, "agent");
            asm volatile("s_waitcnt vmcnt(0)" ::: "memory");
            const unsigned og = xb_add(&bar[XB_TOP], 1u);
            const unsigned tg = og / nx;
            if (og + 1u == (tg + 1u) * nx) xb_add(&bar[XB_TOPGEN], 1u);
            else XB_SPIN(xb_ld(&bar[XB_TOPGEN]) == tg, bar);
            __builtin_amdgcn_fence(__ATOMIC_ACQUIRE, "agent");
            xb_add(&bar[XB_XGEN(b.x)], 1u);
            asm volatile("s_waitcnt vmcnt(0)" ::: "memory");
        } else {
            XB_SPIN(xb_ld(&bar[XB_XGEN(b.x)]) == gen, bar);
            __builtin_amdgcn_fence(__ATOMIC_ACQUIRE, "agent");
            asm volatile("s_waitcnt vmcnt(0)" ::: "memory");
        }
    }
    __syncthreads();
}

constexpr int CW_XBAR = 1024;
DI void seam_barrier(ldsp lds) {
    XcdBarrier b; b.bar = (unsigned*)(kargs()->ws + WS_CTL) + CW_XBAR; b.x = xb_xcc_id(); b.st = (volatile LAS unsigned*)(lds + LDS_BYTES - 32);
    xcd_barrier(b);
}

constexpr int N_PHASES = 8;
DI void in_gemm(ldsp lds, int layer) {
    kargp P = kargs(); unsigned char* ws = P->ws;
    pg8::Gemm g{(const bf16_t*)(ws + WS_HB), (const bf16_t*)(ws + WS_WIN + layer * WIN_BYTES), NTOK, NP, DM}; pg8::StaticOrder S; S.init(NTOK, NP, gridDim.x, blockIdx.x);
    if (EPI_NORM && layer == 1) {
        { const int tid = threadIdx.x, lane = tid & 63, wave = __builtin_amdgcn_readfirstlane(tid >> 6), p16 = lane & 15;
          const float* ssp = (const float*)(ws + WS_SSP); const float* ffp = (const float*)(ws + WS_FFP); float* lf = (float*)(ws + WS_LF);
          const f32x4 bias = *(const f32x4*)(P->fox_f_bias + NH);
          for (int r4 = blockIdx.x * 8 + wave; r4 < NTOK / 4; r4 += gridDim.x * 8) { const size_t row = (size_t)r4 * 4 + (lane >> 4);
              const float s1 = sum16(ssp[row * 16 + p16]); f32x4 f = *(const f32x4*)(ffp + (row * 16 + p16) * 4);
              f.x = sum16(f.x); f.y = sum16(f.y); f.z = sum16(f.z); f.w = sum16(f.w);
              const float rstd = 1.0f / sqrtf(s1 * (1.f / DM) + EPS);
              if (p16 < 4) { const float z = (p16 == 0 ? f.x : p16 == 1 ? f.y : p16 == 2 ? f.z : f.w) * rstd + (p16 == 0 ? bias.x : p16 == 1 ? bias.y : p16 == 2 ? bias.z : bias.w);
                  lf[row * 4 + p16] = fminf(z, 0.f) - log1pf(expf(-fabsf(z))); } } }
        pg8::EpiBf16RowScale E{(bf16_t*)(ws + WS_PROJ), NP, (const float*)(ws + WS_SSP), 1.f / DM, EPS};
        pg8::gemm_phase<pg8::EpiBf16RowScale, pg8::StaticOrder, true, true>(lds, g, S, E);
    } else {
        pg8::EpiBf16<0> E{(bf16_t*)(ws + WS_PROJ), NP, nullptr, 0, 0, 1.f};
        pg8::gemm_phase<pg8::EpiBf16<0>, pg8::StaticOrder, true, true>(lds, g, S, E);
    }
}
DI void kv_gemm(ldsp lds) {
    const int bid = blockIdx.x; if (bid >= 128) return;
    kargp P = kargs(); unsigned char* ws = P->ws; const int l2 = bid >> 6;
    pg8::Gemm g{(const bf16_t*)(ws + WS_MNB + l2 * MNB_BYTES), (const bf16_t*)(ws + WS_WKV + l2 * WKV_BYTES), NB * NMEM, 512, DM}; pg8::StaticOrder S; S.init(NB * NMEM, 512, 64, bid & 63);
    pg8::EpiBf16<0> E{(bf16_t*)(ws + WS_KVM + l2 * KVM_BYTES), 512, nullptr, 0, 0, 1.f};
    pg8::gemm_phase<pg8::EpiBf16<0>, pg8::StaticOrder, true, true>(lds, g, S, E);
}
DI void out_gemm(ldsp lds, int layer) {
    kargp P = kargs(); unsigned char* ws = P->ws;
    pg8::Gemm g{(const bf16_t*)(ws + WS_MIX), (const bf16_t*)(ws + WS_WOUT + layer * WOUT_BYTES), NTOK, DM, DMIX}; pg8::StaticOrder S; S.init(NTOK, DM, gridDim.x, blockIdx.x);
    if (EPI_NORM && layer == 0) { pg8::EpiResStats E{P->x, P->out, DM, (unsigned short*)(ws + WS_HB), (const float*)(ws + WS_GW), (float*)(ws + WS_SSP), (float*)(ws + WS_FFP)};
        pg8::gemm_phase<pg8::EpiResStats, pg8::StaticOrder, true, true>(lds, g, S, E); }
    else { pg8::EpiRes E{layer == 0 ? P->x : P->out, P->out, DM};
        pg8::gemm_phase<pg8::EpiRes, pg8::StaticOrder, true, true>(lds, g, S, E); }
    if (FUSE_NORM && layer + 1 < DEPTH) {
        const int tid = threadIdx.x, lane = tid & 63, wave = __builtin_amdgcn_readfirstlane(tid >> 6);
        __threadfence();
        __syncthreads();
        LAS int* todo = (LAS int*)(lds + 16384);
        if (tid == 0) { int cnt = 0; pg8::Unit u;
            for (int i = 0; S.next(i, u); ++i) { const unsigned old = atomicAdd((unsigned*)(kargs()->ws + WS_CTL) + 256 + u.pm, 1u); if (old == (unsigned)(DM / 256 - 1)) todo[1 + cnt++] = u.pm; }
            todo[0] = cnt; }
        __syncthreads();
        const int ncnt = __builtin_amdgcn_readfirstlane(todo[0]);
        int pms[4];
#pragma unroll
        for (int i = 0; i < 4; ++i) pms[i] = __builtin_amdgcn_readfirstlane(todo[1 + (i < ncnt ? i : 0)]);
        __threadfence();
        if (ncnt > 0) {
            kargp Q = kargs(); const int nl = layer + 1;
#pragma unroll 1
            for (int i = 0; i < ncnt; ++i) { const int pm = i == 0 ? pms[0] : i == 1 ? pms[1] : i == 2 ? pms[2] : pms[3];
                norm_phase(lds, Q->out, Q->norm_g + nl * DM, Q->w_in + (size_t)nl * DM * DIN, Q->fox_f_bias + nl * NH, (bf16_t*)(Q->ws + WS_HB), (float*)(Q->ws + WS_LF), pm * 256 + wave, 8, pm * 256 + 256, tid, lane); }
        }
    }
}
DI void do_norm(ldsp lds, int nl) {
    kargp P = kargs(); const int tid = threadIdx.x, lane = tid & 63, wave = __builtin_amdgcn_readfirstlane(tid >> 6);
    norm_phase(lds, nl ? P->out : P->x, P->norm_g + nl * DM, P->w_in + (size_t)nl * DM * DIN, P->fox_f_bias + nl * NH, (bf16_t*)(P->ws + WS_HB), (float*)(P->ws + WS_LF), blockIdx.x * 8 + wave, gridDim.x * 8, NTOK, tid, lane);
}
__global__ void __launch_bounds__(512, 2) hybrid_fwd(Params Parg) {
    extern __shared__ __attribute__((aligned(16))) unsigned char lds_raw[];
    ldsp lds = (ldsp)lds_raw;
    const int lo = kargs()->ph_lo, hi = kargs()->ph_hi;
    { volatile LAS unsigned* bst = (volatile LAS unsigned*)(lds + LDS_BYTES - 32);
      if (threadIdx.x < 2) bst[threadIdx.x] = 0u;
      __syncthreads();
      (void)xcd_barrier_post((unsigned*)(kargs()->ws + WS_CTL) + CW_XBAR, bst); }
#define IN(k) (lo <= (k) && (k) < hi)
#define SEAM(k) do { if (IN(k) && IN((k) + 1) && !(EPI_NORM && (k) == 4)) { if ((k) == 0) cg::this_grid().sync(); else seam_barrier(lds); } } while (0)
    if (IN(0)) {
        const int tid = threadIdx.x, lane = tid & 63, wave = __builtin_amdgcn_readfirstlane(tid >> 6);
        weights_phase(lds, blockIdx.x * 8 + wave, gridDim.x * 8, wave, lane);
        __syncthreads();
        memnorm_phase(blockIdx.x * 8 + wave, gridDim.x * 8, lane);
        do_norm(lds, 0);
    }
    SEAM(0);
    if (IN(1)) { in_gemm(lds, 0); kv_gemm(lds);
#if PROBE_PH & 2
        __syncthreads(); in_gemm(lds, 0);
#endif
    }
    SEAM(1);
    if (IN(2)) { mixer_phase(lds, 0, 0);
#if PROBE_PH & 4
        mixer_phase(lds, 0, 2);
#endif
    }
    SEAM(2);
    if (IN(3)) out_gemm(lds, 0);
    SEAM(3);
    if (IN(4) && !EPI_NORM) do_norm(lds, 1);
    SEAM(4);
    if (IN(5)) in_gemm(lds, 1);
    SEAM(5);
    if (IN(6)) mixer_phase(lds, 1, 1);
    SEAM(6);
    if (IN(7)) out_gemm(lds, 1);
#undef IN
#undef SEAM
}

extern "C" void kernel_launch(void* const* d_in, const int* in_sizes, int n_in, void* d_out, int out_size, void* d_ws, size_t ws_size, hipStream_t stream) {
    static int grid = 0;
    if (grid == 0) {
        if (n_in != 16 || in_sizes[0] != NTOK * DM || out_size != NTOK * DM || ws_size < WS_END) { fprintf(stderr, "kernel_launch: unexpected shapes (n_in %d, in0 %d, out %d, ws %zu)\n", n_in, n_in > 0 ? in_sizes[0] : -1, out_size, ws_size); grid = -1; return; }
        int dev = 0, cus = 0, per_cu = 0;
        (void)hipGetDevice(&dev); (void)hipDeviceGetAttribute(&cus, hipDeviceAttributeMultiprocessorCount, dev);
        if (hipFuncSetAttribute((const void*)hybrid_fwd, hipFuncAttributeMaxDynamicSharedMemorySize, LDS_BYTES) != hipSuccess) { fprintf(stderr, "kernel_launch: hipFuncSetAttribute failed\n"); grid = -1; return; }
        if (hipOccupancyMaxActiveBlocksPerMultiprocessor(&per_cu, (const void*)hybrid_fwd, 512, LDS_BYTES) != hipSuccess || per_cu < 1) { fprintf(stderr, "kernel_launch: occupancy query gave %d\n", per_cu); per_cu = 1; }
        (void)hipGetLastError();
        grid = cus * per_cu;
    }
    if (grid < 0) return;
    (void)hipMemsetAsync((char*)d_ws + WS_CTL, 0, CTL_ZERO_BYTES, stream);
    Params p{};
    p.x = (const float*)d_in[0]; p.mem = (const float*)d_in[1]; p.norm_g = (const float*)d_in[2]; p.w_in = (const float*)d_in[3]; p.fox_f_bias = (const float*)d_in[4];
    p.fox_q_norm = (const float*)d_in[5]; p.fox_k_norm = (const float*)d_in[6]; p.lb_logits = (const float*)d_in[7]; p.hgrn_out_norm = (const float*)d_in[8]; p.pool_w = (const float*)d_in[9];
    p.pool_scale = (const float*)d_in[10]; p.mem_norm_g = (const float*)d_in[11]; p.mem_w_kv = (const float*)d_in[12]; p.mem_q_norm = (const float*)d_in[13]; p.mem_k_norm = (const float*)d_in[14];
    p.w_out = (const float*)d_in[15]; p.out = (float*)d_out; p.ws = (unsigned char*)d_ws;
#if MK_SINGLE_LAUNCH
    p.ph_lo = 0; p.ph_hi = N_PHASES;
    void* args[] = {&p};
    const hipError_t e = hipLaunchCooperativeKernel((const void*)hybrid_fwd, dim3(grid), dim3(512), args, LDS_BYTES, stream);
    if (e != hipSuccess) fprintf(stderr, "kernel_launch: cooperative launch failed: %s (grid %d)\n", hipGetErrorString(e), grid);
#else
    for (int ph = 0; ph < N_PHASES; ++ph) { p.ph_lo = ph; p.ph_hi = ph + 1; hipLaunchKernelGGL(hybrid_fwd, dim3(grid), dim3(512), LDS_BYTES, stream, p); }
#endif
}
```

```cpp
#include <hip/hip_runtime.h>
#include <hip/hip_cooperative_groups.h>
#include <cstdio>
#include <cstdint>
namespace cg = cooperative_groups;
namespace pg8 {
#define PG8_LAS __attribute__((address_space(3)))
typedef unsigned short bf16_t;
typedef short bf16x8 __attribute__((ext_vector_type(8)));
typedef float f32x4 __attribute__((ext_vector_type(4)));
typedef unsigned u32x4 __attribute__((ext_vector_type(4)));
constexpr int BM = 256, BK = 64, HALF = 128, HTB = HALF * BK * 2  , STAGE_BYTES = 8 * HTB, NXCD = 8, WGM = 8;

__host__ __device__ __forceinline__ int lds_byte(int r, int c) { const int st = (r >> 4) * 2 + (c >> 5), rr = r & 15, cc = c & 31, ob = rr * 64 + cc * 2; return st * 1024 + (ob ^ (((ob >> 9) & 1) << 5)); }
__host__ __device__ __forceinline__ void stage_rc(int b, int& R, int& C) { const int st = b / 1024, sb = b % 1024, swz = sb ^ (((sb >> 9) & 1) << 5); R = (st >> 1) * 16 + swz / 64; C = (st & 1) * 32 + (swz % 64) / 2; }
__host__ __device__ __forceinline__ int perm32(int rho) { const int n = rho >> 4, i = rho & 15; return 8 * (i >> 2) + 4 * n + (i & 3); }

struct Unit { int pm, pn; };
struct Gemm { const bf16_t* A; const bf16_t* Bt; int M, N, K; };

struct StaticOrder {
    int nM, nN, nwg, G, c;
    __host__ __device__ void init(int M, int N, int G_, int c_) { nM = M / BM; nN = N / BM; nwg = nM * nN; G = G_; c = c_; }
    __host__ __device__ bool next(int i, Unit& u) const {
        const long L = (long)i * G + c; if (L >= nwg) return false;
        int wgid = (int)L; { const int q = nwg / NXCD, r = nwg % NXCD, xcd = wgid % NXCD, off = wgid / NXCD; wgid = (xcd < r ? xcd * (q + 1) : r * (q + 1) + (xcd - r) * q) + off; }
        const int nig = WGM * nN, gid = wgid / nig, fm = gid * WGM, gsz = (nM - fm) < WGM ? (nM - fm) : WGM;
        u.pm = fm + ((wgid % nig) % gsz); u.pn = (wgid % nig) / gsz; return true;
    }
    __device__ __forceinline__ void a_ready(const Unit&) const {}
    __device__ __forceinline__ void done(const Unit&) const {}
};

__device__ __forceinline__ unsigned cvt_pk_bf16(float lo, float hi) { unsigned r; asm volatile("v_cvt_pk_bf16_f32 %0, %1, %2" : "=v"(r) : "v"(lo), "v"(hi)); return r; }
typedef float f32x2 __attribute__((ext_vector_type(2)));
__device__ __forceinline__ f32x2 gelu_pk(f32x2 v) {
    const f32x2 av = __builtin_elementwise_abs(v), d = av * 0.2316418882f + 1.0f;
    f32x2 t; t.x = __builtin_amdgcn_rcpf(d.x); t.y = __builtin_amdgcn_rcpf(d.y);
    f32x2 q = t * 0.5307027145f + (-0.7265760135f); q = q * t + 0.7107068705f; q = q * t + (-0.142248368f); q = q * t + 0.127414796f; q = q * t;
    const f32x2 s = (v * v) * (-0.72134752044f);
    f32x2 e; e.x = __builtin_amdgcn_exp2f(s.x); e.y = __builtin_amdgcn_exp2f(s.y);
    const f32x2 m = v * (q * e), r = v - m;
    f32x2 o; o.x = v.x < 0.f ? m.x : r.x; o.y = v.y < 0.f ? m.y : r.y; return o;
}

template <int ACT  > struct EpiBf16 {
    static constexpr bool PERM = true, AFTER_DRAIN = false; static_assert(ACT == 0 || ACT == 1, "EpiBf16: ACT is 0 (none) or 1 (gelu_pk)");
    bf16_t* O; int ldc; const float* bias; int split_cols; size_t split_stride; float scale0;
    __device__ __forceinline__ void operator()(const f32x4 (&acc)[2][2][4][2], const Unit& u, int wr, int wc, int fr, int fq) const {
        const int row0 = u.pm * BM + wr * 64 + fr; int colt = u.pn * BM; bf16_t* base = O;
        float sc = 1.f; if (split_cols) { const int t = colt / split_cols; base += (size_t)t * split_stride; colt -= t * split_cols; if (t == 0) sc = scale0; }
        const int col0 = colt + wc * 32 + 8 * fq, bcol0 = u.pn * BM + wc * 32 + 8 * fq;
        f32x4 bv[2][2];
#pragma unroll
        for (int bj = 0; bj < 2; ++bj)
#pragma unroll
            for (int n = 0; n < 2; ++n) bv[bj][n] = bias ? *(const f32x4*)(bias + bcol0 + bj * HALF + 4 * n) : (f32x4){0.f, 0.f, 0.f, 0.f};
#pragma unroll
        for (int ai = 0; ai < 2; ++ai)
#pragma unroll
            for (int m = 0; m < 4; ++m) { bf16_t* rowp = base + (size_t)(row0 + ai * HALF + m * 16) * ldc + col0;
#pragma unroll
                for (int bj = 0; bj < 2; ++bj) { f32x4 v0 = acc[ai][bj][m][0] + bv[bj][0], v1 = acc[ai][bj][m][1] + bv[bj][1];
                    if (ACT == 1) { f32x2 a = gelu_pk((f32x2){v0[0], v0[1]}), b = gelu_pk((f32x2){v0[2], v0[3]}), c = gelu_pk((f32x2){v1[0], v1[1]}), d = gelu_pk((f32x2){v1[2], v1[3]});
                        v0 = (f32x4){a.x, a.y, b.x, b.y}; v1 = (f32x4){c.x, c.y, d.x, d.y}; }
                    v0 = v0 * sc; v1 = v1 * sc; u32x4 w; w.x = cvt_pk_bf16(v0[0], v0[1]); w.y = cvt_pk_bf16(v0[2], v0[3]); w.z = cvt_pk_bf16(v1[0], v1[1]); w.w = cvt_pk_bf16(v1[2], v1[3]);
                    *(u32x4*)(rowp + bj * HALF) = w; } }
    }
};

struct EpiRes {
    static constexpr bool PERM = false, AFTER_DRAIN = false;
    const float* base; float* out; int ldc;
    __device__ __forceinline__ void operator()(const f32x4 (&acc)[2][2][4][2], const Unit& u, int wr, int wc, int fr, int fq) const {
        const int col0 = u.pn * BM + wc * 32 + 4 * fq;
#pragma unroll
        for (int ai = 0; ai < 2; ++ai)
#pragma unroll
            for (int m = 0; m < 4; ++m) { const size_t off = (size_t)(u.pm * BM + ai * HALF + wr * 64 + m * 16 + fr) * ldc + col0;
#pragma unroll
                for (int bj = 0; bj < 2; ++bj)
#pragma unroll
                    for (int n = 0; n < 2; ++n) { const f32x4 bs = *(const f32x4*)(base + off + bj * HALF + n * 16); *(f32x4*)(out + off + bj * HALF + n * 16) = bs + acc[ai][bj][m][n]; } }
    }
};

struct EpiResStats {
    static constexpr bool PERM = false, AFTER_DRAIN = false;
    const float* base; float* out; int ldc; unsigned short* xb; const float* gw  ; float* ssp  ; float* ffp  ;
    __device__ __forceinline__ void operator()(const f32x4 (&acc)[2][2][4][2], const Unit& u, int wr, int wc, int fr, int fq) const {
        const int col0 = u.pn * BM + wc * 32 + 4 * fq;
#pragma unroll
        for (int ai = 0; ai < 2; ++ai)
#pragma unroll
            for (int m = 0; m < 4; ++m) {
                float ss = 0.f; f32x4 ff = {0.f, 0.f, 0.f, 0.f};
                const size_t rbase = (size_t)(u.pm * BM + ai * HALF + wr * 64 + m * 16 + fr);
#pragma unroll
                for (int bj = 0; bj < 2; ++bj)
#pragma unroll
                    for (int n = 0; n < 2; ++n) {
                        const int c = col0 + bj * HALF + n * 16; const size_t off = rbase * ldc + c;
                        const f32x4 o = *(const f32x4*)(base + off) + acc[ai][bj][m][n];
                        *(f32x4*)(out + off) = o;
                        typedef unsigned u32x2_ __attribute__((ext_vector_type(2)));
                        *(u32x2_*)(xb + off) = (u32x2_){cvt_pk_bf16(o[0], o[1]), cvt_pk_bf16(o[2], o[3])};
                        ss += (o[0] * o[0] + o[1] * o[1]) + (o[2] * o[2] + o[3] * o[3]);
                        ff += *(const f32x4*)(gw + 4 * (size_t)c) * o[0] + *(const f32x4*)(gw + 4 * (size_t)c + 4) * o[1] + *(const f32x4*)(gw + 4 * (size_t)c + 8) * o[2] + *(const f32x4*)(gw + 4 * (size_t)c + 12) * o[3]; }
                float v5[5] = {ss, ff[0], ff[1], ff[2], ff[3]};
#pragma unroll
                for (int q = 0; q < 5; ++q) { auto a_ = __builtin_amdgcn_permlane16_swap(__float_as_uint(v5[q]), __float_as_uint(v5[q]), false, false); const float s_ = __uint_as_float(a_[0]) + __uint_as_float(a_[1]);
                    auto b_ = __builtin_amdgcn_permlane32_swap(__float_as_uint(s_), __float_as_uint(s_), false, false); v5[q] = __uint_as_float(b_[0]) + __uint_as_float(b_[1]); }
                if (fq == 0) { const int slot = u.pn * 4 + wc; ssp[rbase * 16 + slot] = v5[0]; *(f32x4*)(ffp + (rbase * 16 + slot) * 4) = (f32x4){v5[1], v5[2], v5[3], v5[4]}; }
                asm volatile("" ::: "memory");
            }
    }
};
struct EpiBf16RowScale {
    static constexpr bool PERM = true, AFTER_DRAIN = false;
    bf16_t* O; int ldc; const float* ssp; float inv_k, eps;
    __device__ __forceinline__ void operator()(const f32x4 (&acc)[2][2][4][2], const Unit& u, int wr, int wc, int fr, int fq) const {
        const int row0 = u.pm * BM + wr * 64 + fr; const int col0 = u.pn * BM + wc * 32 + 8 * fq;
#pragma unroll
        for (int ai = 0; ai < 2; ++ai)
#pragma unroll
            for (int m = 0; m < 4; ++m) { const size_t row = (size_t)(row0 + ai * HALF + m * 16);
                const f32x4 a = *(const f32x4*)(ssp + row * 16), b = *(const f32x4*)(ssp + row * 16 + 4), c = *(const f32x4*)(ssp + row * 16 + 8), d = *(const f32x4*)(ssp + row * 16 + 12);
                const float tot = ((a[0] + a[1]) + (a[2] + a[3])) + ((b[0] + b[1]) + (b[2] + b[3])) + ((c[0] + c[1]) + (c[2] + c[3])) + ((d[0] + d[1]) + (d[2] + d[3]));
                const float sc = 1.0f / sqrtf(tot * inv_k + eps);
                bf16_t* rowp = O + row * ldc + col0;
#pragma unroll
                for (int bj = 0; bj < 2; ++bj) { const f32x4 v0 = acc[ai][bj][m][0] * sc, v1 = acc[ai][bj][m][1] * sc;
                    u32x4 w; w.x = cvt_pk_bf16(v0[0], v0[1]); w.y = cvt_pk_bf16(v0[2], v0[3]); w.z = cvt_pk_bf16(v1[0], v1[1]); w.w = cvt_pk_bf16(v1[2], v1[3]);
                    *(u32x4*)(rowp + bj * HALF) = w; } }
    }
};
template <class Epi, class Sched, bool ALIGN_EPI = false, bool SP2 = false>
__device__ __forceinline__ void gemm_phase(PG8_LAS unsigned char* lds, const Gemm g, const Sched& S, const Epi& E) {
    const int tid = threadIdx.x, wid = __builtin_amdgcn_readfirstlane(tid >> 6), lane = tid & 63, wr = wid >> 2, wc = wid & 3, fr = lane & 15, fq = lane >> 4;
    const int K = g.K, nt = K / BK;
    unsigned voffA[2], voffB[2];
#pragma unroll
    for (int i = 0; i < 2; ++i) { int R, C; stage_rc(tid * 16 + i * 8192, R, C); const int Rb = Epi::PERM ? ((R & ~31) + perm32(R & 31)) : R;
        voffA[i] = (unsigned)(R * K + C) * 2u; voffB[i] = (unsigned)(Rb * K + C) * 2u; }
    const size_t kstep = (size_t)(BK * 2);
    const size_t hstep = (size_t)HALF * K * 2;
    const size_t tstep = 2 * hstep;
    const unsigned ldsw = (unsigned)wid * 1024u;
    const int aoff = lds_byte(wr * 64 + fr, fq * 8), boff = lds_byte(wc * 32 + fr, fq * 8);
#define PG8_SA(b, h) (((b) * 2 + (h)) * HTB)
#define PG8_SB(b, h) ((4 + (b) * 2 + (h)) * HTB)
#define PG8_STAGE(bufoff, gbase, voff) do { _Pragma("unroll") for (int _i = 0; _i < 2; ++_i) \
        __builtin_amdgcn_global_load_lds((const unsigned*)((const char*)(gbase) + (voff)[_i]), (PG8_LAS unsigned*)(lds + (bufoff) + ldsw + _i * 8192), 16, 0, 0); } while (0)
#define PG8_LDA(dst, b, h) do { _Pragma("unroll") for (int m = 0; m < 4; ++m) _Pragma("unroll") for (int k = 0; k < 2; ++k) dst[m][k] = *(const PG8_LAS bf16x8*)(lds + PG8_SA(b, h) + aoff + m * 2048 + k * 1024); } while (0)
#define PG8_LDB(dst, b, h) do { _Pragma("unroll") for (int n = 0; n < 2; ++n) _Pragma("unroll") for (int k = 0; k < 2; ++k) dst[n][k] = *(const PG8_LAS bf16x8*)(lds + PG8_SB(b, h) + boff + n * 2048 + k * 1024); } while (0)
#define PG8_MMA(ai, bj, At, Bt) do { __builtin_amdgcn_s_setprio(1); _Pragma("unroll") for (int m = 0; m < 4; ++m) _Pragma("unroll") for (int n = 0; n < 2; ++n) _Pragma("unroll") for (int k = 0; k < 2; ++k) \
        acc[ai][bj][m][n] = __builtin_amdgcn_mfma_f32_16x16x32_bf16(Bt[n][k], At[m][k], acc[ai][bj][m][n], 0, 0, 0); __builtin_amdgcn_s_setprio(0); } while (0)
#define PG8_WAIT_V(n) asm volatile("s_waitcnt vmcnt(" #n ")" ::: "memory")
#define PG8_WAIT_L(n) asm volatile("s_waitcnt lgkmcnt(" #n ")" ::: "memory")
#define PG8_BAR __builtin_amdgcn_s_barrier()
#define PG8_SCHED __builtin_amdgcn_sched_barrier(0)
    Unit cur, nxt; int ui = 0;
    if (!S.next(0, cur)) return;
    f32x4 acc[2][2][4][2];
#pragma unroll
    for (int a = 0; a < 2; ++a)
#pragma unroll
        for (int b = 0; b < 2; ++b)
#pragma unroll
            for (int m = 0; m < 4; ++m)
#pragma unroll
                for (int n = 0; n < 2; ++n) acc[a][b][m][n] = (f32x4){0.f, 0.f, 0.f, 0.f};
    bf16x8 At[4][2], B0[2][2], B1[2][2];
    const char* cA = (const char*)g.A + (size_t)cur.pm * tstep; const char* cB = (const char*)g.Bt + (size_t)cur.pn * tstep;
    S.a_ready(cur);
    if constexpr (SP2) {
        PG8_STAGE(PG8_SB(0, 0), cB, voffB); PG8_STAGE(PG8_SB(0, 1), cB + hstep, voffB); PG8_STAGE(PG8_SA(0, 0), cA, voffA); PG8_STAGE(PG8_SA(0, 1), cA + hstep, voffA);
        if (wr == 1) PG8_BAR;
        PG8_WAIT_V(2); PG8_BAR;
        PG8_STAGE(PG8_SB(1, 0), cB + kstep, voffB); PG8_STAGE(PG8_SA(1, 0), cA + kstep, voffA); PG8_STAGE(PG8_SB(1, 1), cB + hstep + kstep, voffB);
        PG8_WAIT_V(6); PG8_BAR;
    } else {
        PG8_STAGE(PG8_SB(0, 0), cB, voffB); PG8_STAGE(PG8_SA(0, 0), cA, voffA); PG8_STAGE(PG8_SB(0, 1), cB + hstep, voffB); PG8_STAGE(PG8_SA(0, 1), cA + hstep, voffA);
        if (wr == 1) PG8_BAR;
        PG8_WAIT_V(4); PG8_BAR;
        PG8_STAGE(PG8_SB(1, 0), cB + kstep, voffB); PG8_STAGE(PG8_SA(1, 0), cA + kstep, voffA); PG8_STAGE(PG8_SB(1, 1), cB + hstep + kstep, voffB);
        PG8_WAIT_V(6); PG8_BAR;
    }
    for (;;) {
        const bool has_next = S.next(ui + 1, nxt);
        const char* nA = has_next ? (const char*)g.A + (size_t)nxt.pm * tstep : cA; const char* nB = has_next ? (const char*)g.Bt + (size_t)nxt.pn * tstep : cB;
        for (int t = 0; t < nt; t += 2) {
            const bool last = (t == nt - 2);
            const char* a1 = cA + (size_t)(t + 1) * kstep;
            const char* a2 = last ? nA : cA + (size_t)(t + 2) * kstep; const char* b2 = last ? nB : cB + (size_t)(t + 2) * kstep;
            const char* a3 = a2 + kstep; const char* b3 = b2 + kstep;
            if (last && has_next) S.a_ready(nxt);
            if constexpr (SP2) {
            PG8_LDB(B0, 0, 0); PG8_LDB(B1, 0, 1); PG8_SCHED; PG8_LDA(At, 0, 0); PG8_STAGE(PG8_SA(1, 1), a1 + hstep, voffA);
            PG8_WAIT_V(8); PG8_WAIT_L(0); PG8_BAR; PG8_MMA(0, 0, At, B0); PG8_MMA(0, 1, At, B1); PG8_BAR; PG8_SCHED;
            PG8_LDA(At, 0, 1); PG8_STAGE(PG8_SB(0, 0), b2, voffB); PG8_STAGE(PG8_SB(0, 1), b2 + hstep, voffB); PG8_STAGE(PG8_SA(0, 0), a2, voffA);
            PG8_WAIT_V(8); PG8_WAIT_L(0); PG8_BAR; PG8_MMA(1, 0, At, B0); PG8_MMA(1, 1, At, B1); PG8_BAR; PG8_SCHED;
            PG8_LDB(B0, 1, 0); PG8_LDB(B1, 1, 1); PG8_SCHED; PG8_LDA(At, 1, 0); PG8_STAGE(PG8_SA(0, 1), a2 + hstep, voffA);
            PG8_WAIT_V(8); PG8_WAIT_L(0); PG8_BAR; PG8_MMA(0, 0, At, B0); PG8_MMA(0, 1, At, B1); PG8_BAR; PG8_SCHED;
            PG8_LDA(At, 1, 1); PG8_STAGE(PG8_SB(1, 0), b3, voffB); PG8_STAGE(PG8_SB(1, 1), b3 + hstep, voffB); PG8_STAGE(PG8_SA(1, 0), a3, voffA);
            PG8_WAIT_V(8); PG8_WAIT_L(0); PG8_BAR; PG8_MMA(1, 0, At, B0); PG8_MMA(1, 1, At, B1); PG8_BAR; PG8_SCHED;
            } else {
            PG8_LDB(B0, 0, 0); PG8_SCHED; PG8_LDA(At, 0, 0); PG8_STAGE(PG8_SA(1, 1), a1 + hstep, voffA);
            PG8_WAIT_L(8); PG8_BAR; PG8_WAIT_L(0); PG8_MMA(0, 0, At, B0); PG8_BAR; PG8_SCHED;
            PG8_LDB(B1, 0, 1); PG8_STAGE(PG8_SB(0, 0), b2, voffB);
            PG8_BAR; PG8_WAIT_L(0); PG8_MMA(0, 1, At, B1); PG8_BAR;
            PG8_LDA(At, 0, 1); PG8_STAGE(PG8_SA(0, 0), a2, voffA);
            PG8_BAR; PG8_WAIT_L(0); PG8_MMA(1, 0, At, B0); PG8_BAR; PG8_SCHED;
            PG8_STAGE(PG8_SB(0, 1), b2 + hstep, voffB);
            PG8_WAIT_V(6); PG8_BAR; PG8_MMA(1, 1, At, B1); PG8_BAR;
            PG8_LDB(B0, 1, 0); PG8_SCHED; PG8_LDA(At, 1, 0); PG8_STAGE(PG8_SA(0, 1), a2 + hstep, voffA);
            PG8_WAIT_L(8); PG8_BAR; PG8_WAIT_L(0); PG8_MMA(0, 0, At, B0); PG8_BAR; PG8_SCHED;
            PG8_LDB(B1, 1, 1); PG8_STAGE(PG8_SB(1, 0), b3, voffB);
            PG8_BAR; PG8_WAIT_L(0); PG8_MMA(0, 1, At, B1); PG8_BAR;
            PG8_LDA(At, 1, 1); PG8_STAGE(PG8_SA(1, 0), a3, voffA);
            PG8_BAR; PG8_WAIT_L(0); PG8_MMA(1, 0, At, B0); PG8_BAR; PG8_SCHED;
            PG8_STAGE(PG8_SB(1, 1), b3 + hstep, voffB);
            PG8_WAIT_V(6); PG8_BAR; PG8_MMA(1, 1, At, B1); PG8_BAR;
            }
        }
        if constexpr (ALIGN_EPI) { if (wr == 0) PG8_BAR; }
        if constexpr (!Epi::AFTER_DRAIN) { E(acc, cur, wr, wc, fr, fq); S.done(cur); }
        if (!has_next) break;
#pragma unroll
        for (int a = 0; a < 2; ++a)
#pragma unroll
            for (int b = 0; b < 2; ++b)
#pragma unroll
                for (int m = 0; m < 4; ++m)
#pragma unroll
                    for (int n = 0; n < 2; ++n) acc[a][b][m][n] = (f32x4){0.f, 0.f, 0.f, 0.f};
        cur = nxt; cA = nA; cB = nB; ++ui;
        if constexpr (ALIGN_EPI) { if (wr == 1) PG8_BAR; }
    }
    PG8_WAIT_V(0);
    if constexpr (!ALIGN_EPI) { if (wr == 0) PG8_BAR; }
    PG8_BAR;
    if constexpr (Epi::AFTER_DRAIN) { E.fused(acc, cur, wr, wc, fr, fq, lds, wid, lane); S.done(cur); }
#undef PG8_SA
#undef PG8_SB
#undef PG8_STAGE
#undef PG8_LDA
#undef PG8_LDB
#undef PG8_MMA
#undef PG8_WAIT_V
#undef PG8_WAIT_L
#undef PG8_BAR
#undef PG8_SCHED
}
}
#ifndef EPI_NORM
#define EPI_NORM 0
#endif

#ifndef PROBE_PH
#define PROBE_PH 0
#endif
#ifndef PROBE_UNIT
#define PROBE_UNIT 0
#endif
#ifndef PROBE_SUB
#define PROBE_SUB 0
#endif
#ifndef MK_SINGLE_LAUNCH
#define MK_SINGLE_LAUNCH 1
#endif

constexpr int DM = 1024, NB = 32, SEQ = 2048, NTOK = NB * SEQ, NMEM = 256, DIN = 4100, NP = 4096, DMIX = 1280, NH = 4, HD = 64, DEPTH = 2;
constexpr float EPS = 1e-6f, LOG2E = 1.4426950408889634f;
constexpr int C_FQ = 0, C_FK = 256, C_FV = 512, C_FG = 768, C_SQ = 1024, C_SK = 1280, C_SV = 1536, C_SG = 1792, C_HQ = 2048, C_HF = 2304, C_HI = 2560, C_HG = 2816, C_PV = 3072, C_PG = 3328, C_MQ = 3584, C_MG = 3840;
constexpr int O_FOX = 0, O_SB = 256, O_HG = 512, O_POOL = 768, O_MEM = 1024;

constexpr size_t MiB = 1u << 20;
constexpr size_t WS_CTL = 0, CTL_ZERO_BYTES = 32768;
constexpr size_t WS_WIN = 2 * MiB, WIN_BYTES = (size_t)NP * DM * 2;
constexpr size_t WS_WOUT = 18 * MiB, WOUT_BYTES = (size_t)DM * DMIX * 2;
constexpr size_t WS_WKV = 24 * MiB, WKV_BYTES = (size_t)512 * DM * 2;
constexpr size_t WS_WPOOL = 27 * MiB, WPOOL_BYTES = 4 * 64 * 64 * 2;
constexpr size_t WS_LF = 26 * MiB;
constexpr size_t WS_MNB = 28 * MiB, MNB_BYTES = (size_t)NB * NMEM * DM * 2;
constexpr size_t WS_KVM = 60 * MiB, KVM_BYTES = (size_t)NB * NMEM * 512 * 2;
constexpr size_t WS_HB = 76 * MiB;
constexpr size_t WS_MIX = 204 * MiB;
constexpr size_t WS_PROJ = 364 * MiB;
constexpr size_t WS_C2 = 876 * MiB;
constexpr size_t WS_SSP = 877 * MiB;
constexpr size_t WS_FFP = 881 * MiB;
constexpr size_t WS_GW = 897 * MiB;
constexpr size_t WS_END = 898 * MiB;

constexpr int LDS_BYTES = 147456;
constexpr int LDS_SLOT = LDS_BYTES - 64;

#define LAS __attribute__((address_space(3)))
typedef LAS unsigned char* ldsp;
typedef unsigned short bf16_t;
typedef short bf16x8 __attribute__((ext_vector_type(8)));
typedef short s16x4 __attribute__((ext_vector_type(4)));
typedef float f32x16 __attribute__((ext_vector_type(16)));
typedef float f32x4 __attribute__((ext_vector_type(4)));
typedef float f32x2 __attribute__((ext_vector_type(2)));
typedef unsigned u32x4 __attribute__((ext_vector_type(4)));
typedef unsigned u32x2 __attribute__((ext_vector_type(2)));
typedef __bf16 bf16x2_t __attribute__((ext_vector_type(2)));

#define DI __device__ __forceinline__
DI float bf_lo(unsigned u) { return __uint_as_float(u << 16); }
DI float bf_hi(unsigned u) { return __uint_as_float(u & 0xffff0000u); }
DI unsigned pk2(float lo, float hi) { f32x2 v = {lo, hi}; bf16x2_t b = __builtin_convertvector(v, bf16x2_t); return __builtin_bit_cast(unsigned, b); }
DI float ex2(float x) { return __builtin_amdgcn_exp2f(x); }
DI float rcpf_(float x) { return __builtin_amdgcn_rcpf(x); }
DI float silu_f(float x) { return x * rcpf_(1.f + ex2(-x * LOG2E)); }
template <int CTRL> DI float dppf(float v) { return __uint_as_float((unsigned)__builtin_amdgcn_update_dpp(0, (int)__float_as_uint(v), CTRL, 0xF, 0xF, true)); }
DI float sum8(float v) { v += dppf<0xB1>(v); v += dppf<0x4E>(v); v += dppf<0x141>(v); return v; }
DI float sum16(float v) { v = sum8(v); v += dppf<0x140>(v); return v; }
DI float wave_sum(float v) { v = sum16(v);
    return (__int_as_float(__builtin_amdgcn_readlane(__float_as_int(v), 0)) + __int_as_float(__builtin_amdgcn_readlane(__float_as_int(v), 16))) +
           (__int_as_float(__builtin_amdgcn_readlane(__float_as_int(v), 32)) + __int_as_float(__builtin_amdgcn_readlane(__float_as_int(v), 48))); }
DI void halves(float x, float& lo, float& hi) { auto rr = __builtin_amdgcn_permlane32_swap(__float_as_uint(x), __float_as_uint(x), false, false); lo = __uint_as_float(rr[0]); hi = __uint_as_float(rr[1]); }
template <class T> DI T* launder(T* p) { asm volatile("" : "+s"(p)); return p; }
#define MFMA32(a, b, c) __builtin_amdgcn_mfma_f32_32x32x16_bf16((a), (b), (c), 0, 0, 0)

struct Params {
    const float *x, *mem, *norm_g, *w_in, *fox_f_bias, *fox_q_norm, *fox_k_norm, *lb_logits, *hgrn_out_norm, *pool_w, *pool_scale, *mem_norm_g, *mem_w_kv, *mem_q_norm, *mem_k_norm, *w_out;
    float* out; unsigned char* ws; int ph_lo, ph_hi;
};
typedef const __attribute__((address_space(4))) Params* kargp;
DI kargp kargs() { kargp p = (kargp)__builtin_amdgcn_kernarg_segment_ptr(); asm volatile("" : "+s"(p)); return p; }

DI void transpose_item(const float* W, int K, int ldw, bf16_t* WT, int k0, int src_n0, int dst_n0, LAS float* scr, int lane, const float* kscale = nullptr) {
#pragma unroll 8
    for (int i = 0; i < 32; ++i) { const int kk = 2 * i + (lane >> 5); scr[kk * 33 + (lane & 31)] = W[(size_t)(k0 + kk) * ldw + src_n0 + (lane & 31)] * (kscale ? kscale[k0 + kk] : 1.f); }
    asm volatile("s_waitcnt lgkmcnt(0)" ::: "memory");
    const int c = lane & 7;
#pragma unroll
    for (int j = 0; j < 4; ++j) { const int n = (lane >> 3) + 8 * j; const LAS float* s = scr + (8 * c) * 33 + n;
        u32x4 o; o.x = pk2(s[0 * 33], s[1 * 33]); o.y = pk2(s[2 * 33], s[3 * 33]); o.z = pk2(s[4 * 33], s[5 * 33]); o.w = pk2(s[6 * 33], s[7 * 33]);
        *(u32x4*)(WT + (size_t)(dst_n0 + n) * K + k0 + 8 * c) = o; }
    asm volatile("s_waitcnt lgkmcnt(0)" ::: "memory");
}

DI void weights_phase(ldsp lds, int gw, int NGW, int wave, int lane) {
    if (EPI_NORM) { kargp P = kargs(); float* gwt = (float*)(P->ws + WS_GW);
      for (int i = gw * 64 + lane; i < DM * 4; i += NGW * 64) { const int c = i >> 2, j = i & 3; gwt[i] = P->norm_g[DM + c] * P->w_in[(size_t)DM * DIN + (size_t)c * DIN + 1024 + j]; } }
    { kargp P = kargs(); const float* pw = P->pool_w; bf16_t* wt = (bf16_t*)(P->ws + WS_WPOOL);
      for (int i = gw * 64 + lane; i < DEPTH * 4 * 64 * 64; i += NGW * 64) { const int lg = i >> 12, c = (i >> 6) & 63, d = i & 63; wt[(lg * 64 + d) * 64 + c] = (bf16_t)(pk2(pw[i], 0.f) & 0xffffu); } }
    LAS float* scr = (LAS float*)(lds + wave * 16384);
    constexpr int I_IN = (DM / 64) * (NP / 32), I_OUT = (DMIX / 64) * (DM / 32), I_KV = (DM / 64) * (512 / 32), I_L = I_IN + I_OUT + I_KV;
    for (int it = gw; it < DEPTH * I_L; it += NGW) {
        const int l = it / I_L; int r = it % I_L; kargp P = kargs();
        if (r < I_IN) { const int nblk = NP / 32, kb = r / nblk, nb = r % nblk, n0 = 32 * nb;
            transpose_item(P->w_in + (size_t)l * DM * DIN, DM, DIN, (bf16_t*)(P->ws + WS_WIN + l * WIN_BYTES), 64 * kb, n0 + (n0 >= 1024 ? 4 : 0), n0, scr, lane, (EPI_NORM && l == 1) ? P->norm_g + DM : nullptr); continue; }
        r -= I_IN;
        if (r < I_OUT) { const int nblk = DM / 32, kb = r / nblk, nb = r % nblk;
            transpose_item(P->w_out + (size_t)l * DMIX * DM, DMIX, DM, (bf16_t*)(P->ws + WS_WOUT + l * WOUT_BYTES), 64 * kb, 32 * nb, 32 * nb, scr, lane); continue; }
        r -= I_OUT;
        { const int nblk = 512 / 32, kb = r / nblk, nb = r % nblk;
            transpose_item(P->mem_w_kv + (size_t)l * DM * 512, DM, 512, (bf16_t*)(P->ws + WS_WKV + l * WKV_BYTES), 64 * kb, 32 * nb, 32 * nb, scr, lane); }
    }
}

DI void memnorm_phase(int gw, int NGW, int lane) {
    kargp P = kargs(); const float* mng = P->mem_norm_g; const float* memp = P->mem; unsigned char* ws = P->ws;
    f32x4 g0[4], g1[4];
#pragma unroll
    for (int j = 0; j < 4; ++j) { g0[j] = ((const f32x4*)mng)[64 * j + lane]; g1[j] = ((const f32x4*)(mng + DM))[64 * j + lane]; }
    for (int m = gw; m < NB * NMEM; m += NGW) {
        const f32x4* xr = (const f32x4*)(memp + (size_t)m * DM) + lane;
        f32x4 v[4]; float s = 0.f;
#pragma unroll
        for (int j = 0; j < 4; ++j) { v[j] = xr[64 * j]; s += (v[j].x * v[j].x + v[j].y * v[j].y) + (v[j].z * v[j].z + v[j].w * v[j].w); }
        const float rstd = __builtin_amdgcn_rsqf(wave_sum(s) * (1.f / DM) + EPS);
        u32x2* o0 = (u32x2*)(ws + WS_MNB + (size_t)m * DM * 2) + lane; u32x2* o1 = (u32x2*)(ws + WS_MNB + MNB_BYTES + (size_t)m * DM * 2) + lane;
#pragma unroll
        for (int j = 0; j < 4; ++j) { const f32x4 y = v[j] * rstd; const f32x4 a = y * g0[j], b = y * g1[j];
            o0[64 * j] = (u32x2){pk2(a.x, a.y), pk2(a.z, a.w)}; o1[64 * j] = (u32x2){pk2(b.x, b.y), pk2(b.z, b.w)}; }
    }
}

DI void norm_phase(ldsp lds, const float* x, const float* g, const float* w_in_l, const float* fbias, bf16_t* hb, float* lf, int gw, int NGW, int mend, int tid, int lane) {
    for (int k = tid; k < DM; k += 512) { const int j = k >> 8, ln = (k & 255) >> 2, i = k & 3;
        *(LAS f32x4*)(lds + 16 * ((j * 4 + i) * 64 + ln)) = *(const f32x4*)(w_in_l + (size_t)k * DIN + 1024); }
    __syncthreads();
    f32x4 gv[4];
#pragma unroll
    for (int j = 0; j < 4; ++j) gv[j] = ((const f32x4*)g)[64 * j + lane];
    const float mybias = fbias[lane & 3];
    f32x4 nv[4], nv2[4];
    if (gw < mend) { const f32x4* xr = (const f32x4*)(x + (size_t)gw * DM) + lane;
#pragma unroll
        for (int j = 0; j < 4; ++j) nv[j] = __builtin_nontemporal_load(xr + 64 * j); }
    if (gw + NGW < mend) { const f32x4* xr = (const f32x4*)(x + (size_t)(gw + NGW) * DM) + lane;
#pragma unroll
        for (int j = 0; j < 4; ++j) nv2[j] = __builtin_nontemporal_load(xr + 64 * j); }
    for (int m = gw; m < mend; m += NGW) {
        f32x4 v[4]; float s = 0.f;
#pragma unroll
        for (int j = 0; j < 4; ++j) { v[j] = nv[j]; nv[j] = nv2[j]; }
        if (m + 2 * NGW < mend) { const f32x4* xn = (const f32x4*)(x + (size_t)(m + 2 * NGW) * DM) + lane;
#pragma unroll
            for (int j = 0; j < 4; ++j) nv2[j] = __builtin_nontemporal_load(xn + 64 * j); }
#pragma unroll
        for (int j = 0; j < 4; ++j) s += (v[j].x * v[j].x + v[j].y * v[j].y) + (v[j].z * v[j].z + v[j].w * v[j].w);
        const float rstd = __builtin_amdgcn_rsqf(wave_sum(s) * (1.f / DM) + EPS);
        u32x2* o8 = (u32x2*)(hb + (size_t)m * DM) + lane;
        f32x4 ff = {0.f, 0.f, 0.f, 0.f};
#pragma unroll
        for (int j = 0; j < 4; ++j) { const f32x4 y = (v[j] * rstd) * gv[j];
            o8[64 * j] = (u32x2){pk2(y.x, y.y), pk2(y.z, y.w)};
#pragma unroll
            for (int i = 0; i < 4; ++i) { const f32x4 w = *(LAS f32x4*)(lds + 16 * ((j * 4 + i) * 64 + lane)); ff += w * y[i]; } }
        ff.x = wave_sum(ff.x); ff.y = wave_sum(ff.y); ff.z = wave_sum(ff.z); ff.w = wave_sum(ff.w);
        if (lane < 4) { const float z = (lane == 0 ? ff.x : lane == 1 ? ff.y : lane == 2 ? ff.z : ff.w) + mybias;
            lf[(size_t)m * 4 + lane] = fminf(z, 0.f) - 0.6931471805599453f * __builtin_amdgcn_logf(1.f + ex2(-fabsf(z) * LOG2E)); }
    }
    __syncthreads();
}

DI void knorm_rows(bf16_t* base, int nrows4  , int stride, const float* kw, int gw, int NGW, int lane) {
    const f32x4 w0 = *(const f32x4*)(kw + 8 * (lane & 7)), w1 = *(const f32x4*)(kw + 8 * (lane & 7) + 4);
    for (int r8 = gw; r8 < nrows4 / 8; r8 += NGW) { const int rid = r8 * 8 + (lane >> 3);
        u32x4* p = (u32x4*)(base + (size_t)(rid >> 2) * stride + (rid & 3) * HD + 8 * (lane & 7));
        const u32x4 kr = *p;
        const float f[8] = {bf_lo(kr.x), bf_hi(kr.x), bf_lo(kr.y), bf_hi(kr.y), bf_lo(kr.z), bf_hi(kr.z), bf_lo(kr.w), bf_hi(kr.w)};
        float ss = 0.f;
#pragma unroll
        for (int j = 0; j < 8; ++j) ss += f[j] * f[j];
        ss = sum8(ss);
        const float rstd = __builtin_amdgcn_rsqf(ss * (1.f / HD) + EPS);
        *p = (u32x4){pk2(f[0] * rstd * w0.x, f[1] * rstd * w0.y), pk2(f[2] * rstd * w0.z, f[3] * rstd * w0.w), pk2(f[4] * rstd * w1.x, f[5] * rstd * w1.y), pk2(f[6] * rstd * w1.z, f[7] * rstd * w1.w)}; }
}
DI void kprep_phase(ldsp lds, int layer) {
    kargp P = kargs(); const int tid = threadIdx.x, lane = tid & 63, wave = __builtin_amdgcn_readfirstlane(tid >> 6), gw = blockIdx.x * 8 + wave, NGW = gridDim.x * 8;
    knorm_rows((bf16_t*)(P->ws + WS_PROJ) + C_FK, NTOK * 4, NP, P->fox_k_norm + layer * HD, gw, NGW, lane);
    knorm_rows((bf16_t*)(P->ws + WS_KVM + layer * KVM_BYTES), NB * NMEM * 4, 512, P->mem_k_norm + layer * HD, gw, NGW, lane);
    if (blockIdx.x < NB * NH) {
        const int b = blockIdx.x >> 2, h = blockIdx.x & 3;
        const float* lfp = (const float*)(P->ws + WS_LF) + (size_t)b * SEQ * 4 + h;
        float a[4];
#pragma unroll
        for (int j = 0; j < 4; ++j) a[j] = lfp[(size_t)(4 * tid + j) * 4];
        const float s0 = a[0], s1 = s0 + a[1], s2 = s1 + a[2], s3 = s2 + a[3];
        float inc = s3;
#pragma unroll
        for (int off = 1; off < 64; off <<= 1) { const float v = __shfl_up(inc, off); if (lane >= off) inc += v; }
        LAS float* wsum = (LAS float*)lds;
        if (lane == 63) wsum[wave] = inc;
        __syncthreads();
        float offs = 0.f;
        for (int w = 0; w < wave; ++w) offs += wsum[w];
        const float pre = offs + inc - s3;
        *(f32x4*)((float*)(P->ws + WS_C2) + (size_t)blockIdx.x * SEQ + 4 * tid) = (f32x4){(pre + s0) * LOG2E, (pre + s1) * LOG2E, (pre + s2) * LOG2E, (pre + s3) * LOG2E};
        __syncthreads();
    }
}

constexpr int ATT_SLOT = 16384, ATT_NSLOT = 5, ATT_NRES = 6, ATT_CS = ATT_NRES * ATT_SLOT, ATT_FLAG = ATT_CS + 8192, ATT_RK = ATT_FLAG + 128, ATT_WT = ATT_RK + ATT_NRES * 256, ATT_Q = ATT_WT + 64, ATT_END = ATT_Q + 32768;
static_assert(ATT_END <= 147392, "attention LDS map");
#ifndef FUSE_NORM
#define FUSE_NORM 0
#endif
#ifndef ATT_STAGGER
#define ATT_STAGGER 0
#endif
#ifndef ATT_TILE_SKIP
#define ATT_TILE_SKIP 1
#endif
DI int crow(int reg, int h) { return (reg & 3) + 8 * (reg >> 2) + 4 * h; }
DI int swz8(int row) { const int x = (row >> 1) & 7; return ((x & 1) << 2) | (x >> 1); }
DI u32x4 pack8(const f32x16& p, int s) { return (u32x4){pk2(p[8 * s], p[8 * s + 1]), pk2(p[8 * s + 2], p[8 * s + 3]), pk2(p[8 * s + 4], p[8 * s + 5]), pk2(p[8 * s + 6], p[8 * s + 7])}; }
DI s16x4 tr_rd(ldsp p) { typedef short v4i16_t __attribute__((ext_vector_type(4))); return __builtin_bit_cast(s16x4, __builtin_amdgcn_ds_read_tr16_b64_v4i16((LAS v4i16_t*)p)); }
DI void att_zero(f32x16& p0, f32x16& p1) {
#pragma unroll
    for (int i = 0; i < 16; ++i) { p0[i] = 0.f; p1[i] = 0.f; }
}
template <int MODE> DI void att_bias(f32x16& p0, f32x16& p1, ldsp lds, int slot, int kt, int hh) {
    if (MODE == 1) return;
#pragma unroll
    for (int g = 0; g < 4; ++g) {
        const f32x4 r0 = *(LAS f32x4*)(lds + ATT_RK + 4 * (64 * slot + 8 * g + 4 * hh)), r1 = *(LAS f32x4*)(lds + ATT_RK + 4 * (64 * slot + 32 + 8 * g + 4 * hh));
        if (MODE == 0) { const f32x4 c0 = *(LAS f32x4*)(lds + ATT_CS + 4 * (64 * kt + 8 * g + 4 * hh)), c1 = *(LAS f32x4*)(lds + ATT_CS + 4 * (64 * kt + 32 + 8 * g + 4 * hh));
#pragma unroll
            for (int j = 0; j < 4; ++j) { p0[4 * g + j] = p0[4 * g + j] * r0[j] + c0[j]; p1[4 * g + j] = p1[4 * g + j] * r1[j] + c1[j]; } }
        else {
#pragma unroll
            for (int j = 0; j < 4; ++j) { p0[4 * g + j] *= r0[j]; p1[4 * g + j] *= r1[j]; } }
    }
}
template <int MODE> DI void att_prep(ldsp lds, int slot, int kt, const float* lfp, int tid, int lane, int wid) {
    if (MODE == 1) return;
    { const int row = tid >> 3, sc = tid & 7;
      const u32x4 kr = *(LAS u32x4*)(lds + slot * ATT_SLOT + row * 128 + ((sc ^ swz8(row)) << 4));
      const float f[8] = {bf_lo(kr.x), bf_hi(kr.x), bf_lo(kr.y), bf_hi(kr.y), bf_lo(kr.z), bf_hi(kr.z), bf_lo(kr.w), bf_hi(kr.w)};
      float ss = 0.f;
#pragma unroll
      for (int j = 0; j < 8; ++j) ss += f[j] * f[j];
      ss = sum8(ss);
      if (sc == 0) *(LAS float*)(lds + ATT_RK + 4 * (64 * slot + row)) = __builtin_amdgcn_rsqf(ss * (1.f / HD) + EPS); }
    if (MODE == 0 && wid == 0) {
        const float a = lfp[(size_t)(64 * kt + lane) * 4] * LOG2E;
        float suf = a;
#pragma unroll
        for (int off = 1; off < 64; off <<= 1) { const float v = __shfl_down(suf, off); if (lane + off < 64) suf += v; }
        const float E = *(LAS float*)(lds + ATT_WT + 32);
        *(LAS float*)(lds + ATT_CS + 4 * (64 * kt + lane)) = E + suf - a;
        if (lane == 0) *(LAS float*)(lds + ATT_WT + 32) = E + suf;
    }
}
DI void att_qk(f32x16& p0, f32x16& p1, ldsp Kb, ldsp Qb  , int r, int hh) {
    const int sw = swz8(r);
#pragma unroll
    for (int ks = 0; ks < 4; ++ks) {
        const int co = ((2 * ks + hh) ^ sw) << 4;
        const bf16x8 k0 = *(LAS bf16x8*)(Kb + r * 128 + co);
        const bf16x8 k1 = *(LAS bf16x8*)(Kb + (32 + r) * 128 + co);
        const bf16x8 qv = *(LAS bf16x8*)(Qb + 1024 * ks);
        p0 = MFMA32(k0, qv, p0); p1 = MFMA32(k1, qv, p1); }
}
DI void att_pv(f32x16& o0, f32x16& o1, ldsp Vb, const f32x16& p0, const f32x16& p1, int hh, int q4, int p4, int blk) {
    const int rl = 4 * hh + q4, sl = swz8(rl), sh = swz8(rl + 8), cb = 2 * blk + (p4 >> 1), in8 = 8 * (p4 & 1);
    const int ol0 = rl * 128 + ((cb ^ sl) << 4) + in8, ol1 = rl * 128 + (((4 + cb) ^ sl) << 4) + in8;
    const int oh0 = (rl + 8) * 128 + ((cb ^ sh) << 4) + in8, oh1 = (rl + 8) * 128 + (((4 + cb) ^ sh) << 4) + in8;
#pragma unroll
    for (int sb = 0; sb < 2; ++sb)
#pragma unroll
        for (int s = 0; s < 2; ++s) {
            const bf16x8 pf = __builtin_bit_cast(bf16x8, pack8(sb ? p1 : p0, s));
            ldsp a = Vb + (32 * sb + 16 * s) * 128;
            const s16x4 l0 = tr_rd(a + ol0), h0 = tr_rd(a + oh0), l1 = tr_rd(a + ol1), h1 = tr_rd(a + oh1);
            const bf16x8 v0 = __builtin_shufflevector(l0, h0, 0, 1, 2, 3, 4, 5, 6, 7), v1 = __builtin_shufflevector(l1, h1, 0, 1, 2, 3, 4, 5, 6, 7);
            o0 = MFMA32(v0, pf, o0); o1 = MFMA32(v1, pf, o1);
        }
}
DI void att_softmax(f32x16& p0, f32x16& p1, float& m_run, float& l_run, f32x16& o0, f32x16& o1) {
    float tm = fmaxf(p0[0], p1[0]);
#pragma unroll
    for (int i = 1; i < 16; ++i) tm = fmaxf(tm, fmaxf(p0[i], p1[i]));
    { float lo_, hi_; halves(tm, lo_, hi_); tm = fmaxf(lo_, hi_); }
    const float mn = fmaxf(m_run, tm);
    if (__any(mn > m_run)) { const float alpha = ex2(m_run - mn); l_run *= alpha;
#pragma unroll
        for (int i = 0; i < 16; ++i) { o0[i] *= alpha; o1[i] *= alpha; } }
    m_run = mn;
    float rs = 0.f;
#pragma unroll
    for (int i = 0; i < 16; ++i) { p0[i] = ex2(p0[i] - mn); p1[i] = ex2(p1[i] - mn); rs += p0[i] + p1[i]; }
    l_run += rs;
}
DI float mul_s(float a, float b) { return a * b; }
template <bool BAND> DI void att_sb(f32x16& p0, f32x16& p1, float& R, int jrel, int qrel, int hh) {
#pragma unroll
    for (int sb = 1; sb >= 0; --sb) {
#pragma unroll
        for (int g = 3; g >= 0; --g) {
            float omb[4], be[4];
#pragma unroll
            for (int j = 0; j < 4; ++j) { const float z = sb ? p1[4 * g + j] : p0[4 * g + j];
                float e = ex2(z);
                if (BAND) { const int kv = 64 * jrel + 32 * sb + 8 * g + 4 * hh + j; if (kv >= qrel) e = 0.f; }
                omb[j] = rcpf_(1.f + e); be[j] = 1.f - omb[j]; }
            const float t2 = omb[3], t1 = mul_s(t2, omb[2]), t0 = mul_s(t1, omb[1]), my4 = mul_s(t0, omb[0]);
            float lo_, hi_; halves(my4, lo_, hi_);
            const float base = hh ? R : mul_s(R, hi_);
            const float w3 = mul_s(be[3], base), w2 = mul_s(be[2], mul_s(base, t2)), w1 = mul_s(be[1], mul_s(base, t1)), w0 = mul_s(be[0], mul_s(base, t0));
            R = mul_s(R, mul_s(lo_, hi_));
            if (sb) { p1[4 * g] = w0; p1[4 * g + 1] = w1; p1[4 * g + 2] = w2; p1[4 * g + 3] = w3; }
            else { p0[4 * g] = w0; p0[4 * g + 1] = w1; p0[4 * g + 2] = w2; p0[4 * g + 3] = w3; }
        }
    }
}
DI void glds16(const void* gsrc, unsigned lds_dst) { unsigned keep;
    asm volatile("s_mov_b32 %0, m0\n\ts_mov_b32 m0, %2\n\ts_nop 0\n\tglobal_load_lds_dwordx4 %1, off\n\ts_mov_b32 m0, %0" : "=&s"(keep) : "v"(gsrc), "s"(lds_dst) : "memory"); }
#define ATT_WAITBAR(N) asm volatile("s_waitcnt vmcnt(" #N ") lgkmcnt(0)\n\ts_barrier" ::: "memory")

template <int MODE>
DI void attn_unit(ldsp lds, const bf16_t* Qp, const bf16_t* Kp, const bf16_t* Vp, int kvstride, const bf16_t* Gp, bf16_t* Op, const float* lfp  , const float* qnw, const float* knw, int qt, int nq) {
    int tid_ = threadIdx.x; asm volatile("" : "+v"(tid_));
    const int tid = tid_, lane = tid & 63, wid = __builtin_amdgcn_readfirstlane(tid >> 6), r = lane & 31, hh = lane >> 5;
    qnw = launder(qnw); lfp = launder(lfp); knw = launder(knw);
    const int NT = (MODE == 2) ? 4 : 4 * qt + 4;
    const int NRES = NT < ATT_NRES ? NT : ATT_NRES;
#define ATT_KT(i) ((MODE == 2) ? (i) : NT - 1 - (i))
    const int drow = 8 * wid + (lane >> 3);
    const size_t dma_off = (size_t)drow * kvstride + 8 * ((lane & 7) ^ swz8(drow));
    const unsigned lds0 = (unsigned)(uintptr_t)lds;
#define ATT_DMA_TO(i, slot) do { const size_t to_ = (size_t)ATT_KT(i) * 64 * kvstride + dma_off; const unsigned sl_ = __builtin_amdgcn_readfirstlane(lds0 + (slot) * ATT_SLOT + wid * 1024); \
        glds16(Kp + to_, sl_); glds16(Vp + to_, sl_ + 8192); } while (0)
#define ATT_DMA(i) ATT_DMA_TO(i, (i) % ATT_NSLOT)
    u32x4 qraw[4];
    { const bf16_t* qrow = Qp + (size_t)(qt * 256 + wid * 32 + r) * NP + 8 * hh;
#pragma unroll
      for (int ks = 0; ks < 4; ++ks) qraw[ks] = *(const u32x4*)(qrow + 16 * ks); }
#pragma unroll 1
    for (int i = 0; i < NRES; ++i) ATT_DMA_TO(i, i);
    if (tid < 24) *(LAS unsigned*)(lds + ATT_FLAG + 4 * tid) = 0u;
    float sufv = 0.f, av = 0.f; const int klo = 64 * (NT - NRES), kcnt = 64 * NRES;
    if (MODE == 0) {
        if (tid < kcnt) av = lfp[(size_t)(klo + tid) * 4] * LOG2E;
        sufv = av;
#pragma unroll
        for (int off = 1; off < 64; off <<= 1) { const float v = __shfl_down(sufv, off); if (lane + off < 64) sufv += v; }
        if (lane == 0) *(LAS float*)(lds + ATT_WT + 4 * wid) = sufv;
    }
    ATT_WAITBAR(0);
#pragma unroll 1
    for (int i = 0; i < NRES; ++i) att_prep<(MODE == 0) ? 2 : MODE>(lds, i, 0, nullptr, tid, lane, wid);
    if (MODE == 0) { float offs = 0.f;
#pragma unroll
        for (int w = 0; w < 8; ++w) { const float x = *(LAS float*)(lds + ATT_WT + 4 * w); if (w > wid) offs += x; }
        if (tid < kcnt) *(LAS float*)(lds + ATT_CS + 4 * (klo + tid)) = offs + sufv - av;
        if (tid == 0) *(LAS float*)(lds + ATT_WT + 32) = offs + sufv; }
    asm volatile("s_waitcnt lgkmcnt(0)\n\ts_barrier" ::: "memory");
    const int qrel = 32 * wid + r;
    const int q4 = (lane & 15) >> 2, p4 = lane & 3, blk = (lane >> 4) & 1;
    ldsp Qb = lds + ATT_Q + wid * 4096 + lane * 16;
#pragma unroll 1
    for (int qq = 0; qq < nq; ++qq) {
        const int q0 = (qt + qq) * 256;
        float qn2 = 0.f;
        { float v[4][8]; float ss = 0.f;
#pragma unroll
          for (int ks = 0; ks < 4; ++ks) { const u32x4 raw = qraw[ks];
              v[ks][0] = bf_lo(raw.x); v[ks][1] = bf_hi(raw.x); v[ks][2] = bf_lo(raw.y); v[ks][3] = bf_hi(raw.y); v[ks][4] = bf_lo(raw.z); v[ks][5] = bf_hi(raw.z); v[ks][6] = bf_lo(raw.w); v[ks][7] = bf_hi(raw.w);
#pragma unroll
              for (int j = 0; j < 8; ++j) ss += v[ks][j] * v[ks][j]; }
          float sc_all = 0.125f * LOG2E;
          if (MODE != 1) { float lo_, hi_; halves(ss, lo_, hi_); sc_all *= __builtin_amdgcn_rsqf((lo_ + hi_) * (1.f / HD) + EPS); }
#pragma unroll
          for (int ks = 0; ks < 4; ++ks) {
              float w[8];
#pragma unroll
              for (int j = 0; j < 8; ++j) w[j] = (MODE != 1) ? qnw[16 * ks + 8 * hh + j] * knw[16 * ks + 8 * hh + j] : 1.f;
              u32x4 pk; pk.x = pk2(v[ks][0] * sc_all * w[0], v[ks][1] * sc_all * w[1]); pk.y = pk2(v[ks][2] * sc_all * w[2], v[ks][3] * sc_all * w[3]);
              pk.z = pk2(v[ks][4] * sc_all * w[4], v[ks][5] * sc_all * w[5]); pk.w = pk2(v[ks][6] * sc_all * w[6], v[ks][7] * sc_all * w[7]);
              *(LAS u32x4*)(Qb + ks * 1024) = pk;
              if (MODE == 0) {
#pragma unroll
                  for (int j = 0; j < 8; ++j) { const float t_ = v[ks][j] * sc_all * w[j]; qn2 += t_ * t_; } } } }
        if (qq + 1 < nq) { const bf16_t* qrow = Qp + (size_t)(q0 + 256 + wid * 32 + r) * NP + 8 * hh;
#pragma unroll
            for (int ks = 0; ks < 4; ++ks) qraw[ks] = *(const u32x4*)(qrow + 16 * ks); }
        u32x2 graw[8];
#pragma unroll
        for (int e = 0; e < 8; ++e) graw[e] = *(const u32x2*)(Gp + (size_t)(q0 + wid * 32 + r) * NP + 32 * (e >> 2) + 8 * (e & 3) + 4 * hh);
        float smax = 0.f;
        if (MODE == 0) { float lo_, hi_; halves(qn2, lo_, hi_); smax = sqrtf(lo_ + hi_) * 8.f * 1.02f; }

        float m_run = -INFINITY, l_run = 0.f, R = 1.f;
        f32x16 o0, o1, p0, p1;
#pragma unroll
        for (int i = 0; i < 16; ++i) { o0[i] = 0.f; o1[i] = 0.f; }
        bool done = false;
#pragma unroll 1
        for (int it = (MODE == 2) ? 0 : 3 - ((32 * wid + 31) >> 6); it < NRES; ++it) {
            const bool band = (MODE != 2) && it < 4;
            const int jrel = 3 - it;
#if ATT_TILE_SKIP
            if (MODE != 2 && !band) {
                bool sk;
                if (MODE == 0) { const float nmax = *(LAS float*)(lds + ATT_CS + 4 * (64 * ATT_KT(it) + 63));
                    sk = !__any(nmax + smax >= m_run - 48.f); }
                else sk = !__any(R >= 0x1p-48f);
                if (sk) { done = true; break; }
            }
#endif
            ldsp Kb = lds + it * ATT_SLOT;
            att_zero(p0, p1);
            att_qk(p0, p1, Kb, Qb, r, hh);
            att_bias<MODE>(p0, p1, lds, it, ATT_KT(it), hh);
            if (MODE == 1) { if (band) att_sb<true>(p0, p1, R, jrel, qrel, hh); else att_sb<false>(p0, p1, R, -1, qrel, hh); }
            else {
                if (MODE == 0 && band) {
#pragma unroll
                    for (int e = 0; e < 16; ++e) { const int kv = 64 * jrel + crow(e, hh); if (kv > qrel) p0[e] = -INFINITY; if (kv + 32 > qrel) p1[e] = -INFINITY; } }
                att_softmax(p0, p1, m_run, l_run, o0, o1);
            }
            att_pv(o0, o1, Kb + 8192, p0, p1, hh, q4, p4, blk);
        }
        if (MODE != 2 && NRES < NT) {
            if (lane == 0) *(LAS unsigned*)(lds + ATT_FLAG + 64 + 4 * wid) = done ? 0u : 1u;
            asm volatile("s_waitcnt lgkmcnt(0)\n\ts_barrier" ::: "memory");
            const u32x4 n0 = *(LAS u32x4*)(lds + ATT_FLAG + 64), n1 = *(LAS u32x4*)(lds + ATT_FLAG + 80);
            if (__builtin_amdgcn_readfirstlane((n0.x | n0.y) | (n0.z | n0.w) | (n1.x | n1.y) | (n1.z | n1.w)) != 0u) {
                const int it0 = NRES;
                ATT_DMA(it0); if (it0 + 1 < NT) ATT_DMA(it0 + 1); if (it0 + 2 < NT) ATT_DMA(it0 + 2);
                ATT_WAITBAR(0);
#pragma unroll 1
                for (int k = 0; k < 3; ++k) if (it0 + k < NT) att_prep<MODE>(lds, (it0 + k) % ATT_NSLOT, ATT_KT(it0 + k), lfp, tid, lane, wid);
                asm volatile("s_waitcnt lgkmcnt(0)\n\ts_barrier" ::: "memory");
                bool skipcur = false;
#pragma unroll 1
                for (int s2 = 2 * it0; s2 < 2 * NT; ++s2) {
                    const int i = s2 >> 1;
#if ATT_TILE_SKIP
                    if ((s2 & 1) == 0 && i > it0) {
                        const u32x4 f0 = *(LAS u32x4*)(lds + ATT_FLAG + 32 * ((i - 1) & 1)), f1 = *(LAS u32x4*)(lds + ATT_FLAG + 32 * ((i - 1) & 1) + 16);
                        if (__builtin_amdgcn_readfirstlane((f0.x & f0.y) & (f0.z & f0.w) & (f1.x & f1.y) & (f1.z & f1.w)) != 0u) break; }
#endif
                    if ((s2 & 1) == 0 && i + 3 < NT) ATT_DMA(i + 3);
                    ldsp Kb = lds + (i % ATT_NSLOT) * ATT_SLOT;
                    if ((s2 & 1) == 0) {
                        skipcur = done;
#if ATT_TILE_SKIP
                        if (!skipcur) {
                            if (MODE == 0) { const float nmax = *(LAS float*)(lds + ATT_CS + 4 * (64 * ATT_KT(i) + 63)); skipcur = !__any(nmax + smax >= m_run - 48.f); }
                            else skipcur = !__any(R >= 0x1p-48f);
                            if (skipcur) done = true; }
                        if (skipcur && lane == 0) *(LAS unsigned*)(lds + ATT_FLAG + 32 * (i & 1) + 4 * wid) = 1u;
#endif
                        if (!skipcur) { att_zero(p0, p1); att_qk(p0, p1, Kb, Qb, r, hh); att_bias<MODE>(p0, p1, lds, i % ATT_NSLOT, ATT_KT(i), hh); }
                    } else {
                        if (!skipcur) {
                            if (MODE == 1) att_sb<false>(p0, p1, R, -1, qrel, hh); else att_softmax(p0, p1, m_run, l_run, o0, o1);
                            att_pv(o0, o1, Kb + 8192, p0, p1, hh, q4, p4, blk); }
                        ATT_WAITBAR(0);
                        if (i + 3 < NT) att_prep<MODE>(lds, (i + 3) % ATT_NSLOT, ATT_KT(i + 3), lfp, tid, lane, wid);
                        asm volatile("s_waitcnt lgkmcnt(0)\n\ts_barrier" ::: "memory");
                    }
                }
                ATT_WAITBAR(0);
            }
        }
        float inv = 1.f;
        if (MODE != 1) { float lo_, hi_; halves(l_run, lo_, hi_); inv = 1.0f / (lo_ + hi_); }
        ldsp st = lds + ATT_Q + wid * 4096;
#pragma unroll
        for (int dt = 0; dt < 2; ++dt)
#pragma unroll
            for (int g = 0; g < 4; ++g) {
                const u32x2 gr = graw[4 * dt + g];
                const float g0 = silu_f(bf_lo(gr.x)), g1 = silu_f(bf_hi(gr.x)), g2 = silu_f(bf_lo(gr.y)), g3 = silu_f(bf_hi(gr.y));
                const float a0 = dt ? o1[4 * g] : o0[4 * g], a1 = dt ? o1[4 * g + 1] : o0[4 * g + 1], a2 = dt ? o1[4 * g + 2] : o0[4 * g + 2], a3 = dt ? o1[4 * g + 3] : o0[4 * g + 3];
                *(LAS u32x2*)(st + r * 128 + (((4 * dt + g) ^ (r & 7)) << 4) + 8 * hh) = (u32x2){pk2(a0 * inv * g0, a1 * inv * g1), pk2(a2 * inv * g2, a3 * inv * g3)}; }
#pragma unroll
        for (int i = 0; i < 4; ++i) { const int orow = (lane >> 3) + 8 * i, c16 = lane & 7;
            const u32x4 v = *(LAS u32x4*)(st + orow * 128 + ((c16 ^ (orow & 7)) << 4));
            *(u32x4*)(Op + (size_t)(q0 + wid * 32 + orow) * DMIX + 8 * c16) = v; }
    }
    asm volatile("s_waitcnt lgkmcnt(0)\n\ts_barrier" ::: "memory");
#undef ATT_KT
#undef ATT_DMA
#undef ATT_DMA_TO
}

constexpr int HG_Q = 0, HG_F = 8192, HG_V = 16384, HG_O = 24576;
DI void hgrn_unit_valu(ldsp lds, const bf16_t* pj  , bf16_t* mx  , int h, int layer, const float* lb_logits, const float* onorm) {
    int tid_ = threadIdx.x; asm volatile("" : "+v"(tid_));
    const int tid = tid_, lane = tid & 63, wid = __builtin_amdgcn_readfirstlane(tid >> 6);
    lb_logits = launder(lb_logits); onorm = launder(onorm);
    const int tt = tid >> 4, c4 = (tid & 15) * 4;
    float oml[4], onw[4];
#pragma unroll
    for (int j = 0; j < 4; ++j) { const int c = h * HD + c4 + j;
        float lbv = 0.f;
        if (layer == 1) { const float l0 = lb_logits[c], l1 = lb_logits[256 + c], mx_ = fmaxf(l0, l1), e0 = expf(l0 - mx_), e1 = expf(l1 - mx_), p0 = e0 / (e0 + e1), p1 = e1 / (e0 + e1);
            lbv = fminf(fmaxf((p0 + p1) - p0, 0.f), 1.0f - 1e-6f); }
        oml[j] = 1.f - lbv; onw[j] = onorm[c]; }
    f32x2 S2[4];
#pragma unroll
    for (int i = 0; i < 4; ++i) S2[i] = (f32x2){0.f, 0.f};
    const bf16_t* base = pj + (size_t)tt * NP + h * HD + c4;
    u32x2 rq = *(const u32x2*)(base + C_HQ), rf = *(const u32x2*)(base + C_HF), ri = *(const u32x2*)(base + C_HI);
#pragma unroll 1
    for (int ch = 0; ch < SEQ / 32; ++ch) {
        { const float hq[4] = {bf_lo(rq.x), bf_hi(rq.x), bf_lo(rq.y), bf_hi(rq.y)}, hf[4] = {bf_lo(rf.x), bf_hi(rf.x), bf_lo(rf.y), bf_hi(rf.y)};
          f32x4 q, f;
#pragma unroll
          for (int j = 0; j < 4; ++j) { q[j] = silu_f(hq[j]); const float sg = rcpf_(1.f + ex2(hf[j] * LOG2E)); f[j] = 1.f - oml[j] * sg; }
          *(LAS f32x4*)(lds + HG_Q + 4 * (tt * 64 + c4)) = q; *(LAS f32x4*)(lds + HG_F + 4 * (tt * 64 + c4)) = f;
          *(LAS f32x4*)(lds + HG_V + 4 * (tt * 64 + c4)) = (f32x4){bf_lo(ri.x), bf_hi(ri.x), bf_lo(ri.y), bf_hi(ri.y)}; }
        __syncthreads();
        if (ch + 1 < SEQ / 32) { const bf16_t* nb = base + (size_t)(ch + 1) * 32 * NP; rq = *(const u32x2*)(nb + C_HQ); rf = *(const u32x2*)(nb + C_HF); ri = *(const u32x2*)(nb + C_HI); }
        const u32x2 gr = *(const u32x2*)(base + (size_t)ch * 32 * NP + C_HG);
        float acc[32];
#pragma unroll
        for (int t = 0; t < 32; ++t) {
            const f32x4 qa = *(LAS f32x4*)(lds + HG_Q + 4 * (t * 64 + 8 * wid)), qb = *(LAS f32x4*)(lds + HG_Q + 4 * (t * 64 + 8 * wid + 4));
            const f32x4 fa = *(LAS f32x4*)(lds + HG_F + 4 * (t * 64 + 8 * wid)), fb = *(LAS f32x4*)(lds + HG_F + 4 * (t * 64 + 8 * wid + 4));
            const float v = *(LAS float*)(lds + HG_V + 4 * (t * 64 + lane));
            const f32x2 v2 = {v, v};
            S2[0] = (f32x2){fa.x, fa.y} * (S2[0] - v2) + v2; S2[1] = (f32x2){fa.z, fa.w} * (S2[1] - v2) + v2;
            S2[2] = (f32x2){fb.x, fb.y} * (S2[2] - v2) + v2; S2[3] = (f32x2){fb.z, fb.w} * (S2[3] - v2) + v2;
            f32x2 a2 = S2[0] * (f32x2){qa.x, qa.y}, b2 = S2[1] * (f32x2){qa.z, qa.w};
            a2 += S2[2] * (f32x2){qb.x, qb.y}; b2 += S2[3] * (f32x2){qb.z, qb.w};
            a2 += b2; acc[t] = a2.x + a2.y;
        }
#pragma unroll
        for (int t = 0; t < 32; ++t) *(LAS float*)(lds + HG_O + 4 * ((wid * 32 + t) * 64 + lane)) = acc[t];
        __syncthreads();
        f32x4 o = *(LAS f32x4*)(lds + HG_O + 4 * (tt * 64 + c4));
#pragma unroll
        for (int w = 1; w < 8; ++w) o += *(LAS f32x4*)(lds + HG_O + 4 * ((w * 32 + tt) * 64 + c4));
        float ss = (o.x * o.x + o.y * o.y) + (o.z * o.z + o.w * o.w);
        ss = sum16(ss);
        const float rstd = 1.0f / sqrtf(ss * (1.f / HD) + EPS);
        const float g0 = silu_f(bf_lo(gr.x)), g1 = silu_f(bf_hi(gr.x)), g2 = silu_f(bf_lo(gr.y)), g3 = silu_f(bf_hi(gr.y));
        *(u32x2*)(mx + (size_t)(ch * 32 + tt) * DMIX + O_HG + h * HD + c4) = (u32x2){pk2(o.x * rstd * onw[0] * g0, o.y * rstd * onw[1] * g1), pk2(o.z * rstd * onw[2] * g2, o.w * rstd * onw[3] * g3)};
    }
    __syncthreads();
}

typedef short s16x4v __attribute__((ext_vector_type(4)));
#define MFMA16(a, b, c) __builtin_amdgcn_mfma_f32_16x16x16bf16_1k((a), (b), (c), 0, 0, 0)
constexpr int HM_QS = 0, HM_QM = 16 * 136, HM_KM = 2 * 16 * 136, HM_KET = 3 * 16 * 136, HM_VT = HM_KET + 64 * 40, HM_DEC = HM_VT + 64 * 40, HM_SLOT = HM_DEC + 256, HM_NS = 4, HM_OB = HM_NS * HM_SLOT, HM_OSTR = 272;
constexpr int HM_RAW = HM_OB + 2 * 16 * HM_OSTR, HM_RSLOT = 8192, HM_NR = 8;
static_assert(HM_SLOT % 16 == 0 && HM_RAW % 16 == 0 && HM_RAW + HM_NR * HM_RSLOT <= 147392, "HGRN LDS map");
DI s16x4v pack4(const f32x4 v) { u32x2 p = {pk2(v.x, v.y), pk2(v.z, v.w)}; return __builtin_bit_cast(s16x4v, p); }
DI void hgrn_unit(ldsp lds, const bf16_t* pj  , bf16_t* mx  , int h, int layer, const float* lb_logits, const float* onorm) {
    int tid_ = threadIdx.x; asm volatile("" : "+v"(tid_));
    const int tid = tid_, lane = tid & 63, wid = __builtin_amdgcn_readfirstlane(tid >> 6);
    lb_logits = launder(lb_logits); onorm = launder(onorm);
    const bool cons = wid < 4;
    const int fr = lane & 15, fq = lane >> 4;
    constexpr int NBLK = SEQ / 16;
    const int dl = lane >> 2, tq = lane & 3;
    const int pd = 16 * (wid & 3) + dl;
    float oml = 1.f;
    if (layer == 1) { const float l0 = lb_logits[h * HD + pd], l1 = lb_logits[256 + h * HD + pd], mx_ = fmaxf(l0, l1), e0 = expf(l0 - mx_), e1 = expf(l1 - mx_), p0 = e0 / (e0 + e1), p1 = e1 / (e0 + e1);
        oml = 1.f - fminf(fmaxf((p0 + p1) - p0, 0.f), 1.0f - 1e-6f); }
    f32x4 Sacc[4];
#pragma unroll
    for (int i = 0; i < 4; ++i) Sacc[i] = (f32x4){0.f, 0.f, 0.f, 0.f};
    const int e4 = 4 * fr, trow = 4 * wid + fq;
    const f32x4 onw = *(const f32x4*)(onorm + h * HD + e4);
    const unsigned lds0 = (unsigned)(uintptr_t)lds;
    const int pseg = (wid & 3);
    const bf16_t* dsrc = pj + (size_t)(lane >> 3) * NP + (pseg == 0 ? C_HQ : pseg == 1 ? C_HF : pseg == 2 ? C_HI : C_HG) + h * HD + 8 * (lane & 7);
#define HM_DMA(blk) do { const unsigned d_ = __builtin_amdgcn_readfirstlane(lds0 + HM_RAW + ((blk) & (HM_NR - 1)) * HM_RSLOT + pseg * 2048); \
        glds16(dsrc + (size_t)(blk) * 16 * NP, d_); glds16(dsrc + (size_t)((blk) * 16 + 8) * NP, d_ + 1024); } while (0)
    if (!cons) { HM_DMA(0); HM_DMA(1); HM_DMA(2); HM_DMA(3); asm volatile("s_waitcnt vmcnt(6)" ::: "memory"); }
    asm volatile("s_waitcnt lgkmcnt(0)\n\ts_barrier" ::: "memory");
#pragma unroll 1
    for (int n = -2; n <= NBLK; ++n) {
        if (!cons) {
            const int nb = n + 2;
            if (n + 6 < NBLK) HM_DMA(n + 6);
            if (nb < NBLK) {
                ldsp sb = lds + (nb & 3) * HM_SLOT;
                ldsp rw = lds + HM_RAW + (nb & (HM_NR - 1)) * HM_RSLOT + (4 * tq) * 128 + 2 * pd;
                float q[4], k[4], c[4], v[4];
#pragma unroll
                for (int i = 0; i < 4; ++i) { const float hq = __uint_as_float((unsigned)*(LAS bf16_t*)(rw + i * 128) << 16), hf = __uint_as_float((unsigned)*(LAS bf16_t*)(rw + 2048 + i * 128) << 16);
                    v[i] = __uint_as_float((unsigned)*(LAS bf16_t*)(rw + 4096 + i * 128) << 16);
                    q[i] = silu_f(hq); k[i] = oml * rcpf_(1.f + ex2(hf * LOG2E));
                    c[i] = fmaxf(__builtin_amdgcn_logf(1.f - k[i]), -15.f); }
                c[1] += c[0]; c[2] += c[1]; c[3] += c[2];
                float inc = c[3];
                { const float u1 = dppf<0x90>(inc); if (tq >= 1) inc += u1; const float u2 = dppf<0x44>(inc); if (tq >= 2) inc += u2; }
                const float exc = inc - c[3];
                const float Bm = dppf<0x55>(inc), Be = dppf<0xFF>(inc);
                s16x4v ket, vt; bf16_t* ketp = (bf16_t*)&ket; bf16_t* vtp = (bf16_t*)&vt;
#pragma unroll
                for (int i = 0; i < 4; ++i) { const float B = exc + c[i]; const int t = 4 * tq + i;
                    *(LAS bf16_t*)(sb + HM_QS + t * 136 + 2 * pd) = (bf16_t)(pk2(q[i] * ex2(B), 0.f) & 0xffffu);
                    *(LAS bf16_t*)(sb + HM_QM + t * 136 + 2 * pd) = (bf16_t)(pk2(q[i] * ex2(B - Bm), 0.f) & 0xffffu);
                    *(LAS bf16_t*)(sb + HM_KM + t * 136 + 2 * pd) = (bf16_t)(pk2(k[i] * ex2(Bm - B), 0.f) & 0xffffu);
                    ketp[i] = (bf16_t)(pk2(k[i] * ex2(Be - B), 0.f) & 0xffffu); vtp[i] = (bf16_t)(pk2(v[i], 0.f) & 0xffffu); }
                *(LAS s16x4v*)(sb + HM_KET + pd * 40 + 8 * tq) = ket;
                *(LAS s16x4v*)(sb + HM_VT + pd * 40 + 8 * tq) = vt;
                if (tq == 3) *(LAS float*)(sb + HM_DEC + 4 * pd) = ex2(Be);
            }
            { const int ahead = (n + 6 < NBLK ? n + 6 : NBLK - 1) - (n + 3);
              if (ahead >= 3) asm volatile("s_waitcnt vmcnt(6)" ::: "memory"); else if (ahead == 2) asm volatile("s_waitcnt vmcnt(4)" ::: "memory");
              else if (ahead == 1) asm volatile("s_waitcnt vmcnt(2)" ::: "memory"); else asm volatile("s_waitcnt vmcnt(0)" ::: "memory"); }
        } else {
            if (n >= 1) {
                const f32x4 o = *(LAS f32x4*)(lds + HM_OB + ((n - 1) & 1) * 16 * HM_OSTR + trow * HM_OSTR + 4 * e4);
                const u32x2 gv = *(LAS u32x2*)(lds + HM_RAW + ((n - 1) & (HM_NR - 1)) * HM_RSLOT + 3 * 2048 + trow * 128 + 2 * e4);
                const float ss = sum16((o.x * o.x + o.y * o.y) + (o.z * o.z + o.w * o.w));
                const float rstd = __builtin_amdgcn_rsqf(ss * (1.f / HD) + EPS);
                const float g0 = silu_f(bf_lo(gv.x)), g1 = silu_f(bf_hi(gv.x)), g2 = silu_f(bf_lo(gv.y)), g3 = silu_f(bf_hi(gv.y));
                *(u32x2*)(mx + (size_t)(16 * (n - 1) + trow) * DMIX + O_HG + h * HD + e4) = (u32x2){pk2(o.x * rstd * onw.x * g0, o.y * rstd * onw.y * g1), pk2(o.z * rstd * onw.z * g2, o.w * rstd * onw.w * g3)};
            }
            if (n >= 0 && n < NBLK) {
                ldsp sb = lds + (n & 3) * HM_SLOT;
                s16x4v qm[4], qs[4], km[4];
#pragma unroll
                for (int dt = 0; dt < 4; ++dt) { const int co = fr * 136 + (16 * dt + 4 * fq) * 2;
                    qm[dt] = *(LAS s16x4v*)(sb + HM_QM + co); qs[dt] = *(LAS s16x4v*)(sb + HM_QS + co); km[dt] = *(LAS s16x4v*)(sb + HM_KM + co); }
                const s16x4v vt = *(LAS s16x4v*)(sb + HM_VT + (16 * wid + fr) * 40 + 8 * fq);
                f32x4 pt = {0.f, 0.f, 0.f, 0.f};
#pragma unroll
                for (int dt = 0; dt < 4; ++dt) pt = MFMA16(km[dt], qm[dt], pt);
#pragma unroll
                for (int i = 0; i < 4; ++i) if (4 * fq + i > fr) pt[i] = 0.f;
                f32x4 ot = {0.f, 0.f, 0.f, 0.f};
#pragma unroll
                for (int dt = 0; dt < 4; ++dt) ot = MFMA16(pack4(Sacc[dt]), qs[dt], ot);
                ot = MFMA16(vt, pack4(pt), ot);
                *(LAS f32x4*)(lds + HM_OB + (n & 1) * 16 * HM_OSTR + fr * HM_OSTR + 4 * (16 * wid + 4 * fq)) = ot;
#pragma unroll
                for (int dt = 0; dt < 4; ++dt) { const f32x4 dc = *(LAS f32x4*)(sb + HM_DEC + 4 * (16 * dt + 4 * fq));
                    const s16x4v ke = *(LAS s16x4v*)(sb + HM_KET + (16 * dt + fr) * 40 + 8 * fq);
                    Sacc[dt] = MFMA16(ke, vt, Sacc[dt] * dc); }
            }
        }
        asm volatile("s_waitcnt lgkmcnt(0)\n\ts_barrier" ::: "memory");
    }
#undef HM_DMA
}

constexpr int PL_U = 0, PL_D = 79 * 512, PL_DSTR = 528, PL_Y = PL_D + 64 * PL_DSTR, PL_YSTR = 272;
static_assert(PL_Y + 8 * 32 * PL_YSTR <= 147392, "pooling LDS map");
DI void pool_unit(ldsp lds, const bf16_t* pj, bf16_t* mx, int t0, const bf16_t* wt  , const float* pscale) {
    wt = launder(wt); pscale = launder(pscale);
    int tid_ = threadIdx.x; asm volatile("" : "+v"(tid_));
    const int tid = tid_, lane = tid & 63, wid = __builtin_amdgcn_readfirstlane(tid >> 6), r = lane & 31, hh = lane >> 5;
    for (int idx = tid; idx < 79 * 32; idx += 512) { const int rr = idx >> 5, c16 = idx & 31, tok = t0 - 15 + rr;
        u32x4 v = {0u, 0u, 0u, 0u};
        if (tok >= 0) v = *(const u32x4*)(pj + (size_t)tok * NP + C_PV + 8 * c16);
        *(LAS u32x4*)(lds + PL_U + rr * 512 + 16 * c16) = v; }
    const int g = wid >> 1, th = wid & 1;
    bf16x8 bw[2][4];
#pragma unroll
    for (int nt = 0; nt < 2; ++nt)
#pragma unroll
        for (int ks = 0; ks < 4; ++ks) bw[nt][ks] = *(const bf16x8*)(wt + (size_t)(g * 64 + 32 * nt + r) * 64 + 16 * ks + 8 * hh);
    __syncthreads();
    { const int vec = lane & 7, run = lane >> 3, win = 2 << g, tl0 = 32 * th + 4 * run;
      ldsp ub = lds + PL_U + (15 + tl0) * 512 + g * 128 + vec * 16;
      float acc[8];
#pragma unroll
      for (int j = 0; j < 8; ++j) acc[j] = 0.f;
      for (int j = 0; j < win; ++j) { const u32x4 v = *(LAS u32x4*)(ub - j * 512);
          acc[0] += bf_lo(v.x); acc[1] += bf_hi(v.x); acc[2] += bf_lo(v.y); acc[3] += bf_hi(v.y); acc[4] += bf_lo(v.z); acc[5] += bf_hi(v.z); acc[6] += bf_lo(v.w); acc[7] += bf_hi(v.w); }
#pragma unroll
      for (int k = 0; k < 4; ++k) {
          const u32x4 u = *(LAS u32x4*)(ub + k * 512);
          const float us[8] = {bf_lo(u.x), bf_hi(u.x), bf_lo(u.y), bf_hi(u.y), bf_lo(u.z), bf_hi(u.z), bf_lo(u.w), bf_hi(u.w)};
          if (k > 0) { const u32x4 o = *(LAS u32x4*)(ub + (k - win) * 512);
              const float os[8] = {bf_lo(o.x), bf_hi(o.x), bf_lo(o.y), bf_hi(o.y), bf_lo(o.z), bf_hi(o.z), bf_lo(o.w), bf_hi(o.w)};
#pragma unroll
              for (int j = 0; j < 8; ++j) acc[j] += us[j] - os[j]; }
          const int t = t0 + tl0 + k, cnt = (t + 1 < win) ? t + 1 : win;
          const float icnt = 1.0f / (float)cnt;
          *(LAS u32x4*)(lds + PL_D + (tl0 + k) * PL_DSTR + g * 128 + vec * 16) = (u32x4){pk2(acc[0] * icnt - us[0], acc[1] * icnt - us[1]), pk2(acc[2] * icnt - us[2], acc[3] * icnt - us[3]),
                                                                                      pk2(acc[4] * icnt - us[4], acc[5] * icnt - us[5]), pk2(acc[6] * icnt - us[6], acc[7] * icnt - us[7])};
      } }
    { f32x16 y0, y1;
#pragma unroll
      for (int i = 0; i < 16; ++i) { y0[i] = 0.f; y1[i] = 0.f; }
#pragma unroll
      for (int ks = 0; ks < 4; ++ks) { const bf16x8 a = *(LAS bf16x8*)(lds + PL_D + (32 * th + r) * PL_DSTR + (64 * g + 16 * ks + 8 * hh) * 2);
          y0 = MFMA32(a, bw[0][ks], y0); y1 = MFMA32(a, bw[1][ks], y1); }
      const float sc0 = pscale[64 * g + r], sc1 = pscale[64 * g + 32 + r];
      ldsp ys = lds + PL_Y + wid * 32 * PL_YSTR;
#pragma unroll
      for (int i = 0; i < 16; ++i) { *(LAS float*)(ys + crow(i, hh) * PL_YSTR + 4 * r) = y0[i] * sc0; *(LAS float*)(ys + crow(i, hh) * PL_YSTR + 4 * (32 + r)) = y1[i] * sc1; }
      const int tok = lane >> 1, hf = lane & 1;
      const size_t trow = (size_t)(t0 + 32 * th + tok);
#pragma unroll
      for (int k = 0; k < 4; ++k) {
          const u32x4 gv = *(const u32x4*)(pj + trow * NP + C_PG + 64 * g + 32 * hf + 8 * k);
          const f32x4 ya = *(LAS f32x4*)(ys + tok * PL_YSTR + 4 * (32 * hf + 8 * k)), yb = *(LAS f32x4*)(ys + tok * PL_YSTR + 4 * (32 * hf + 8 * k + 4));
          *(u32x4*)(mx + trow * DMIX + O_POOL + 64 * g + 32 * hf + 8 * k) = (u32x4){pk2(ya.x * silu_f(bf_lo(gv.x)), ya.y * silu_f(bf_hi(gv.x))), pk2(ya.z * silu_f(bf_lo(gv.y)), ya.w * silu_f(bf_hi(gv.y))),
                                                                                  pk2(yb.x * silu_f(bf_lo(gv.z)), yb.y * silu_f(bf_hi(gv.z))), pk2(yb.z * silu_f(bf_lo(gv.w)), yb.w * silu_f(bf_hi(gv.w)))}; } }
    __syncthreads();
}

constexpr int U_HG = 128, U_AT = 1024, U_PL = 1024;
constexpr int U_ME = 256;
constexpr int U0_ME = U_HG, U0_SB = U0_ME + U_ME, U0_FX = U0_SB + U_AT, U0_PL = U0_FX + U_AT, U_TOTAL = U0_PL + U_PL;
DI void mixer_phase(ldsp lds, int layer, int cslot) {
    LAS int* slot = (LAS int*)(lds + LDS_SLOT);
    for (;;) {
        __syncthreads();
        if (threadIdx.x == 0) *slot = (int)atomicAdd((unsigned*)(kargs()->ws + WS_CTL) + 64 * cslot, 1u);
        __syncthreads();
        const int u = __builtin_amdgcn_readfirstlane(*slot);
        if (u >= U_TOTAL) break;
        kargp P = kargs();
        const bf16_t* proj = (const bf16_t*)(P->ws + WS_PROJ); bf16_t* mixed = (bf16_t*)(P->ws + WS_MIX);
        if (u < U0_ME) {
#ifndef NO_HGRN
            const int b = u >> 2, h = u & 3;
#pragma unroll 1
            for (int rep = 0; rep < ((PROBE_UNIT & 1) ? 2 : 1); ++rep)
            hgrn_unit(lds, proj + (size_t)b * SEQ * NP, mixed + (size_t)b * SEQ * DMIX, h, layer, P->lb_logits, P->hgrn_out_norm + layer * 256);
#endif
        } else if (u < U0_SB) {
#ifndef NO_MEM
            const int i = u - U0_ME, qt = 4 * (i >> 7), bh = i & 127, b = bh >> 2, h = bh & 3;
            const bf16_t* pb = proj + (size_t)b * SEQ * NP + h * HD; bf16_t* ob = mixed + (size_t)b * SEQ * DMIX + O_MEM + h * HD;
            const bf16_t* kb = (const bf16_t*)(P->ws + WS_KVM + layer * KVM_BYTES) + (size_t)b * NMEM * 512 + h * HD;
#pragma unroll 1
            for (int rep = 0; rep < ((PROBE_UNIT & 8) ? 2 : 1); ++rep)
            attn_unit<2>(lds, pb + C_MQ, kb, kb + 256, 512, pb + C_MG, ob, nullptr, P->mem_q_norm + layer * HD, P->mem_k_norm + layer * HD, qt, 4);
#endif
        } else if (u < U0_FX) {
#ifndef NO_SB
            const int i = u - U0_SB, qt = 7 - (i >> 7), bh = i & 127, b = bh >> 2, h = bh & 3;
            const bf16_t* pb = proj + (size_t)b * SEQ * NP + h * HD; bf16_t* ob = mixed + (size_t)b * SEQ * DMIX + O_SB + h * HD;
#pragma unroll 1
            for (int rep = 0; rep < ((PROBE_UNIT & 2) ? 2 : 1); ++rep)
            attn_unit<1>(lds, pb + C_SQ, pb + C_SK, pb + C_SV, NP, pb + C_SG, ob, nullptr, nullptr, nullptr, qt, 1);
#endif
        } else if (u < U0_PL) {
#ifndef NO_FOX
            const int i = u - U0_FX, qt = 7 - (i >> 7), bh = i & 127, b = bh >> 2, h = bh & 3;
            const bf16_t* pb = proj + (size_t)b * SEQ * NP + h * HD; bf16_t* ob = mixed + (size_t)b * SEQ * DMIX + O_FOX + h * HD;
            const float* lfp = (const float*)(P->ws + WS_LF) + (size_t)b * SEQ * 4 + h;
#pragma unroll 1
            for (int rep = 0; rep < ((PROBE_UNIT & 4) ? 2 : 1); ++rep)
            attn_unit<0>(lds, pb + C_FQ, pb + C_FK, pb + C_FV, NP, pb + C_FG, ob, lfp, P->fox_q_norm + layer * HD, P->fox_k_norm + layer * HD, qt, 1);
#endif
        } else {
#ifndef NO_POOL
            const int i = u - U0_PL, b = i >> 5, t0 = (i & 31) * 64;
#pragma unroll 1
            for (int rep = 0; rep < ((PROBE_UNIT & 16) ? 2 : 1); ++rep)
            pool_unit(lds, proj + (size_t)b * SEQ * NP, mixed + (size_t)b * SEQ * DMIX, t0, (const bf16_t*)(P->ws + WS_WPOOL + layer * WPOOL_BYTES), P->pool_scale + layer * 256);
#endif
        }
    }
}

#define XB_TMO      128
#define XB_XCNT(j)  (256  + 64 * (j))
#define XB_XSUB(j)  (1280 + 64 * (j))
#define XB_XGEN(j)  (2304 + 64 * (j))
#define XB_TOP      3328
#define XB_TOPGEN   3392
#define XCD_BAR_WORDS 3456
#define XB_SPIN_CAP (1u << 18)

__device__ __forceinline__ unsigned xb_ld(unsigned* p)              { return __hip_atomic_load(p, __ATOMIC_RELAXED, __HIP_MEMORY_SCOPE_AGENT); }
__device__ __forceinline__ unsigned xb_add(unsigned* p, unsigned v) { return __hip_atomic_fetch_add(p, v, __ATOMIC_RELAXED, __HIP_MEMORY_SCOPE_AGENT); }
__device__ __forceinline__ unsigned xb_xcc_id() { return (unsigned)__builtin_amdgcn_s_getreg((3 << 11) | 20) & 0xFu; }
#define XB_SPIN(cond, bar) do { unsigned _sp = 0; while (cond) { __builtin_amdgcn_s_sleep(1); \
    if ((++_sp & 255u) == 0u) { if (xb_ld(&(bar)[XB_TMO])) break; if (_sp > XB_SPIN_CAP) { atomicAdd(&(bar)[XB_TMO], 1u); break; } } } } while (0)

struct XcdBarrier {
    unsigned* bar; unsigned x;
    volatile LAS unsigned* st;
};

__device__ __forceinline__ XcdBarrier xcd_barrier_post(unsigned* bar, volatile LAS unsigned* st) {
    XcdBarrier b; b.bar = bar; b.x = xb_xcc_id(); b.st = st;
    if (threadIdx.x == 0) (void)xb_add(&bar[XB_XCNT(b.x)], 1u);
    return b;
}
__device__ __forceinline__ void xcd_barrier_complete(unsigned* bar, unsigned x, unsigned& nloc, unsigned& nx) {
    const unsigned G = gridDim.x * gridDim.y * gridDim.z;
    unsigned sum, cnt, mine, sp = 0u;
    for (;;) {
        sum = 0u; cnt = 0u; mine = 0u;
#pragma unroll
        for (unsigned j = 0; j < 16; ++j) { const unsigned c = xb_ld(&bar[XB_XCNT(j)]); sum += c; cnt += (c > 0u) ? 1u : 0u; mine = (j == x) ? c : mine; }
        if (sum == G) break;
        __builtin_amdgcn_s_sleep(1);
        if ((++sp & 255u) == 0u) { if (xb_ld(&bar[XB_TMO])) break; if (sp > XB_SPIN_CAP) { atomicAdd(&bar[XB_TMO], 1u); break; } }
    }
    nloc = mine > 0u ? mine : 1u; nx = cnt > 0u ? cnt : 1u;
}

__device__ __forceinline__ void xcd_barrier(const XcdBarrier& b) {
    asm volatile("s_waitcnt vmcnt(0)" ::: "memory");
    __syncthreads();
    if (threadIdx.x == 0) {
        unsigned* bar = b.bar;
        __builtin_amdgcn_s_waitcnt(0);
        unsigned nloc = b.st[0], nx = b.st[1];
        if (nloc == 0u) { xcd_barrier_complete(bar, b.x, nloc, nx); b.st[0] = nloc; b.st[1] = nx; }
        const unsigned old = xb_add(&bar[XB_XSUB(b.x)], 1u);
        const unsigned gen = old / nloc;
        if (old + 1u == (gen + 1u) * nloc) {
            __builtin_amdgcn_fence(__ATOMIC_RELEASE, "agent");
            asm volatile("s_waitcnt vmcnt(0)" ::: "memory");
            const unsigned og = xb_add(&bar[XB_TOP], 1u);
            const unsigned tg = og / nx;
            if (og + 1u == (tg + 1u) * nx) xb_add(&bar[XB_TOPGEN], 1u);
            else XB_SPIN(xb_ld(&bar[XB_TOPGEN]) == tg, bar);
            __builtin_amdgcn_fence(__ATOMIC_ACQUIRE, "agent");
            xb_add(&bar[XB_XGEN(b.x)], 1u);
            asm volatile("s_waitcnt vmcnt(0)" ::: "memory");
        } else {
            XB_SPIN(xb_ld(&bar[XB_XGEN(b.x)]) == gen, bar);
            __builtin_amdgcn_fence(__ATOMIC_ACQUIRE, "agent");
            asm volatile("s_waitcnt vmcnt(0)" ::: "memory");
        }
    }
    __syncthreads();
}

constexpr int CW_XBAR = 1024;
DI void seam_barrier(ldsp lds) {
    XcdBarrier b; b.bar = (unsigned*)(kargs()->ws + WS_CTL) + CW_XBAR; b.x = xb_xcc_id(); b.st = (volatile LAS unsigned*)(lds + LDS_BYTES - 32);
    xcd_barrier(b);
}

constexpr int N_PHASES = 8;
DI void in_gemm(ldsp lds, int layer) {
    kargp P = kargs(); unsigned char* ws = P->ws;
    pg8::Gemm g{(const bf16_t*)(ws + WS_HB), (const bf16_t*)(ws + WS_WIN + layer * WIN_BYTES), NTOK, NP, DM}; pg8::StaticOrder S; S.init(NTOK, NP, gridDim.x, blockIdx.x);
    if (EPI_NORM && layer == 1) {
        { const int tid = threadIdx.x, lane = tid & 63, wave = __builtin_amdgcn_readfirstlane(tid >> 6), p16 = lane & 15;
          const float* ssp = (const float*)(ws + WS_SSP); const float* ffp = (const float*)(ws + WS_FFP); float* lf = (float*)(ws + WS_LF);
          const f32x4 bias = *(const f32x4*)(P->fox_f_bias + NH);
          for (int r4 = blockIdx.x * 8 + wave; r4 < NTOK / 4; r4 += gridDim.x * 8) { const size_t row = (size_t)r4 * 4 + (lane >> 4);
              const float s1 = sum16(ssp[row * 16 + p16]); f32x4 f = *(const f32x4*)(ffp + (row * 16 + p16) * 4);
              f.x = sum16(f.x); f.y = sum16(f.y); f.z = sum16(f.z); f.w = sum16(f.w);
              const float rstd = 1.0f / sqrtf(s1 * (1.f / DM) + EPS);
              if (p16 < 4) { const float z = (p16 == 0 ? f.x : p16 == 1 ? f.y : p16 == 2 ? f.z : f.w) * rstd + (p16 == 0 ? bias.x : p16 == 1 ? bias.y : p16 == 2 ? bias.z : bias.w);
                  lf[row * 4 + p16] = fminf(z, 0.f) - log1pf(expf(-fabsf(z))); } } }
        pg8::EpiBf16RowScale E{(bf16_t*)(ws + WS_PROJ), NP, (const float*)(ws + WS_SSP), 1.f / DM, EPS};
        pg8::gemm_phase<pg8::EpiBf16RowScale, pg8::StaticOrder, true, true>(lds, g, S, E);
    } else {
        pg8::EpiBf16<0> E{(bf16_t*)(ws + WS_PROJ), NP, nullptr, 0, 0, 1.f};
        pg8::gemm_phase<pg8::EpiBf16<0>, pg8::StaticOrder, true, true>(lds, g, S, E);
    }
}
DI void kv_gemm(ldsp lds) {
    const int bid = blockIdx.x; if (bid >= 128) return;
    kargp P = kargs(); unsigned char* ws = P->ws; const int l2 = bid >> 6;
    pg8::Gemm g{(const bf16_t*)(ws + WS_MNB + l2 * MNB_BYTES), (const bf16_t*)(ws + WS_WKV + l2 * WKV_BYTES), NB * NMEM, 512, DM}; pg8::StaticOrder S; S.init(NB * NMEM, 512, 64, bid & 63);
    pg8::EpiBf16<0> E{(bf16_t*)(ws + WS_KVM + l2 * KVM_BYTES), 512, nullptr, 0, 0, 1.f};
    pg8::gemm_phase<pg8::EpiBf16<0>, pg8::StaticOrder, true, true>(lds, g, S, E);
}
DI void out_gemm(ldsp lds, int layer) {
    kargp P = kargs(); unsigned char* ws = P->ws;
    pg8::Gemm g{(const bf16_t*)(ws + WS_MIX), (const bf16_t*)(ws + WS_WOUT + layer * WOUT_BYTES), NTOK, DM, DMIX}; pg8::StaticOrder S; S.init(NTOK, DM, gridDim.x, blockIdx.x);
    if (EPI_NORM && layer == 0) { pg8::EpiResStats E{P->x, P->out, DM, (unsigned short*)(ws + WS_HB), (const float*)(ws + WS_GW), (float*)(ws + WS_SSP), (float*)(ws + WS_FFP)};
        pg8::gemm_phase<pg8::EpiResStats, pg8::StaticOrder, true, true>(lds, g, S, E); }
    else { pg8::EpiRes E{layer == 0 ? P->x : P->out, P->out, DM};
        pg8::gemm_phase<pg8::EpiRes, pg8::StaticOrder, true, true>(lds, g, S, E); }
    if (FUSE_NORM && layer + 1 < DEPTH) {
        const int tid = threadIdx.x, lane = tid & 63, wave = __builtin_amdgcn_readfirstlane(tid >> 6);
        __threadfence();
        __syncthreads();
        LAS int* todo = (LAS int*)(lds + 16384);
        if (tid == 0) { int cnt = 0; pg8::Unit u;
            for (int i = 0; S.next(i, u); ++i) { const unsigned old = atomicAdd((unsigned*)(kargs()->ws + WS_CTL) + 256 + u.pm, 1u); if (old == (unsigned)(DM / 256 - 1)) todo[1 + cnt++] = u.pm; }
            todo[0] = cnt; }
        __syncthreads();
        const int ncnt = __builtin_amdgcn_readfirstlane(todo[0]);
        int pms[4];
#pragma unroll
        for (int i = 0; i < 4; ++i) pms[i] = __builtin_amdgcn_readfirstlane(todo[1 + (i < ncnt ? i : 0)]);
        __threadfence();
        if (ncnt > 0) {
            kargp Q = kargs(); const int nl = layer + 1;
#pragma unroll 1
            for (int i = 0; i < ncnt; ++i) { const int pm = i == 0 ? pms[0] : i == 1 ? pms[1] : i == 2 ? pms[2] : pms[3];
                norm_phase(lds, Q->out, Q->norm_g + nl * DM, Q->w_in + (size_t)nl * DM * DIN, Q->fox_f_bias + nl * NH, (bf16_t*)(Q->ws + WS_HB), (float*)(Q->ws + WS_LF), pm * 256 + wave, 8, pm * 256 + 256, tid, lane); }
        }
    }
}
DI void do_norm(ldsp lds, int nl) {
    kargp P = kargs(); const int tid = threadIdx.x, lane = tid & 63, wave = __builtin_amdgcn_readfirstlane(tid >> 6);
    norm_phase(lds, nl ? P->out : P->x, P->norm_g + nl * DM, P->w_in + (size_t)nl * DM * DIN, P->fox_f_bias + nl * NH, (bf16_t*)(P->ws + WS_HB), (float*)(P->ws + WS_LF), blockIdx.x * 8 + wave, gridDim.x * 8, NTOK, tid, lane);
}
__global__ void __launch_bounds__(512, 2) hybrid_fwd(Params Parg) {
    extern __shared__ __attribute__((aligned(16))) unsigned char lds_raw[];
    ldsp lds = (ldsp)lds_raw;
    const int lo = kargs()->ph_lo, hi = kargs()->ph_hi;
    { volatile LAS unsigned* bst = (volatile LAS unsigned*)(lds + LDS_BYTES - 32);
      if (threadIdx.x < 2) bst[threadIdx.x] = 0u;
      __syncthreads();
      (void)xcd_barrier_post((unsigned*)(kargs()->ws + WS_CTL) + CW_XBAR, bst); }
#define IN(k) (lo <= (k) && (k) < hi)
#define SEAM(k) do { if (IN(k) && IN((k) + 1) && !(EPI_NORM && (k) == 4)) { if ((k) == 0) cg::this_grid().sync(); else seam_barrier(lds); } } while (0)
    if (IN(0)) {
        const int tid = threadIdx.x, lane = tid & 63, wave = __builtin_amdgcn_readfirstlane(tid >> 6);
        weights_phase(lds, blockIdx.x * 8 + wave, gridDim.x * 8, wave, lane);
        __syncthreads();
        memnorm_phase(blockIdx.x * 8 + wave, gridDim.x * 8, lane);
        do_norm(lds, 0);
    }
    SEAM(0);
    if (IN(1)) { in_gemm(lds, 0); kv_gemm(lds);
#if PROBE_PH & 2
        __syncthreads(); in_gemm(lds, 0);
#endif
    }
    SEAM(1);
    if (IN(2)) { mixer_phase(lds, 0, 0);
#if PROBE_PH & 4
        mixer_phase(lds, 0, 2);
#endif
    }
    SEAM(2);
    if (IN(3)) out_gemm(lds, 0);
    SEAM(3);
    if (IN(4) && !EPI_NORM) do_norm(lds, 1);
    SEAM(4);
    if (IN(5)) in_gemm(lds, 1);
    SEAM(5);
    if (IN(6)) mixer_phase(lds, 1, 1);
    SEAM(6);
    if (IN(7)) out_gemm(lds, 1);
#undef IN
#undef SEAM
}

extern "C" void kernel_launch(void* const* d_in, const int* in_sizes, int n_in, void* d_out, int out_size, void* d_ws, size_t ws_size, hipStream_t stream) {
    static int grid = 0;
    if (grid == 0) {
        if (n_in != 16 || in_sizes[0] != NTOK * DM || out_size != NTOK * DM || ws_size < WS_END) { fprintf(stderr, "kernel_launch: unexpected shapes (n_in %d, in0 %d, out %d, ws %zu)\n", n_in, n_in > 0 ? in_sizes[0] : -1, out_size, ws_size); grid = -1; return; }
        int dev = 0, cus = 0, per_cu = 0;
        (void)hipGetDevice(&dev); (void)hipDeviceGetAttribute(&cus, hipDeviceAttributeMultiprocessorCount, dev);
        if (hipFuncSetAttribute((const void*)hybrid_fwd, hipFuncAttributeMaxDynamicSharedMemorySize, LDS_BYTES) != hipSuccess) { fprintf(stderr, "kernel_launch: hipFuncSetAttribute failed\n"); grid = -1; return; }
        if (hipOccupancyMaxActiveBlocksPerMultiprocessor(&per_cu, (const void*)hybrid_fwd, 512, LDS_BYTES) != hipSuccess || per_cu < 1) { fprintf(stderr, "kernel_launch: occupancy query gave %d\n", per_cu); per_cu = 1; }
        (void)hipGetLastError();
        grid = cus * per_cu;
    }
    if (grid < 0) return;
    (void)hipMemsetAsync((char*)d_ws + WS_CTL, 0, CTL_ZERO_BYTES, stream);
    Params p{};
    p.x = (const float*)d_in[0]; p.mem = (const float*)d_in[1]; p.norm_g = (const float*)d_in[2]; p.w_in = (const float*)d_in[3]; p.fox_f_bias = (const float*)d_in[4];
    p.fox_q_norm = (const float*)d_in[5]; p.fox_k_norm = (const float*)d_in[6]; p.lb_logits = (const float*)d_in[7]; p.hgrn_out_norm = (const float*)d_in[8]; p.pool_w = (const float*)d_in[9];
    p.pool_scale = (const float*)d_in[10]; p.mem_norm_g = (const float*)d_in[11]; p.mem_w_kv = (const float*)d_in[12]; p.mem_q_norm = (const float*)d_in[13]; p.mem_k_norm = (const float*)d_in[14];
    p.w_out = (const float*)d_in[15]; p.out = (float*)d_out; p.ws = (unsigned char*)d_ws;
#if MK_SINGLE_LAUNCH
    p.ph_lo = 0; p.ph_hi = N_PHASES;
    void* args[] = {&p};
    const hipError_t e = hipLaunchCooperativeKernel((const void*)hybrid_fwd, dim3(grid), dim3(512), args, LDS_BYTES, stream);
    if (e != hipSuccess) fprintf(stderr, "kernel_launch: cooperative launch failed: %s (grid %d)\n", hipGetErrorString(e), grid);
#else
    for (int ph = 0; ph < N_PHASES; ++ph) { p.ph_lo = ph; p.ph_hi = ph + 1; hipLaunchKernelGGL(hybrid_fwd, dim3(grid), dim3(512), LDS_BYTES, stream, p); }
#endif
}
```

```cpp
#include <hip/hip_runtime.h>
#include <hip/hip_cooperative_groups.h>
#include <cstdio>
#include <cstdint>
namespace cg = cooperative_groups;
namespace pg8 {
#define PG8_LAS __attribute__((address_space(3)))
typedef unsigned short bf16_t;
typedef short bf16x8 __attribute__((ext_vector_type(8)));
typedef float f32x4 __attribute__((ext_vector_type(4)));
typedef unsigned u32x4 __attribute__((ext_vector_type(4)));
constexpr int BM = 256, BK = 64, HALF = 128, HTB = HALF * BK * 2  , STAGE_BYTES = 8 * HTB, NXCD = 8, WGM = 8;

__host__ __device__ __forceinline__ int lds_byte(int r, int c) { const int st = (r >> 4) * 2 + (c >> 5), rr = r & 15, cc = c & 31, ob = rr * 64 + cc * 2; return st * 1024 + (ob ^ (((ob >> 9) & 1) << 5)); }
__host__ __device__ __forceinline__ void stage_rc(int b, int& R, int& C) { const int st = b / 1024, sb = b % 1024, swz = sb ^ (((sb >> 9) & 1) << 5); R = (st >> 1) * 16 + swz / 64; C = (st & 1) * 32 + (swz % 64) / 2; }
__host__ __device__ __forceinline__ int perm32(int rho) { const int n = rho >> 4, i = rho & 15; return 8 * (i >> 2) + 4 * n + (i & 3); }

struct Unit { int pm, pn; };
struct Gemm { const bf16_t* A; const bf16_t* Bt; int M, N, K; };

struct StaticOrder {
    int nM, nN, nwg, G, c;
    __host__ __device__ void init(int M, int N, int G_, int c_) { nM = M / BM; nN = N / BM; nwg = nM * nN; G = G_; c = c_; }
    __host__ __device__ bool next(int i, Unit& u) const {
        const long L = (long)i * G + c; if (L >= nwg) return false;
        int wgid = (int)L; { const int q = nwg / NXCD, r = nwg % NXCD, xcd = wgid % NXCD, off = wgid / NXCD; wgid = (xcd < r ? xcd * (q + 1) : r * (q + 1) + (xcd - r) * q) + off; }
        const int nig = WGM * nN, gid = wgid / nig, fm = gid * WGM, gsz = (nM - fm) < WGM ? (nM - fm) : WGM;
        u.pm = fm + ((wgid % nig) % gsz); u.pn = (wgid % nig) / gsz; return true;
    }
    __device__ __forceinline__ void a_ready(const Unit&) const {}
    __device__ __forceinline__ void done(const Unit&) const {}
};

__device__ __forceinline__ unsigned cvt_pk_bf16(float lo, float hi) { unsigned r; asm volatile("v_cvt_pk_bf16_f32 %0, %1, %2" : "=v"(r) : "v"(lo), "v"(hi)); return r; }
typedef float f32x2 __attribute__((ext_vector_type(2)));
__device__ __forceinline__ f32x2 gelu_pk(f32x2 v) {
    const f32x2 av = __builtin_elementwise_abs(v), d = av * 0.2316418882f + 1.0f;
    f32x2 t; t.x = __builtin_amdgcn_rcpf(d.x); t.y = __builtin_amdgcn_rcpf(d.y);
    f32x2 q = t * 0.5307027145f + (-0.7265760135f); q = q * t + 0.7107068705f; q = q * t + (-0.142248368f); q = q * t + 0.127414796f; q = q * t;
    const f32x2 s = (v * v) * (-0.72134752044f);
    f32x2 e; e.x = __builtin_amdgcn_exp2f(s.x); e.y = __builtin_amdgcn_exp2f(s.y);
    const f32x2 m = v * (q * e), r = v - m;
    f32x2 o; o.x = v.x < 0.f ? m.x : r.x; o.y = v.y < 0.f ? m.y : r.y; return o;
}

template <int ACT  > struct EpiBf16 {
    static constexpr bool PERM = true, AFTER_DRAIN = false; static_assert(ACT == 0 || ACT == 1, "EpiBf16: ACT is 0 (none) or 1 (gelu_pk)");
    bf16_t* O; int ldc; const float* bias; int split_cols; size_t split_stride; float scale0;
    __device__ __forceinline__ void operator()(const f32x4 (&acc)[2][2][4][2], const Unit& u, int wr, int wc, int fr, int fq) const {
        const int row0 = u.pm * BM + wr * 64 + fr; int colt = u.pn * BM; bf16_t* base = O;
        float sc = 1.f; if (split_cols) { const int t = colt / split_cols; base += (size_t)t * split_stride; colt -= t * split_cols; if (t == 0) sc = scale0; }
        const int col0 = colt + wc * 32 + 8 * fq, bcol0 = u.pn * BM + wc * 32 + 8 * fq;
        f32x4 bv[2][2];
#pragma unroll
        for (int bj = 0; bj < 2; ++bj)
#pragma unroll
            for (int n = 0; n < 2; ++n) bv[bj][n] = bias ? *(const f32x4*)(bias + bcol0 + bj * HALF + 4 * n) : (f32x4){0.f, 0.f, 0.f, 0.f};
#pragma unroll
        for (int ai = 0; ai < 2; ++ai)
#pragma unroll
            for (int m = 0; m < 4; ++m) { bf16_t* rowp = base + (size_t)(row0 + ai * HALF + m * 16) * ldc + col0;
#pragma unroll
                for (int bj = 0; bj < 2; ++bj) { f32x4 v0 = acc[ai][bj][m][0] + bv[bj][0], v1 = acc[ai][bj][m][1] + bv[bj][1];
                    if (ACT == 1) { f32x2 a = gelu_pk((f32x2){v0[0], v0[1]}), b = gelu_pk((f32x2){v0[2], v0[3]}), c = gelu_pk((f32x2){v1[0], v1[1]}), d = gelu_pk((f32x2){v1[2], v1[3]});
                        v0 = (f32x4){a.x, a.y, b.x, b.y}; v1 = (f32x4){c.x, c.y, d.x, d.y}; }
                    v0 = v0 * sc; v1 = v1 * sc; u32x4 w; w.x = cvt_pk_bf16(v0[0], v0[1]); w.y = cvt_pk_bf16(v0[2], v0[3]); w.z = cvt_pk_bf16(v1[0], v1[1]); w.w = cvt_pk_bf16(v1[2], v1[3]);
                    *(u32x4*)(rowp + bj * HALF) = w; } }
    }
};

struct EpiRes {
    static constexpr bool PERM = false, AFTER_DRAIN = false;
    const float* base; float* out; int ldc;
    __device__ __forceinline__ void operator()(const f32x4 (&acc)[2][2][4][2], const Unit& u, int wr, int wc, int fr, int fq) const {
        const int col0 = u.pn * BM + wc * 32 + 4 * fq;
#pragma unroll
        for (int ai = 0; ai < 2; ++ai)
#pragma unroll
            for (int m = 0; m < 4; ++m) { const size_t off = (size_t)(u.pm * BM + ai * HALF + wr * 64 + m * 16 + fr) * ldc + col0;
#pragma unroll
                for (int bj = 0; bj < 2; ++bj)
#pragma unroll
                    for (int n = 0; n < 2; ++n) { const f32x4 bs = *(const f32x4*)(base + off + bj * HALF + n * 16); *(f32x4*)(out + off + bj * HALF + n * 16) = bs + acc[ai][bj][m][n]; } }
    }
};

struct EpiResStats {
    static constexpr bool PERM = false, AFTER_DRAIN = false;
    const float* base; float* out; int ldc; unsigned short* xb; const float* gw  ; float* ssp  ; float* ffp  ;
    __device__ __forceinline__ void operator()(const f32x4 (&acc)[2][2][4][2], const Unit& u, int wr, int wc, int fr, int fq) const {
        const int col0 = u.pn * BM + wc * 32 + 4 * fq;
#pragma unroll
        for (int ai = 0; ai < 2; ++ai)
#pragma unroll
            for (int m = 0; m < 4; ++m) {
                float ss = 0.f; f32x4 ff = {0.f, 0.f, 0.f, 0.f};
                const size_t rbase = (size_t)(u.pm * BM + ai * HALF + wr * 64 + m * 16 + fr);
#pragma unroll
                for (int bj = 0; bj < 2; ++bj)
#pragma unroll
                    for (int n = 0; n < 2; ++n) {
                        const int c = col0 + bj * HALF + n * 16; const size_t off = rbase * ldc + c;
                        const f32x4 o = *(const f32x4*)(base + off) + acc[ai][bj][m][n];
                        *(f32x4*)(out + off) = o;
                        typedef unsigned u32x2_ __attribute__((ext_vector_type(2)));
                        *(u32x2_*)(xb + off) = (u32x2_){cvt_pk_bf16(o[0], o[1]), cvt_pk_bf16(o[2], o[3])};
                        ss += (o[0] * o[0] + o[1] * o[1]) + (o[2] * o[2] + o[3] * o[3]);
                        ff += *(const f32x4*)(gw + 4 * (size_t)c) * o[0] + *(const f32x4*)(gw + 4 * (size_t)c + 4) * o[1] + *(const f32x4*)(gw + 4 * (size_t)c + 8) * o[2] + *(const f32x4*)(gw + 4 * (size_t)c + 12) * o[3]; }
                float v5[5] = {ss, ff[0], ff[1], ff[2], ff[3]};
#pragma unroll
                for (int q = 0; q < 5; ++q) { auto a_ = __builtin_amdgcn_permlane16_swap(__float_as_uint(v5[q]), __float_as_uint(v5[q]), false, false); const float s_ = __uint_as_float(a_[0]) + __uint_as_float(a_[1]);
                    auto b_ = __builtin_amdgcn_permlane32_swap(__float_as_uint(s_), __float_as_uint(s_), false, false); v5[q] = __uint_as_float(b_[0]) + __uint_as_float(b_[1]); }
                if (fq == 0) { const int slot = u.pn * 4 + wc; ssp[rbase * 16 + slot] = v5[0]; *(f32x4*)(ffp + (rbase * 16 + slot) * 4) = (f32x4){v5[1], v5[2], v5[3], v5[4]}; }
                asm volatile("" ::: "memory");
            }
    }
};
struct EpiBf16RowScale {
    static constexpr bool PERM = true, AFTER_DRAIN = false;
    bf16_t* O; int ldc; const float* ssp; float inv_k, eps;
    __device__ __forceinline__ void operator()(const f32x4 (&acc)[2][2][4][2], const Unit& u, int wr, int wc, int fr, int fq) const {
        const int row0 = u.pm * BM + wr * 64 + fr; const int col0 = u.pn * BM + wc * 32 + 8 * fq;
#pragma unroll
        for (int ai = 0; ai < 2; ++ai)
#pragma unroll
            for (int m = 0; m < 4; ++m) { const size_t row = (size_t)(row0 + ai * HALF + m * 16);
                const f32x4 a = *(const f32x4*)(ssp + row * 16), b = *(const f32x4*)(ssp + row * 16 + 4), c = *(const f32x4*)(ssp + row * 16 + 8), d = *(const f32x4*)(ssp + row * 16 + 12);
                const float tot = ((a[0] + a[1]) + (a[2] + a[3])) + ((b[0] + b[1]) + (b[2] + b[3])) + ((c[0] + c[1]) + (c[2] + c[3])) + ((d[0] + d[1]) + (d[2] + d[3]));
                const float sc = 1.0f / sqrtf(tot * inv_k + eps);
                bf16_t* rowp = O + row * ldc + col0;
#pragma unroll
                for (int bj = 0; bj < 2; ++bj) { const f32x4 v0 = acc[ai][bj][m][0] * sc, v1 = acc[ai][bj][m][1] * sc;
                    u32x4 w; w.x = cvt_pk_bf16(v0[0], v0[1]); w.y = cvt_pk_bf16(v0[2], v0[3]); w.z = cvt_pk_bf16(v1[0], v1[1]); w.w = cvt_pk_bf16(v1[2], v1[3]);
                    *(u32x4*)(rowp + bj * HALF) = w; } }
    }
};
template <class Epi, class Sched, bool ALIGN_EPI = false, bool SP2 = false>
__device__ __forceinline__ void gemm_phase(PG8_LAS unsigned char* lds, const Gemm g, const Sched& S, const Epi& E) {
    const int tid = threadIdx.x, wid = __builtin_amdgcn_readfirstlane(tid >> 6), lane = tid & 63, wr = wid >> 2, wc = wid & 3, fr = lane & 15, fq = lane >> 4;
    const int K = g.K, nt = K / BK;
    unsigned voffA[2], voffB[2];
#pragma unroll
    for (int i = 0; i < 2; ++i) { int R, C; stage_rc(tid * 16 + i * 8192, R, C); const int Rb = Epi::PERM ? ((R & ~31) + perm32(R & 31)) : R;
        voffA[i] = (unsigned)(R * K + C) * 2u; voffB[i] = (unsigned)(Rb * K + C) * 2u; }
    const size_t kstep = (size_t)(BK * 2);
    const size_t hstep = (size_t)HALF * K * 2;
    const size_t tstep = 2 * hstep;
    const unsigned ldsw = (unsigned)wid * 1024u;
    const int aoff = lds_byte(wr * 64 + fr, fq * 8), boff = lds_byte(wc * 32 + fr, fq * 8);
#define PG8_SA(b, h) (((b) * 2 + (h)) * HTB)
#define PG8_SB(b, h) ((4 + (b) * 2 + (h)) * HTB)
#define PG8_STAGE(bufoff, gbase, voff) do { _Pragma("unroll") for (int _i = 0; _i < 2; ++_i) \
        __builtin_amdgcn_global_load_lds((const unsigned*)((const char*)(gbase) + (voff)[_i]), (PG8_LAS unsigned*)(lds + (bufoff) + ldsw + _i * 8192), 16, 0, 0); } while (0)
#define PG8_LDA(dst, b, h) do { _Pragma("unroll") for (int m = 0; m < 4; ++m) _Pragma("unroll") for (int k = 0; k < 2; ++k) dst[m][k] = *(const PG8_LAS bf16x8*)(lds + PG8_SA(b, h) + aoff + m * 2048 + k * 1024); } while (0)
#define PG8_LDB(dst, b, h) do { _Pragma("unroll") for (int n = 0; n < 2; ++n) _Pragma("unroll") for (int k = 0; k < 2; ++k) dst[n][k] = *(const PG8_LAS bf16x8*)(lds + PG8_SB(b, h) + boff + n * 2048 + k * 1024); } while (0)
#define PG8_MMA(ai, bj, At, Bt) do { __builtin_amdgcn_s_setprio(1); _Pragma("unroll") for (int m = 0; m < 4; ++m) _Pragma("unroll") for (int n = 0; n < 2; ++n) _Pragma("unroll") for (int k = 0; k < 2; ++k) \
        acc[ai][bj][m][n] = __builtin_amdgcn_mfma_f32_16x16x32_bf16(Bt[n][k], At[m][k], acc[ai][bj][m][n], 0, 0, 0); __builtin_amdgcn_s_setprio(0); } while (0)
#define PG8_WAIT_V(n) asm volatile("s_waitcnt vmcnt(" #n ")" ::: "memory")
#define PG8_WAIT_L(n) asm volatile("s_waitcnt lgkmcnt(" #n ")" ::: "memory")
#define PG8_BAR __builtin_amdgcn_s_barrier()
#define PG8_SCHED __builtin_amdgcn_sched_barrier(0)
    Unit cur, nxt; int ui = 0;
    if (!S.next(0, cur)) return;
    f32x4 acc[2][2][4][2];
#pragma unroll
    for (int a = 0; a < 2; ++a)
#pragma unroll
        for (int b = 0; b < 2; ++b)
#pragma unroll
            for (int m = 0; m < 4; ++m)
#pragma unroll
                for (int n = 0; n < 2; ++n) acc[a][b][m][n] = (f32x4){0.f, 0.f, 0.f, 0.f};
    bf16x8 At[4][2], B0[2][2], B1[2][2];
    const char* cA = (const char*)g.A + (size_t)cur.pm * tstep; const char* cB = (const char*)g.Bt + (size_t)cur.pn * tstep;
    S.a_ready(cur);
    if constexpr (SP2) {
        PG8_STAGE(PG8_SB(0, 0), cB, voffB); PG8_STAGE(PG8_SB(0, 1), cB + hstep, voffB); PG8_STAGE(PG8_SA(0, 0), cA, voffA); PG8_STAGE(PG8_SA(0, 1), cA + hstep, voffA);
        if (wr == 1) PG8_BAR;
        PG8_WAIT_V(2); PG8_BAR;
        PG8_STAGE(PG8_SB(1, 0), cB + kstep, voffB); PG8_STAGE(PG8_SA(1, 0), cA + kstep, voffA); PG8_STAGE(PG8_SB(1, 1), cB + hstep + kstep, voffB);
        PG8_WAIT_V(6); PG8_BAR;
    } else {
        PG8_STAGE(PG8_SB(0, 0), cB, voffB); PG8_STAGE(PG8_SA(0, 0), cA, voffA); PG8_STAGE(PG8_SB(0, 1), cB + hstep, voffB); PG8_STAGE(PG8_SA(0, 1), cA + hstep, voffA);
        if (wr == 1) PG8_BAR;
        PG8_WAIT_V(4); PG8_BAR;
        PG8_STAGE(PG8_SB(1, 0), cB + kstep, voffB); PG8_STAGE(PG8_SA(1, 0), cA + kstep, voffA); PG8_STAGE(PG8_SB(1, 1), cB + hstep + kstep, voffB);
        PG8_WAIT_V(6); PG8_BAR;
    }
    for (;;) {
        const bool has_next = S.next(ui + 1, nxt);
        const char* nA = has_next ? (const char*)g.A + (size_t)nxt.pm * tstep : cA; const char* nB = has_next ? (const char*)g.Bt + (size_t)nxt.pn * tstep : cB;
        for (int t = 0; t < nt; t += 2) {
            const bool last = (t == nt - 2);
            const char* a1 = cA + (size_t)(t + 1) * kstep;
            const char* a2 = last ? nA : cA + (size_t)(t + 2) * kstep; const char* b2 = last ? nB : cB + (size_t)(t + 2) * kstep;
            const char* a3 = a2 + kstep; const char* b3 = b2 + kstep;
            if (last && has_next) S.a_ready(nxt);
            if constexpr (SP2) {
            PG8_LDB(B0, 0, 0); PG8_LDB(B1, 0, 1); PG8_SCHED; PG8_LDA(At, 0, 0); PG8_STAGE(PG8_SA(1, 1), a1 + hstep, voffA);
            PG8_WAIT_V(8); PG8_WAIT_L(0); PG8_BAR; PG8_MMA(0, 0, At, B0); PG8_MMA(0, 1, At, B1); PG8_BAR; PG8_SCHED;
            PG8_LDA(At, 0, 1); PG8_STAGE(PG8_SB(0, 0), b2, voffB); PG8_STAGE(PG8_SB(0, 1), b2 + hstep, voffB); PG8_STAGE(PG8_SA(0, 0), a2, voffA);
            PG8_WAIT_V(8); PG8_WAIT_L(0); PG8_BAR; PG8_MMA(1, 0, At, B0); PG8_MMA(1, 1, At, B1); PG8_BAR; PG8_SCHED;
            PG8_LDB(B0, 1, 0); PG8_LDB(B1, 1, 1); PG8_SCHED; PG8_LDA(At, 1, 0); PG8_STAGE(PG8_SA(0, 1), a2 + hstep, voffA);
            PG8_WAIT_V(8); PG8_WAIT_L(0); PG8_BAR; PG8_MMA(0, 0, At, B0); PG8_MMA(0, 1, At, B1); PG8_BAR; PG8_SCHED;
            PG8_LDA(At, 1, 1); PG8_STAGE(PG8_SB(1, 0), b3, voffB); PG8_STAGE(PG8_SB(1, 1), b3 + hstep, voffB); PG8_STAGE(PG8_SA(1, 0), a3, voffA);
            PG8_WAIT_V(8); PG8_WAIT_L(0); PG8_BAR; PG8_MMA(1, 0, At, B0); PG8_MMA(1, 1, At, B1); PG8_BAR; PG8_SCHED;
            } else {
            PG8_LDB(B0, 0, 0); PG8_SCHED; PG8_LDA(At, 0, 0); PG8_STAGE(PG8_SA(1, 1), a1 + hstep, voffA);
            PG8_WAIT_L(8); PG8_BAR; PG8_WAIT_L(0); PG8_MMA(0, 0, At, B0); PG8_BAR; PG8_SCHED;
            PG8_LDB(B1, 0, 1); PG8_STAGE(PG8_SB(0, 0), b2, voffB);
            PG8_BAR; PG8_WAIT_L(0); PG8_MMA(0, 1, At, B1); PG8_BAR;
            PG8_LDA(At, 0, 1); PG8_STAGE(PG8_SA(0, 0), a2, voffA);
            PG8_BAR; PG8_WAIT_L(0); PG8_MMA(1, 0, At, B0); PG8_BAR; PG8_SCHED;
            PG8_STAGE(PG8_SB(0, 1), b2 + hstep, voffB);
            PG8_WAIT_V(6); PG8_BAR; PG8_MMA(1, 1, At, B1); PG8_BAR;
            PG8_LDB(B0, 1, 0); PG8_SCHED; PG8_LDA(At, 1, 0); PG8_STAGE(PG8_SA(0, 1), a2 + hstep, voffA);
            PG8_WAIT_L(8); PG8_BAR; PG8_WAIT_L(0); PG8_MMA(0, 0, At, B0); PG8_BAR; PG8_SCHED;
            PG8_LDB(B1, 1, 1); PG8_STAGE(PG8_SB(1, 0), b3, voffB);
            PG8_BAR; PG8_WAIT_L(0); PG8_MMA(0, 1, At, B1); PG8_BAR;
            PG8_LDA(At, 1, 1); PG8_STAGE(PG8_SA(1, 0), a3, voffA);
            PG8_BAR; PG8_WAIT_L(0); PG8_MMA(1, 0, At, B0); PG8_BAR; PG8_SCHED;
            PG8_STAGE(PG8_SB(1, 1), b3 + hstep, voffB);
            PG8_WAIT_V(6); PG8_BAR; PG8_MMA(1, 1, At, B1); PG8_BAR;
            }
        }
        if constexpr (ALIGN_EPI) { if (wr == 0) PG8_BAR; }
        if constexpr (!Epi::AFTER_DRAIN) { E(acc, cur, wr, wc, fr, fq); S.done(cur); }
        if (!has_next) break;
#pragma unroll
        for (int a = 0; a < 2; ++a)
#pragma unroll
            for (int b = 0; b < 2; ++b)
#pragma unroll
                for (int m = 0; m < 4; ++m)
#pragma unroll
                    for (int n = 0; n < 2; ++n) acc[a][b][m][n] = (f32x4){0.f, 0.f, 0.f, 0.f};
        cur = nxt; cA = nA; cB = nB; ++ui;
        if constexpr (ALIGN_EPI) { if (wr == 1) PG8_BAR; }
    }
    PG8_WAIT_V(0);
    if constexpr (!ALIGN_EPI) { if (wr == 0) PG8_BAR; }
    PG8_BAR;
    if constexpr (Epi::AFTER_DRAIN) { E.fused(acc, cur, wr, wc, fr, fq, lds, wid, lane); S.done(cur); }
#undef PG8_SA
#undef PG8_SB
#undef PG8_STAGE
#undef PG8_LDA
#undef PG8_LDB
#undef PG8_MMA
#undef PG8_WAIT_V
#undef PG8_WAIT_L
#undef PG8_BAR
#undef PG8_SCHED
}
}
#ifndef EPI_NORM
#define EPI_NORM 0
#endif

#ifndef PROBE_PH
#define PROBE_PH 0
#endif
#ifndef PROBE_UNIT
#define PROBE_UNIT 0
#endif
#ifndef PROBE_SUB
#define PROBE_SUB 0
#endif
#ifndef MK_SINGLE_LAUNCH
#define MK_SINGLE_LAUNCH 1
#endif

constexpr int DM = 1024, NB = 32, SEQ = 2048, NTOK = NB * SEQ, NMEM = 256, DIN = 4100, NP = 4096, DMIX = 1280, NH = 4, HD = 64, DEPTH = 2;
constexpr float EPS = 1e-6f, LOG2E = 1.4426950408889634f;
constexpr int C_FQ = 0, C_FK = 256, C_FV = 512, C_FG = 768, C_SQ = 1024, C_SK = 1280, C_SV = 1536, C_SG = 1792, C_HQ = 2048, C_HF = 2304, C_HI = 2560, C_HG = 2816, C_PV = 3072, C_PG = 3328, C_MQ = 3584, C_MG = 3840;
constexpr int O_FOX = 0, O_SB = 256, O_HG = 512, O_POOL = 768, O_MEM = 1024;

constexpr size_t MiB = 1u << 20;
constexpr size_t WS_CTL = 0, CTL_ZERO_BYTES = 32768;
constexpr size_t WS_WIN = 2 * MiB, WIN_BYTES = (size_t)NP * DM * 2;
constexpr size_t WS_WOUT = 18 * MiB, WOUT_BYTES = (size_t)DM * DMIX * 2;
constexpr size_t WS_WKV = 24 * MiB, WKV_BYTES = (size_t)512 * DM * 2;
constexpr size_t WS_WPOOL = 27 * MiB, WPOOL_BYTES = 4 * 64 * 64 * 2;
constexpr size_t WS_LF = 26 * MiB;
constexpr size_t WS_MNB = 28 * MiB, MNB_BYTES = (size_t)NB * NMEM * DM * 2;
constexpr size_t WS_KVM = 60 * MiB, KVM_BYTES = (size_t)NB * NMEM * 512 * 2;
constexpr size_t WS_HB = 76 * MiB;
constexpr size_t WS_MIX = 204 * MiB;
constexpr size_t WS_PROJ = 364 * MiB;
constexpr size_t WS_C2 = 876 * MiB;
constexpr size_t WS_SSP = 877 * MiB;
constexpr size_t WS_FFP = 881 * MiB;
constexpr size_t WS_GW = 897 * MiB;
constexpr size_t WS_END = 898 * MiB;

constexpr int LDS_BYTES = 147456;
constexpr int LDS_SLOT = LDS_BYTES - 64;

#define LAS __attribute__((address_space(3)))
typedef LAS unsigned char* ldsp;
typedef unsigned short bf16_t;
typedef short bf16x8 __attribute__((ext_vector_type(8)));
typedef short s16x4 __attribute__((ext_vector_type(4)));
typedef float f32x16 __attribute__((ext_vector_type(16)));
typedef float f32x4 __attribute__((ext_vector_type(4)));
typedef float f32x2 __attribute__((ext_vector_type(2)));
typedef unsigned u32x4 __attribute__((ext_vector_type(4)));
typedef unsigned u32x2 __attribute__((ext_vector_type(2)));
typedef __bf16 bf16x2_t __attribute__((ext_vector_type(2)));

#define DI __device__ __forceinline__
DI float bf_lo(unsigned u) { return __uint_as_float(u << 16); }
DI float bf_hi(unsigned u) { return __uint_as_float(u & 0xffff0000u); }
DI unsigned pk2(float lo, float hi) { f32x2 v = {lo, hi}; bf16x2_t b = __builtin_convertvector(v, bf16x2_t); return __builtin_bit_cast(unsigned, b); }
DI float ex2(float x) { return __builtin_amdgcn_exp2f(x); }
DI float rcpf_(float x) { return __builtin_amdgcn_rcpf(x); }
DI float silu_f(float x) { return x * rcpf_(1.f + ex2(-x * LOG2E)); }
template <int CTRL> DI float dppf(float v) { return __uint_as_float((unsigned)__builtin_amdgcn_update_dpp(0, (int)__float_as_uint(v), CTRL, 0xF, 0xF, true)); }
DI float sum8(float v) { v += dppf<0xB1>(v); v += dppf<0x4E>(v); v += dppf<0x141>(v); return v; }
DI float sum16(float v) { v = sum8(v); v += dppf<0x140>(v); return v; }
DI float wave_sum(float v) { v = sum16(v);
    return (__int_as_float(__builtin_amdgcn_readlane(__float_as_int(v), 0)) + __int_as_float(__builtin_amdgcn_readlane(__float_as_int(v), 16))) +
           (__int_as_float(__builtin_amdgcn_readlane(__float_as_int(v), 32)) + __int_as_float(__builtin_amdgcn_readlane(__float_as_int(v), 48))); }
DI void halves(float x, float& lo, float& hi) { auto rr = __builtin_amdgcn_permlane32_swap(__float_as_uint(x), __float_as_uint(x), false, false); lo = __uint_as_float(rr[0]); hi = __uint_as_float(rr[1]); }
template <class T> DI T* launder(T* p) { asm volatile("" : "+s"(p)); return p; }
#define MFMA32(a, b, c) __builtin_amdgcn_mfma_f32_32x32x16_bf16((a), (b), (c), 0, 0, 0)

struct Params {
    const float *x, *mem, *norm_g, *w_in, *fox_f_bias, *fox_q_norm, *fox_k_norm, *lb_logits, *hgrn_out_norm, *pool_w, *pool_scale, *mem_norm_g, *mem_w_kv, *mem_q_norm, *mem_k_norm, *w_out;
    float* out; unsigned char* ws; int ph_lo, ph_hi;
};
typedef const __attribute__((address_space(4))) Params* kargp;
DI kargp kargs() { kargp p = (kargp)__builtin_amdgcn_kernarg_segment_ptr(); asm volatile("" : "+s"(p)); return p; }

DI void transpose_item(const float* W, int K, int ldw, bf16_t* WT, int k0, int src_n0, int dst_n0, LAS float* scr, int lane, const float* kscale = nullptr) {
#pragma unroll 8
    for (int i = 0; i < 32; ++i) { const int kk = 2 * i + (lane >> 5); scr[kk * 33 + (lane & 31)] = W[(size_t)(k0 + kk) * ldw + src_n0 + (lane & 31)] * (kscale ? kscale[k0 + kk] : 1.f); }
    asm volatile("s_waitcnt lgkmcnt(0)" ::: "memory");
    const int c = lane & 7;
#pragma unroll
    for (int j = 0; j < 4; ++j) { const int n = (lane >> 3) + 8 * j; const LAS float* s = scr + (8 * c) * 33 + n;
        u32x4 o; o.x = pk2(s[0 * 33], s[1 * 33]); o.y = pk2(s[2 * 33], s[3 * 33]); o.z = pk2(s[4 * 33], s[5 * 33]); o.w = pk2(s[6 * 33], s[7 * 33]);
        *(u32x4*)(WT + (size_t)(dst_n0 + n) * K + k0 + 8 * c) = o; }
    asm volatile("s_waitcnt lgkmcnt(0)" ::: "memory");
}

DI void weights_phase(ldsp lds, int gw, int NGW, int wave, int lane) {
    if (EPI_NORM) { kargp P = kargs(); float* gwt = (float*)(P->ws + WS_GW);
      for (int i = gw * 64 + lane; i < DM * 4; i += NGW * 64) { const int c = i >> 2, j = i & 3; gwt[i] = P->norm_g[DM + c] * P->w_in[(size_t)DM * DIN + (size_t)c * DIN + 1024 + j]; } }
    { kargp P = kargs(); const float* pw = P->pool_w; bf16_t* wt = (bf16_t*)(P->ws + WS_WPOOL);
      for (int i = gw * 64 + lane; i < DEPTH * 4 * 64 * 64; i += NGW * 64) { const int lg = i >> 12, c = (i >> 6) & 63, d = i & 63; wt[(lg * 64 + d) * 64 + c] = (bf16_t)(pk2(pw[i], 0.f) & 0xffffu); } }
    LAS float* scr = (LAS float*)(lds + wave * 16384);
    constexpr int I_IN = (DM / 64) * (NP / 32), I_OUT = (DMIX / 64) * (DM / 32), I_KV = (DM / 64) * (512 / 32), I_L = I_IN + I_OUT + I_KV;
    for (int it = gw; it < DEPTH * I_L; it += NGW) {
        const int l = it / I_L; int r = it % I_L; kargp P = kargs();
        if (r < I_IN) { const int nblk = NP / 32, kb = r / nblk, nb = r % nblk, n0 = 32 * nb;
            transpose_item(P->w_in + (size_t)l * DM * DIN, DM, DIN, (bf16_t*)(P->ws + WS_WIN + l * WIN_BYTES), 64 * kb, n0 + (n0 >= 1024 ? 4 : 0), n0, scr, lane, (EPI_NORM && l == 1) ? P->norm_g + DM : nullptr); continue; }
        r -= I_IN;
        if (r < I_OUT) { const int nblk = DM / 32, kb = r / nblk, nb = r % nblk;
            transpose_item(P->w_out + (size_t)l * DMIX * DM, DMIX, DM, (bf16_t*)(P->ws + WS_WOUT + l * WOUT_BYTES), 64 * kb, 32 * nb, 32 * nb, scr, lane); continue; }
        r -= I_OUT;
        { const int nblk = 512 / 32, kb = r / nblk, nb = r % nblk;
            transpose_item(P->mem_w_kv + (size_t)l * DM * 512, DM, 512, (bf16_t*)(P->ws + WS_WKV + l * WKV_BYTES), 64 * kb, 32 * nb, 32 * nb, scr, lane); }
    }
}

DI void memnorm_phase(int gw, int NGW, int lane) {
    kargp P = kargs(); const float* mng = P->mem_norm_g; const float* memp = P->mem; unsigned char* ws = P->ws;
    f32x4 g0[4], g1[4];
#pragma unroll
    for (int j = 0; j < 4; ++j) { g0[j] = ((const f32x4*)mng)[64 * j + lane]; g1[j] = ((const f32x4*)(mng + DM))[64 * j + lane]; }
    for (int m = gw; m < NB * NMEM; m += NGW) {
        const f32x4* xr = (const f32x4*)(memp + (size_t)m * DM) + lane;
        f32x4 v[4]; float s = 0.f;
#pragma unroll
        for (int j = 0; j < 4; ++j) { v[j] = xr[64 * j]; s += (v[j].x * v[j].x + v[j].y * v[j].y) + (v[j].z * v[j].z + v[j].w * v[j].w); }
        const float rstd = __builtin_amdgcn_rsqf(wave_sum(s) * (1.f / DM) + EPS);
        u32x2* o0 = (u32x2*)(ws + WS_MNB + (size_t)m * DM * 2) + lane; u32x2* o1 = (u32x2*)(ws + WS_MNB + MNB_BYTES + (size_t)m * DM * 2) + lane;
#pragma unroll
        for (int j = 0; j < 4; ++j) { const f32x4 y = v[j] * rstd; const f32x4 a = y * g0[j], b = y * g1[j];
            o0[64 * j] = (u32x2){pk2(a.x, a.y), pk2(a.z, a.w)}; o1[64 * j] = (u32x2){pk2(b.x, b.y), pk2(b.z, b.w)}; }
    }
}

DI void norm_phase(ldsp lds, const float* x, const float* g, const float* w_in_l, const float* fbias, bf16_t* hb, float* lf, int gw, int NGW, int mend, int tid, int lane) {
    for (int k = tid; k < DM; k += 512) { const int j = k >> 8, ln = (k & 255) >> 2, i = k & 3;
        *(LAS f32x4*)(lds + 16 * ((j * 4 + i) * 64 + ln)) = *(const f32x4*)(w_in_l + (size_t)k * DIN + 1024); }
    __syncthreads();
    f32x4 gv[4];
#pragma unroll
    for (int j = 0; j < 4; ++j) gv[j] = ((const f32x4*)g)[64 * j + lane];
    const float mybias = fbias[lane & 3];
    f32x4 nv[4], nv2[4];
    if (gw < mend) { const f32x4* xr = (const f32x4*)(x + (size_t)gw * DM) + lane;
#pragma unroll
        for (int j = 0; j < 4; ++j) nv[j] = __builtin_nontemporal_load(xr + 64 * j); }
    if (gw + NGW < mend) { const f32x4* xr = (const f32x4*)(x + (size_t)(gw + NGW) * DM) + lane;
#pragma unroll
        for (int j = 0; j < 4; ++j) nv2[j] = __builtin_nontemporal_load(xr + 64 * j); }
    for (int m = gw; m < mend; m += NGW) {
        f32x4 v[4]; float s = 0.f;
#pragma unroll
        for (int j = 0; j < 4; ++j) { v[j] = nv[j]; nv[j] = nv2[j]; }
        if (m + 2 * NGW < mend) { const f32x4* xn = (const f32x4*)(x + (size_t)(m + 2 * NGW) * DM) + lane;
#pragma unroll
            for (int j = 0; j < 4; ++j) nv2[j] = __builtin_nontemporal_load(xn + 64 * j); }
#pragma unroll
        for (int j = 0; j < 4; ++j) s += (v[j].x * v[j].x + v[j].y * v[j].y) + (v[j].z * v[j].z + v[j].w * v[j].w);
        const float rstd = __builtin_amdgcn_rsqf(wave_sum(s) * (1.f / DM) + EPS);
        u32x2* o8 = (u32x2*)(hb + (size_t)m * DM) + lane;
        f32x4 ff = {0.f, 0.f, 0.f, 0.f};
#pragma unroll
        for (int j = 0; j < 4; ++j) { const f32x4 y = (v[j] * rstd) * gv[j];
            o8[64 * j] = (u32x2){pk2(y.x, y.y), pk2(y.z, y.w)};
#pragma unroll
            for (int i = 0; i < 4; ++i) { const f32x4 w = *(LAS f32x4*)(lds + 16 * ((j * 4 + i) * 64 + lane)); ff += w * y[i]; } }
        ff.x = wave_sum(ff.x); ff.y = wave_sum(ff.y); ff.z = wave_sum(ff.z); ff.w = wave_sum(ff.w);
        if (lane < 4) { const float z = (lane == 0 ? ff.x : lane == 1 ? ff.y : lane == 2 ? ff.z : ff.w) + mybias;
            lf[(size_t)m * 4 + lane] = fminf(z, 0.f) - 0.6931471805599453f * __builtin_amdgcn_logf(1.f + ex2(-fabsf(z) * LOG2E)); }
    }
    __syncthreads();
}

DI void knorm_rows(bf16_t* base, int nrows4  , int stride, const float* kw, int gw, int NGW, int lane) {
    const f32x4 w0 = *(const f32x4*)(kw + 8 * (lane & 7)), w1 = *(const f32x4*)(kw + 8 * (lane & 7) + 4);
    for (int r8 = gw; r8 < nrows4 / 8; r8 += NGW) { const int rid = r8 * 8 + (lane >> 3);
        u32x4* p = (u32x4*)(base + (size_t)(rid >> 2) * stride + (rid & 3) * HD + 8 * (lane & 7));
        const u32x4 kr = *p;
        const float f[8] = {bf_lo(kr.x), bf_hi(kr.x), bf_lo(kr.y), bf_hi(kr.y), bf_lo(kr.z), bf_hi(kr.z), bf_lo(kr.w), bf_hi(kr.w)};
        float ss = 0.f;
#pragma unroll
        for (int j = 0; j < 8; ++j) ss += f[j] * f[j];
        ss = sum8(ss);
        const float rstd = __builtin_amdgcn_rsqf(ss * (1.f / HD) + EPS);
        *p = (u32x4){pk2(f[0] * rstd * w0.x, f[1] * rstd * w0.y), pk2(f[2] * rstd * w0.z, f[3] * rstd * w0.w), pk2(f[4] * rstd * w1.x, f[5] * rstd * w1.y), pk2(f[6] * rstd * w1.z, f[7] * rstd * w1.w)}; }
}
DI void kprep_phase(ldsp lds, int layer) {
    kargp P = kargs(); const int tid = threadIdx.x, lane = tid & 63, wave = __builtin_amdgcn_readfirstlane(tid >> 6), gw = blockIdx.x * 8 + wave, NGW = gridDim.x * 8;
    knorm_rows((bf16_t*)(P->ws + WS_PROJ) + C_FK, NTOK * 4, NP, P->fox_k_norm + layer * HD, gw, NGW, lane);
    knorm_rows((bf16_t*)(P->ws + WS_KVM + layer * KVM_BYTES), NB * NMEM * 4, 512, P->mem_k_norm + layer * HD, gw, NGW, lane);
    if (blockIdx.x < NB * NH) {
        const int b = blockIdx.x >> 2, h = blockIdx.x & 3;
        const float* lfp = (const float*)(P->ws + WS_LF) + (size_t)b * SEQ * 4 + h;
        float a[4];
#pragma unroll
        for (int j = 0; j < 4; ++j) a[j] = lfp[(size_t)(4 * tid + j) * 4];
        const float s0 = a[0], s1 = s0 + a[1], s2 = s1 + a[2], s3 = s2 + a[3];
        float inc = s3;
#pragma unroll
        for (int off = 1; off < 64; off <<= 1) { const float v = __shfl_up(inc, off); if (lane >= off) inc += v; }
        LAS float* wsum = (LAS float*)lds;
        if (lane == 63) wsum[wave] = inc;
        __syncthreads();
        float offs = 0.f;
        for (int w = 0; w < wave; ++w) offs += wsum[w];
        const float pre = offs + inc - s3;
        *(f32x4*)((float*)(P->ws + WS_C2) + (size_t)blockIdx.x * SEQ + 4 * tid) = (f32x4){(pre + s0) * LOG2E, (pre + s1) * LOG2E, (pre + s2) * LOG2E, (pre + s3) * LOG2E};
        __syncthreads();
    }
}

constexpr int ATT_SLOT = 16384, ATT_NSLOT = 5, ATT_NRES = 6, ATT_CS = ATT_NRES * ATT_SLOT, ATT_FLAG = ATT_CS + 8192, ATT_RK = ATT_FLAG + 128, ATT_WT = ATT_RK + ATT_NRES * 256, ATT_Q = ATT_WT + 64, ATT_END = ATT_Q + 32768;
static_assert(ATT_END <= 147392, "attention LDS map");
#ifndef FUSE_NORM
#define FUSE_NORM 0
#endif
#ifndef ATT_STAGGER
#define ATT_STAGGER 0
#endif
#ifndef ATT_TILE_SKIP
#define ATT_TILE_SKIP 1
#endif
DI int crow(int reg, int h) { return (reg & 3) + 8 * (reg >> 2) + 4 * h; }
DI int swz8(int row) { const int x = (row >> 1) & 7; return ((x & 1) << 2) | (x >> 1); }
DI u32x4 pack8(const f32x16& p, int s) { return (u32x4){pk2(p[8 * s], p[8 * s + 1]), pk2(p[8 * s + 2], p[8 * s + 3]), pk2(p[8 * s + 4], p[8 * s + 5]), pk2(p[8 * s + 6], p[8 * s + 7])}; }
DI s16x4 tr_rd(ldsp p) { typedef short v4i16_t __attribute__((ext_vector_type(4))); return __builtin_bit_cast(s16x4, __builtin_amdgcn_ds_read_tr16_b64_v4i16((LAS v4i16_t*)p)); }
DI void att_zero(f32x16& p0, f32x16& p1) {
#pragma unroll
    for (int i = 0; i < 16; ++i) { p0[i] = 0.f; p1[i] = 0.f; }
}
template <int MODE> DI void att_bias(f32x16& p0, f32x16& p1, ldsp lds, int slot, int kt, int hh) {
    if (MODE == 1) return;
#pragma unroll
    for (int g = 0; g < 4; ++g) {
        const f32x4 r0 = *(LAS f32x4*)(lds + ATT_RK + 4 * (64 * slot + 8 * g + 4 * hh)), r1 = *(LAS f32x4*)(lds + ATT_RK + 4 * (64 * slot + 32 + 8 * g + 4 * hh));
        if (MODE == 0) { const f32x4 c0 = *(LAS f32x4*)(lds + ATT_CS + 4 * (64 * kt + 8 * g + 4 * hh)), c1 = *(LAS f32x4*)(lds + ATT_CS + 4 * (64 * kt + 32 + 8 * g + 4 * hh));
#pragma unroll
            for (int j = 0; j < 4; ++j) { p0[4 * g + j] = p0[4 * g + j] * r0[j] + c0[j]; p1[4 * g + j] = p1[4 * g + j] * r1[j] + c1[j]; } }
        else {
#pragma unroll
            for (int j = 0; j < 4; ++j) { p0[4 * g + j] *= r0[j]; p1[4 * g + j] *= r1[j]; } }
    }
}
template <int MODE> DI void att_prep(ldsp lds, int slot, int kt, const float* lfp, int tid, int lane, int wid) {
    if (MODE == 1) return;
    { const int row = tid >> 3, sc = tid & 7;
      const u32x4 kr = *(LAS u32x4*)(lds + slot * ATT_SLOT + row * 128 + ((sc ^ swz8(row)) << 4));
      const float f[8] = {bf_lo(kr.x), bf_hi(kr.x), bf_lo(kr.y), bf_hi(kr.y), bf_lo(kr.z), bf_hi(kr.z), bf_lo(kr.w), bf_hi(kr.w)};
      float ss = 0.f;
#pragma unroll
      for (int j = 0; j < 8; ++j) ss += f[j] * f[j];
      ss = sum8(ss);
      if (sc == 0) *(LAS float*)(lds + ATT_RK + 4 * (64 * slot + row)) = __builtin_amdgcn_rsqf(ss * (1.f / HD) + EPS); }
    if (MODE == 0 && wid == 0) {
        const float a = lfp[(size_t)(64 * kt + lane) * 4] * LOG2E;
        float suf = a;
#pragma unroll
        for (int off = 1; off < 64; off <<= 1) { const float v = __shfl_down(suf, off); if (lane + off < 64) suf += v; }
        const float E = *(LAS float*)(lds + ATT_WT + 32);
        *(LAS float*)(lds + ATT_CS + 4 * (64 * kt + lane)) = E + suf - a;
        if (lane == 0) *(LAS float*)(lds + ATT_WT + 32) = E + suf;
    }
}
DI void att_qk(f32x16& p0, f32x16& p1, ldsp Kb, ldsp Qb  , int r, int hh) {
    const int sw = swz8(r);
#pragma unroll
    for (int ks = 0; ks < 4; ++ks) {
        const int co = ((2 * ks + hh) ^ sw) << 4;
        const bf16x8 k0 = *(LAS bf16x8*)(Kb + r * 128 + co);
        const bf16x8 k1 = *(LAS bf16x8*)(Kb + (32 + r) * 128 + co);
        const bf16x8 qv = *(LAS bf16x8*)(Qb + 1024 * ks);
        p0 = MFMA32(k0, qv, p0); p1 = MFMA32(k1, qv, p1); }
}
DI void att_pv(f32x16& o0, f32x16& o1, ldsp Vb, const f32x16& p0, const f32x16& p1, int hh, int q4, int p4, int blk) {
    const int rl = 4 * hh + q4, sl = swz8(rl), sh = swz8(rl + 8), cb = 2 * blk + (p4 >> 1), in8 = 8 * (p4 & 1);
    const int ol0 = rl * 128 + ((cb ^ sl) << 4) + in8, ol1 = rl * 128 + (((4 + cb) ^ sl) << 4) + in8;
    const int oh0 = (rl + 8) * 128 + ((cb ^ sh) << 4) + in8, oh1 = (rl + 8) * 128 + (((4 + cb) ^ sh) << 4) + in8;
#pragma unroll
    for (int sb = 0; sb < 2; ++sb)
#pragma unroll
        for (int s = 0; s < 2; ++s) {
            const bf16x8 pf = __builtin_bit_cast(bf16x8, pack8(sb ? p1 : p0, s));
            ldsp a = Vb + (32 * sb + 16 * s) * 128;
            const s16x4 l0 = tr_rd(a + ol0), h0 = tr_rd(a + oh0), l1 = tr_rd(a + ol1), h1 = tr_rd(a + oh1);
            const bf16x8 v0 = __builtin_shufflevector(l0, h0, 0, 1, 2, 3, 4, 5, 6, 7), v1 = __builtin_shufflevector(l1, h1, 0, 1, 2, 3, 4, 5, 6, 7);
            o0 = MFMA32(v0, pf, o0); o1 = MFMA32(v1, pf, o1);
        }
}
DI void att_softmax(f32x16& p0, f32x16& p1, float& m_run, float& l_run, f32x16& o0, f32x16& o1) {
    float tm = fmaxf(p0[0], p1[0]);
#pragma unroll
    for (int i = 1; i < 16; ++i) tm = fmaxf(tm, fmaxf(p0[i], p1[i]));
    { float lo_, hi_; halves(tm, lo_, hi_); tm = fmaxf(lo_, hi_); }
    const float mn = fmaxf(m_run, tm);
    if (__any(mn > m_run)) { const float alpha = ex2(m_run - mn); l_run *= alpha;
#pragma unroll
        for (int i = 0; i < 16; ++i) { o0[i] *= alpha; o1[i] *= alpha; } }
    m_run = mn;
    float rs = 0.f;
#pragma unroll
    for (int i = 0; i < 16; ++i) { p0[i] = ex2(p0[i] - mn); p1[i] = ex2(p1[i] - mn); rs += p0[i] + p1[i]; }
    l_run += rs;
}
DI float mul_s(float a, float b) { return a * b; }
template <bool BAND> DI void att_sb(f32x16& p0, f32x16& p1, float& R, int jrel, int qrel, int hh) {
#pragma unroll
    for (int sb = 1; sb >= 0; --sb) {
#pragma unroll
        for (int g = 3; g >= 0; --g) {
            float omb[4], be[4];
#pragma unroll
            for (int j = 0; j < 4; ++j) { const float z = sb ? p1[4 * g + j] : p0[4 * g + j];
                float e = ex2(z);
                if (BAND) { const int kv = 64 * jrel + 32 * sb + 8 * g + 4 * hh + j; if (kv >= qrel) e = 0.f; }
                omb[j] = rcpf_(1.f + e); be[j] = 1.f - omb[j]; }
            const float t2 = omb[3], t1 = mul_s(t2, omb[2]), t0 = mul_s(t1, omb[1]), my4 = mul_s(t0, omb[0]);
            float lo_, hi_; halves(my4, lo_, hi_);
            const float base = hh ? R : mul_s(R, hi_);
            const float w3 = mul_s(be[3], base), w2 = mul_s(be[2], mul_s(base, t2)), w1 = mul_s(be[1], mul_s(base, t1)), w0 = mul_s(be[0], mul_s(base, t0));
            R = mul_s(R, mul_s(lo_, hi_));
            if (sb) { p1[4 * g] = w0; p1[4 * g + 1] = w1; p1[4 * g + 2] = w2; p1[4 * g + 3] = w3; }
            else { p0[4 * g] = w0; p0[4 * g + 1] = w1; p0[4 * g + 2] = w2; p0[4 * g + 3] = w3; }
        }
    }
}
DI void glds16(const void* gsrc, unsigned lds_dst) { unsigned keep;
    asm volatile("s_mov_b32 %0, m0\n\ts_mov_b32 m0, %2\n\ts_nop 0\n\tglobal_load_lds_dwordx4 %1, off\n\ts_mov_b32 m0, %0" : "=&s"(keep) : "v"(gsrc), "s"(lds_dst) : "memory"); }
#define ATT_WAITBAR(N) asm volatile("s_waitcnt vmcnt(" #N ") lgkmcnt(0)\n\ts_barrier" ::: "memory")

template <int MODE>
DI void attn_unit(ldsp lds, const bf16_t* Qp, const bf16_t* Kp, const bf16_t* Vp, int kvstride, const bf16_t* Gp, bf16_t* Op, const float* lfp  , const float* qnw, const float* knw, int qt, int nq) {
    int tid_ = threadIdx.x; asm volatile("" : "+v"(tid_));
    const int tid = tid_, lane = tid & 63, wid = __builtin_amdgcn_readfirstlane(tid >> 6), r = lane & 31, hh = lane >> 5;
    qnw = launder(qnw); lfp = launder(lfp); knw = launder(knw);
    const int NT = (MODE == 2) ? 4 : 4 * qt + 4;
    const int NRES = NT < ATT_NRES ? NT : ATT_NRES;
#define ATT_KT(i) ((MODE == 2) ? (i) : NT - 1 - (i))
    const int drow = 8 * wid + (lane >> 3);
    const size_t dma_off = (size_t)drow * kvstride + 8 * ((lane & 7) ^ swz8(drow));
    const unsigned lds0 = (unsigned)(uintptr_t)lds;
#define ATT_DMA_TO(i, slot) do { const size_t to_ = (size_t)ATT_KT(i) * 64 * kvstride + dma_off; const unsigned sl_ = __builtin_amdgcn_readfirstlane(lds0 + (slot) * ATT_SLOT + wid * 1024); \
        glds16(Kp + to_, sl_); glds16(Vp + to_, sl_ + 8192); } while (0)
#define ATT_DMA(i) ATT_DMA_TO(i, (i) % ATT_NSLOT)
    u32x4 qraw[4];
    { const bf16_t* qrow = Qp + (size_t)(qt * 256 + wid * 32 + r) * NP + 8 * hh;
#pragma unroll
      for (int ks = 0; ks < 4; ++ks) qraw[ks] = *(const u32x4*)(qrow + 16 * ks); }
#pragma unroll 1
    for (int i = 0; i < NRES; ++i) ATT_DMA_TO(i, i);
    if (tid < 24) *(LAS unsigned*)(lds + ATT_FLAG + 4 * tid) = 0u;
    float sufv = 0.f, av = 0.f; const int klo = 64 * (NT - NRES), kcnt = 64 * NRES;
    if (MODE == 0) {
        if (tid < kcnt) av = lfp[(size_t)(klo + tid) * 4] * LOG2E;
        sufv = av;
#pragma unroll
        for (int off = 1; off < 64; off <<= 1) { const float v = __shfl_down(sufv, off); if (lane + off < 64) sufv += v; }
        if (lane == 0) *(LAS float*)(lds + ATT_WT + 4 * wid) = sufv;
    }
    ATT_WAITBAR(0);
#pragma unroll 1
    for (int i = 0; i < NRES; ++i) att_prep<(MODE == 0) ? 2 : MODE>(lds, i, 0, nullptr, tid, lane, wid);
    if (MODE == 0) { float offs = 0.f;
#pragma unroll
        for (int w = 0; w < 8; ++w) { const float x = *(LAS float*)(lds + ATT_WT + 4 * w); if (w > wid) offs += x; }
        if (tid < kcnt) *(LAS float*)(lds + ATT_CS + 4 * (klo + tid)) = offs + sufv - av;
        if (tid == 0) *(LAS float*)(lds + ATT_WT + 32) = offs + sufv; }
    asm volatile("s_waitcnt lgkmcnt(0)\n\ts_barrier" ::: "memory");
    const int qrel = 32 * wid + r;
    const int q4 = (lane & 15) >> 2, p4 = lane & 3, blk = (lane >> 4) & 1;
    ldsp Qb = lds + ATT_Q + wid * 4096 + lane * 16;
#pragma unroll 1
    for (int qq = 0; qq < nq; ++qq) {
        const int q0 = (qt + qq) * 256;
        float qn2 = 0.f;
        { float v[4][8]; float ss = 0.f;
#pragma unroll
          for (int ks = 0; ks < 4; ++ks) { const u32x4 raw = qraw[ks];
              v[ks][0] = bf_lo(raw.x); v[ks][1] = bf_hi(raw.x); v[ks][2] = bf_lo(raw.y); v[ks][3] = bf_hi(raw.y); v[ks][4] = bf_lo(raw.z); v[ks][5] = bf_hi(raw.z); v[ks][6] = bf_lo(raw.w); v[ks][7] = bf_hi(raw.w);
#pragma unroll
              for (int j = 0; j < 8; ++j) ss += v[ks][j] * v[ks][j]; }
          float sc_all = 0.125f * LOG2E;
          if (MODE != 1) { float lo_, hi_; halves(ss, lo_, hi_); sc_all *= __builtin_amdgcn_rsqf((lo_ + hi_) * (1.f / HD) + EPS); }
#pragma unroll
          for (int ks = 0; ks < 4; ++ks) {
              float w[8];
#pragma unroll
              for (int j = 0; j < 8; ++j) w[j] = (MODE != 1) ? qnw[16 * ks + 8 * hh + j] * knw[16 * ks + 8 * hh + j] : 1.f;
              u32x4 pk; pk.x = pk2(v[ks][0] * sc_all * w[0], v[ks][1] * sc_all * w[1]); pk.y = pk2(v[ks][2] * sc_all * w[2], v[ks][3] * sc_all * w[3]);
              pk.z = pk2(v[ks][4] * sc_all * w[4], v[ks][5] * sc_all * w[5]); pk.w = pk2(v[ks][6] * sc_all * w[6], v[ks][7] * sc_all * w[7]);
              *(LAS u32x4*)(Qb + ks * 1024) = pk;
              if (MODE == 0) {
#pragma unroll
                  for (int j = 0; j < 8; ++j) { const float t_ = v[ks][j] * sc_all * w[j]; qn2 += t_ * t_; } } } }
        if (qq + 1 < nq) { const bf16_t* qrow = Qp + (size_t)(q0 + 256 + wid * 32 + r) * NP + 8 * hh;
#pragma unroll
            for (int ks = 0; ks < 4; ++ks) qraw[ks] = *(const u32x4*)(qrow + 16 * ks); }
        u32x4 graw[4];
#pragma unroll
        for (int i = 0; i < 4; ++i) graw[i] = *(const u32x4*)(Gp + (size_t)(q0 + wid * 32 + (lane >> 3) + 8 * i) * NP + 8 * (lane & 7));
        float smax = 0.f;
        if (MODE == 0) { float lo_, hi_; halves(qn2, lo_, hi_); smax = sqrtf(lo_ + hi_) * 8.f * 1.02f; }

        float m_run = -INFINITY, l_run = 0.f, R = 1.f;
        f32x16 o0, o1, p0, p1;
#pragma unroll
        for (int i = 0; i < 16; ++i) { o0[i] = 0.f; o1[i] = 0.f; }
        bool done = false;
#pragma unroll 1
        for (int it = (MODE == 2) ? 0 : 3 - ((32 * wid + 31) >> 6); it < NRES; ++it) {
            const bool band = (MODE != 2) && it < 4;
            const int jrel = 3 - it;
#if ATT_TILE_SKIP
            if (MODE != 2 && !band) {
                bool sk;
                if (MODE == 0) { const float nmax = *(LAS float*)(lds + ATT_CS + 4 * (64 * ATT_KT(it) + 63));
                    sk = !__any(nmax + smax >= m_run - 48.f); }
                else sk = !__any(R >= 0x1p-48f);
                if (sk) { done = true; break; }
            }
#endif
            ldsp Kb = lds + it * ATT_SLOT;
            att_zero(p0, p1);
            att_qk(p0, p1, Kb, Qb, r, hh);
            att_bias<MODE>(p0, p1, lds, it, ATT_KT(it), hh);
            if (MODE == 1) { if (band) att_sb<true>(p0, p1, R, jrel, qrel, hh); else att_sb<false>(p0, p1, R, -1, qrel, hh); }
            else {
                if (MODE == 0 && band) {
#pragma unroll
                    for (int e = 0; e < 16; ++e) { const int kv = 64 * jrel + crow(e, hh); if (kv > qrel) p0[e] = -INFINITY; if (kv + 32 > qrel) p1[e] = -INFINITY; } }
                att_softmax(p0, p1, m_run, l_run, o0, o1);
            }
            att_pv(o0, o1, Kb + 8192, p0, p1, hh, q4, p4, blk);
        }
        if (MODE != 2 && NRES < NT) {
            if (lane == 0) *(LAS unsigned*)(lds + ATT_FLAG + 64 + 4 * wid) = done ? 0u : 1u;
            asm volatile("s_waitcnt lgkmcnt(0)\n\ts_barrier" ::: "memory");
            const u32x4 n0 = *(LAS u32x4*)(lds + ATT_FLAG + 64), n1 = *(LAS u32x4*)(lds + ATT_FLAG + 80);
            if (__builtin_amdgcn_readfirstlane((n0.x | n0.y) | (n0.z | n0.w) | (n1.x | n1.y) | (n1.z | n1.w)) != 0u) {
                const int it0 = NRES;
                ATT_DMA(it0); if (it0 + 1 < NT) ATT_DMA(it0 + 1); if (it0 + 2 < NT) ATT_DMA(it0 + 2);
                ATT_WAITBAR(0);
#pragma unroll 1
                for (int k = 0; k < 3; ++k) if (it0 + k < NT) att_prep<MODE>(lds, (it0 + k) % ATT_NSLOT, ATT_KT(it0 + k), lfp, tid, lane, wid);
                asm volatile("s_waitcnt lgkmcnt(0)\n\ts_barrier" ::: "memory");
                bool skipcur = false;
#pragma unroll 1
                for (int s2 = 2 * it0; s2 < 2 * NT; ++s2) {
                    const int i = s2 >> 1;
#if ATT_TILE_SKIP
                    if ((s2 & 1) == 0 && i > it0) {
                        const u32x4 f0 = *(LAS u32x4*)(lds + ATT_FLAG + 32 * ((i - 1) & 1)), f1 = *(LAS u32x4*)(lds + ATT_FLAG + 32 * ((i - 1) & 1) + 16);
                        if (__builtin_amdgcn_readfirstlane((f0.x & f0.y) & (f0.z & f0.w) & (f1.x & f1.y) & (f1.z & f1.w)) != 0u) break; }
#endif
                    if ((s2 & 1) == 0 && i + 3 < NT) ATT_DMA(i + 3);
                    ldsp Kb = lds + (i % ATT_NSLOT) * ATT_SLOT;
                    if ((s2 & 1) == 0) {
                        skipcur = done;
#if ATT_TILE_SKIP
                        if (!skipcur) {
                            if (MODE == 0) { const float nmax = *(LAS float*)(lds + ATT_CS + 4 * (64 * ATT_KT(i) + 63)); skipcur = !__any(nmax + smax >= m_run - 48.f); }
                            else skipcur = !__any(R >= 0x1p-48f);
                            if (skipcur) done = true; }
                        if (skipcur && lane == 0) *(LAS unsigned*)(lds + ATT_FLAG + 32 * (i & 1) + 4 * wid) = 1u;
#endif
                        if (!skipcur) { att_zero(p0, p1); att_qk(p0, p1, Kb, Qb, r, hh); att_bias<MODE>(p0, p1, lds, i % ATT_NSLOT, ATT_KT(i), hh); }
                    } else {
                        if (!skipcur) {
                            if (MODE == 1) att_sb<false>(p0, p1, R, -1, qrel, hh); else att_softmax(p0, p1, m_run, l_run, o0, o1);
                            att_pv(o0, o1, Kb + 8192, p0, p1, hh, q4, p4, blk); }
                        ATT_WAITBAR(0);
                        if (i + 3 < NT) att_prep<MODE>(lds, (i + 3) % ATT_NSLOT, ATT_KT(i + 3), lfp, tid, lane, wid);
                        asm volatile("s_waitcnt lgkmcnt(0)\n\ts_barrier" ::: "memory");
                    }
                }
                ATT_WAITBAR(0);
            }
        }
        float inv = 1.f;
        if (MODE != 1) { float lo_, hi_; halves(l_run, lo_, hi_); inv = 1.0f / (lo_ + hi_); }
        ldsp st = lds + ATT_Q + wid * 4096;
#pragma unroll
        for (int i = 0; i < 4; ++i) { const int grow = (lane >> 3) + 8 * i; *(LAS u32x4*)(st + grow * 128 + (((lane & 7) ^ (grow & 7)) << 4)) = graw[i]; }
#pragma unroll
        for (int dt = 0; dt < 2; ++dt)
#pragma unroll
            for (int g = 0; g < 4; ++g) {
                const u32x2 gr = *(LAS u32x2*)(st + r * 128 + (((4 * dt + g) ^ (r & 7)) << 4) + 8 * hh);
                const float g0 = silu_f(bf_lo(gr.x)), g1 = silu_f(bf_hi(gr.x)), g2 = silu_f(bf_lo(gr.y)), g3 = silu_f(bf_hi(gr.y));
                const float a0 = dt ? o1[4 * g] : o0[4 * g], a1 = dt ? o1[4 * g + 1] : o0[4 * g + 1], a2 = dt ? o1[4 * g + 2] : o0[4 * g + 2], a3 = dt ? o1[4 * g + 3] : o0[4 * g + 3];
                *(LAS u32x2*)(st + r * 128 + (((4 * dt + g) ^ (r & 7)) << 4) + 8 * hh) = (u32x2){pk2(a0 * inv * g0, a1 * inv * g1), pk2(a2 * inv * g2, a3 * inv * g3)}; }
#pragma unroll
        for (int i = 0; i < 4; ++i) { const int orow = (lane >> 3) + 8 * i, c16 = lane & 7;
            const u32x4 v = *(LAS u32x4*)(st + orow * 128 + ((c16 ^ (orow & 7)) << 4));
            *(u32x4*)(Op + (size_t)(q0 + wid * 32 + orow) * DMIX + 8 * c16) = v; }
    }
    asm volatile("s_waitcnt lgkmcnt(0)\n\ts_barrier" ::: "memory");
#undef ATT_KT
#undef ATT_DMA
#undef ATT_DMA_TO
}

constexpr int HG_Q = 0, HG_F = 8192, HG_V = 16384, HG_O = 24576;
DI void hgrn_unit_valu(ldsp lds, const bf16_t* pj  , bf16_t* mx  , int h, int layer, const float* lb_logits, const float* onorm) {
    int tid_ = threadIdx.x; asm volatile("" : "+v"(tid_));
    const int tid = tid_, lane = tid & 63, wid = __builtin_amdgcn_readfirstlane(tid >> 6);
    lb_logits = launder(lb_logits); onorm = launder(onorm);
    const int tt = tid >> 4, c4 = (tid & 15) * 4;
    float oml[4], onw[4];
#pragma unroll
    for (int j = 0; j < 4; ++j) { const int c = h * HD + c4 + j;
        float lbv = 0.f;
        if (layer == 1) { const float l0 = lb_logits[c], l1 = lb_logits[256 + c], mx_ = fmaxf(l0, l1), e0 = expf(l0 - mx_), e1 = expf(l1 - mx_), p0 = e0 / (e0 + e1), p1 = e1 / (e0 + e1);
            lbv = fminf(fmaxf((p0 + p1) - p0, 0.f), 1.0f - 1e-6f); }
        oml[j] = 1.f - lbv; onw[j] = onorm[c]; }
    f32x2 S2[4];
#pragma unroll
    for (int i = 0; i < 4; ++i) S2[i] = (f32x2){0.f, 0.f};
    const bf16_t* base = pj + (size_t)tt * NP + h * HD + c4;
    u32x2 rq = *(const u32x2*)(base + C_HQ), rf = *(const u32x2*)(base + C_HF), ri = *(const u32x2*)(base + C_HI);
#pragma unroll 1
    for (int ch = 0; ch < SEQ / 32; ++ch) {
        { const float hq[4] = {bf_lo(rq.x), bf_hi(rq.x), bf_lo(rq.y), bf_hi(rq.y)}, hf[4] = {bf_lo(rf.x), bf_hi(rf.x), bf_lo(rf.y), bf_hi(rf.y)};
          f32x4 q, f;
#pragma unroll
          for (int j = 0; j < 4; ++j) { q[j] = silu_f(hq[j]); const float sg = rcpf_(1.f + ex2(hf[j] * LOG2E)); f[j] = 1.f - oml[j] * sg; }
          *(LAS f32x4*)(lds + HG_Q + 4 * (tt * 64 + c4)) = q; *(LAS f32x4*)(lds + HG_F + 4 * (tt * 64 + c4)) = f;
          *(LAS f32x4*)(lds + HG_V + 4 * (tt * 64 + c4)) = (f32x4){bf_lo(ri.x), bf_hi(ri.x), bf_lo(ri.y), bf_hi(ri.y)}; }
        __syncthreads();
        if (ch + 1 < SEQ / 32) { const bf16_t* nb = base + (size_t)(ch + 1) * 32 * NP; rq = *(const u32x2*)(nb + C_HQ); rf = *(const u32x2*)(nb + C_HF); ri = *(const u32x2*)(nb + C_HI); }
        const u32x2 gr = *(const u32x2*)(base + (size_t)ch * 32 * NP + C_HG);
        float acc[32];
#pragma unroll
        for (int t = 0; t < 32; ++t) {
            const f32x4 qa = *(LAS f32x4*)(lds + HG_Q + 4 * (t * 64 + 8 * wid)), qb = *(LAS f32x4*)(lds + HG_Q + 4 * (t * 64 + 8 * wid + 4));
            const f32x4 fa = *(LAS f32x4*)(lds + HG_F + 4 * (t * 64 + 8 * wid)), fb = *(LAS f32x4*)(lds + HG_F + 4 * (t * 64 + 8 * wid + 4));
            const float v = *(LAS float*)(lds + HG_V + 4 * (t * 64 + lane));
            const f32x2 v2 = {v, v};
            S2[0] = (f32x2){fa.x, fa.y} * (S2[0] - v2) + v2; S2[1] = (f32x2){fa.z, fa.w} * (S2[1] - v2) + v2;
            S2[2] = (f32x2){fb.x, fb.y} * (S2[2] - v2) + v2; S2[3] = (f32x2){fb.z, fb.w} * (S2[3] - v2) + v2;
            f32x2 a2 = S2[0] * (f32x2){qa.x, qa.y}, b2 = S2[1] * (f32x2){qa.z, qa.w};
            a2 += S2[2] * (f32x2){qb.x, qb.y}; b2 += S2[3] * (f32x2){qb.z, qb.w};
            a2 += b2; acc[t] = a2.x + a2.y;
        }
#pragma unroll
        for (int t = 0; t < 32; ++t) *(LAS float*)(lds + HG_O + 4 * ((wid * 32 + t) * 64 + lane)) = acc[t];
        __syncthreads();
        f32x4 o = *(LAS f32x4*)(lds + HG_O + 4 * (tt * 64 + c4));
#pragma unroll
        for (int w = 1; w < 8; ++w) o += *(LAS f32x4*)(lds + HG_O + 4 * ((w * 32 + tt) * 64 + c4));
        float ss = (o.x * o.x + o.y * o.y) + (o.z * o.z + o.w * o.w);
        ss = sum16(ss);
        const float rstd = 1.0f / sqrtf(ss * (1.f / HD) + EPS);
        const float g0 = silu_f(bf_lo(gr.x)), g1 = silu_f(bf_hi(gr.x)), g2 = silu_f(bf_lo(gr.y)), g3 = silu_f(bf_hi(gr.y));
        *(u32x2*)(mx + (size_t)(ch * 32 + tt) * DMIX + O_HG + h * HD + c4) = (u32x2){pk2(o.x * rstd * onw[0] * g0, o.y * rstd * onw[1] * g1), pk2(o.z * rstd * onw[2] * g2, o.w * rstd * onw[3] * g3)};
    }
    __syncthreads();
}

typedef short s16x4v __attribute__((ext_vector_type(4)));
#define MFMA16(a, b, c) __builtin_amdgcn_mfma_f32_16x16x16bf16_1k((a), (b), (c), 0, 0, 0)
constexpr int HM_QS = 0, HM_QM = 16 * 136, HM_KM = 2 * 16 * 136, HM_KET = 3 * 16 * 136, HM_VT = HM_KET + 64 * 40, HM_DEC = HM_VT + 64 * 40, HM_SLOT = HM_DEC + 256, HM_NS = 4, HM_OB = HM_NS * HM_SLOT, HM_OSTR = 272;
constexpr int HM_RAW = HM_OB + 2 * 16 * HM_OSTR, HM_RSLOT = 8192, HM_NR = 8;
static_assert(HM_SLOT % 16 == 0 && HM_RAW % 16 == 0 && HM_RAW + HM_NR * HM_RSLOT <= 147392, "HGRN LDS map");
DI s16x4v pack4(const f32x4 v) { u32x2 p = {pk2(v.x, v.y), pk2(v.z, v.w)}; return __builtin_bit_cast(s16x4v, p); }
DI void hgrn_unit(ldsp lds, const bf16_t* pj  , bf16_t* mx  , int h, int layer, const float* lb_logits, const float* onorm) {
    int tid_ = threadIdx.x; asm volatile("" : "+v"(tid_));
    const int tid = tid_, lane = tid & 63, wid = __builtin_amdgcn_readfirstlane(tid >> 6);
    lb_logits = launder(lb_logits); onorm = launder(onorm);
    const bool cons = wid < 4;
    const int fr = lane & 15, fq = lane >> 4;
    constexpr int NBLK = SEQ / 16;
    const int dl = lane >> 2, tq = lane & 3;
    const int pd = 16 * (wid & 3) + dl;
    float oml = 1.f;
    if (layer == 1) { const float l0 = lb_logits[h * HD + pd], l1 = lb_logits[256 + h * HD + pd], mx_ = fmaxf(l0, l1), e0 = expf(l0 - mx_), e1 = expf(l1 - mx_), p0 = e0 / (e0 + e1), p1 = e1 / (e0 + e1);
        oml = 1.f - fminf(fmaxf((p0 + p1) - p0, 0.f), 1.0f - 1e-6f); }
    f32x4 Sacc[4];
#pragma unroll
    for (int i = 0; i < 4; ++i) Sacc[i] = (f32x4){0.f, 0.f, 0.f, 0.f};
    const int e4 = 4 * fr, trow = 4 * wid + fq;
    const f32x4 onw = *(const f32x4*)(onorm + h * HD + e4);
    const unsigned lds0 = (unsigned)(uintptr_t)lds;
    const int pseg = (wid & 3);
    const bf16_t* dsrc = pj + (size_t)(lane >> 3) * NP + (pseg == 0 ? C_HQ : pseg == 1 ? C_HF : pseg == 2 ? C_HI : C_HG) + h * HD + 8 * (lane & 7);
#define HM_DMA(blk) do { const unsigned d_ = __builtin_amdgcn_readfirstlane(lds0 + HM_RAW + ((blk) & (HM_NR - 1)) * HM_RSLOT + pseg * 2048); \
        glds16(dsrc + (size_t)(blk) * 16 * NP, d_); glds16(dsrc + (size_t)((blk) * 16 + 8) * NP, d_ + 1024); } while (0)
    if (!cons) { HM_DMA(0); HM_DMA(1); HM_DMA(2); HM_DMA(3); asm volatile("s_waitcnt vmcnt(6)" ::: "memory"); }
    asm volatile("s_waitcnt lgkmcnt(0)\n\ts_barrier" ::: "memory");
#pragma unroll 1
    for (int n = -2; n <= NBLK; ++n) {
        if (!cons) {
            const int nb = n + 2;
            if (n + 6 < NBLK) HM_DMA(n + 6);
            if (nb < NBLK) {
                ldsp sb = lds + (nb & 3) * HM_SLOT;
                ldsp rw = lds + HM_RAW + (nb & (HM_NR - 1)) * HM_RSLOT + (4 * tq) * 128 + 2 * pd;
                float q[4], k[4], c[4], v[4];
#pragma unroll
                for (int i = 0; i < 4; ++i) { const float hq = __uint_as_float((unsigned)*(LAS bf16_t*)(rw + i * 128) << 16), hf = __uint_as_float((unsigned)*(LAS bf16_t*)(rw + 2048 + i * 128) << 16);
                    v[i] = __uint_as_float((unsigned)*(LAS bf16_t*)(rw + 4096 + i * 128) << 16);
                    q[i] = silu_f(hq); k[i] = oml * rcpf_(1.f + ex2(hf * LOG2E));
                    c[i] = fmaxf(__builtin_amdgcn_logf(1.f - k[i]), -15.f); }
                c[1] += c[0]; c[2] += c[1]; c[3] += c[2];
                float inc = c[3];
                { const float u1 = dppf<0x90>(inc); if (tq >= 1) inc += u1; const float u2 = dppf<0x44>(inc); if (tq >= 2) inc += u2; }
                const float exc = inc - c[3];
                const float Bm = dppf<0x55>(inc), Be = dppf<0xFF>(inc);
                s16x4v ket, vt; bf16_t* ketp = (bf16_t*)&ket; bf16_t* vtp = (bf16_t*)&vt;
#pragma unroll
                for (int i = 0; i < 4; ++i) { const float B = exc + c[i]; const int t = 4 * tq + i;
                    *(LAS bf16_t*)(sb + HM_QS + t * 136 + 2 * pd) = (bf16_t)(pk2(q[i] * ex2(B), 0.f) & 0xffffu);
                    *(LAS bf16_t*)(sb + HM_QM + t * 136 + 2 * pd) = (bf16_t)(pk2(q[i] * ex2(B - Bm), 0.f) & 0xffffu);
                    *(LAS bf16_t*)(sb + HM_KM + t * 136 + 2 * pd) = (bf16_t)(pk2(k[i] * ex2(Bm - B), 0.f) & 0xffffu);
                    ketp[i] = (bf16_t)(pk2(k[i] * ex2(Be - B), 0.f) & 0xffffu); vtp[i] = (bf16_t)(pk2(v[i], 0.f) & 0xffffu); }
                *(LAS s16x4v*)(sb + HM_KET + pd * 40 + 8 * tq) = ket;
                *(LAS s16x4v*)(sb + HM_VT + pd * 40 + 8 * tq) = vt;
                if (tq == 3) *(LAS float*)(sb + HM_DEC + 4 * pd) = ex2(Be);
            }
            { const int ahead = (n + 6 < NBLK ? n + 6 : NBLK - 1) - (n + 3);
              if (ahead >= 3) asm volatile("s_waitcnt vmcnt(6)" ::: "memory"); else if (ahead == 2) asm volatile("s_waitcnt vmcnt(4)" ::: "memory");
              else if (ahead == 1) asm volatile("s_waitcnt vmcnt(2)" ::: "memory"); else asm volatile("s_waitcnt vmcnt(0)" ::: "memory"); }
        } else {
            if (n >= 1) {
                const f32x4 o = *(LAS f32x4*)(lds + HM_OB + ((n - 1) & 1) * 16 * HM_OSTR + trow * HM_OSTR + 4 * e4);
                const u32x2 gv = *(LAS u32x2*)(lds + HM_RAW + ((n - 1) & (HM_NR - 1)) * HM_RSLOT + 3 * 2048 + trow * 128 + 2 * e4);
                const float ss = sum16((o.x * o.x + o.y * o.y) + (o.z * o.z + o.w * o.w));
                const float rstd = __builtin_amdgcn_rsqf(ss * (1.f / HD) + EPS);
                const float g0 = silu_f(bf_lo(gv.x)), g1 = silu_f(bf_hi(gv.x)), g2 = silu_f(bf_lo(gv.y)), g3 = silu_f(bf_hi(gv.y));
                *(u32x2*)(mx + (size_t)(16 * (n - 1) + trow) * DMIX + O_HG + h * HD + e4) = (u32x2){pk2(o.x * rstd * onw.x * g0, o.y * rstd * onw.y * g1), pk2(o.z * rstd * onw.z * g2, o.w * rstd * onw.w * g3)};
            }
            if (n >= 0 && n < NBLK) {
                ldsp sb = lds + (n & 3) * HM_SLOT;
                s16x4v qm[4], qs[4], km[4];
#pragma unroll
                for (int dt = 0; dt < 4; ++dt) { const int co = fr * 136 + (16 * dt + 4 * fq) * 2;
                    qm[dt] = *(LAS s16x4v*)(sb + HM_QM + co); qs[dt] = *(LAS s16x4v*)(sb + HM_QS + co); km[dt] = *(LAS s16x4v*)(sb + HM_KM + co); }
                const s16x4v vt = *(LAS s16x4v*)(sb + HM_VT + (16 * wid + fr) * 40 + 8 * fq);
                f32x4 pt = {0.f, 0.f, 0.f, 0.f};
#pragma unroll
                for (int dt = 0; dt < 4; ++dt) pt = MFMA16(km[dt], qm[dt], pt);
#pragma unroll
                for (int i = 0; i < 4; ++i) if (4 * fq + i > fr) pt[i] = 0.f;
                f32x4 ot = {0.f, 0.f, 0.f, 0.f};
#pragma unroll
                for (int dt = 0; dt < 4; ++dt) ot = MFMA16(pack4(Sacc[dt]), qs[dt], ot);
                ot = MFMA16(vt, pack4(pt), ot);
                *(LAS f32x4*)(lds + HM_OB + (n & 1) * 16 * HM_OSTR + fr * HM_OSTR + 4 * (16 * wid + 4 * fq)) = ot;
#pragma unroll
                for (int dt = 0; dt < 4; ++dt) { const f32x4 dc = *(LAS f32x4*)(sb + HM_DEC + 4 * (16 * dt + 4 * fq));
                    const s16x4v ke = *(LAS s16x4v*)(sb + HM_KET + (16 * dt + fr) * 40 + 8 * fq);
                    Sacc[dt] = MFMA16(ke, vt, Sacc[dt] * dc); }
            }
        }
        asm volatile("s_waitcnt lgkmcnt(0)\n\ts_barrier" ::: "memory");
    }
#undef HM_DMA
}

constexpr int PL_U = 0, PL_D = 79 * 512, PL_DSTR = 528, PL_Y = PL_D + 64 * PL_DSTR, PL_YSTR = 272;
static_assert(PL_Y + 8 * 32 * PL_YSTR <= 147392, "pooling LDS map");
DI void pool_unit(ldsp lds, const bf16_t* pj, bf16_t* mx, int t0, const bf16_t* wt  , const float* pscale) {
    wt = launder(wt); pscale = launder(pscale);
    int tid_ = threadIdx.x; asm volatile("" : "+v"(tid_));
    const int tid = tid_, lane = tid & 63, wid = __builtin_amdgcn_readfirstlane(tid >> 6), r = lane & 31, hh = lane >> 5;
    for (int idx = tid; idx < 79 * 32; idx += 512) { const int rr = idx >> 5, c16 = idx & 31, tok = t0 - 15 + rr;
        u32x4 v = {0u, 0u, 0u, 0u};
        if (tok >= 0) v = *(const u32x4*)(pj + (size_t)tok * NP + C_PV + 8 * c16);
        *(LAS u32x4*)(lds + PL_U + rr * 512 + 16 * c16) = v; }
    const int g = wid >> 1, th = wid & 1;
    bf16x8 bw[2][4];
#pragma unroll
    for (int nt = 0; nt < 2; ++nt)
#pragma unroll
        for (int ks = 0; ks < 4; ++ks) bw[nt][ks] = *(const bf16x8*)(wt + (size_t)(g * 64 + 32 * nt + r) * 64 + 16 * ks + 8 * hh);
    __syncthreads();
    { const int vec = lane & 7, run = lane >> 3, win = 2 << g, tl0 = 32 * th + 4 * run;
      ldsp ub = lds + PL_U + (15 + tl0) * 512 + g * 128 + vec * 16;
      float acc[8];
#pragma unroll
      for (int j = 0; j < 8; ++j) acc[j] = 0.f;
      for (int j = 0; j < win; ++j) { const u32x4 v = *(LAS u32x4*)(ub - j * 512);
          acc[0] += bf_lo(v.x); acc[1] += bf_hi(v.x); acc[2] += bf_lo(v.y); acc[3] += bf_hi(v.y); acc[4] += bf_lo(v.z); acc[5] += bf_hi(v.z); acc[6] += bf_lo(v.w); acc[7] += bf_hi(v.w); }
#pragma unroll
      for (int k = 0; k < 4; ++k) {
          const u32x4 u = *(LAS u32x4*)(ub + k * 512);
          const float us[8] = {bf_lo(u.x), bf_hi(u.x), bf_lo(u.y), bf_hi(u.y), bf_lo(u.z), bf_hi(u.z), bf_lo(u.w), bf_hi(u.w)};
          if (k > 0) { const u32x4 o = *(LAS u32x4*)(ub + (k - win) * 512);
              const float os[8] = {bf_lo(o.x), bf_hi(o.x), bf_lo(o.y), bf_hi(o.y), bf_lo(o.z), bf_hi(o.z), bf_lo(o.w), bf_hi(o.w)};
#pragma unroll
              for (int j = 0; j < 8; ++j) acc[j] += us[j] - os[j]; }
          const int t = t0 + tl0 + k, cnt = (t + 1 < win) ? t + 1 : win;
          const float icnt = 1.0f / (float)cnt;
          *(LAS u32x4*)(lds + PL_D + (tl0 + k) * PL_DSTR + g * 128 + vec * 16) = (u32x4){pk2(acc[0] * icnt - us[0], acc[1] * icnt - us[1]), pk2(acc[2] * icnt - us[2], acc[3] * icnt - us[3]),
                                                                                      pk2(acc[4] * icnt - us[4], acc[5] * icnt - us[5]), pk2(acc[6] * icnt - us[6], acc[7] * icnt - us[7])};
      } }
    { f32x16 y0, y1;
#pragma unroll
      for (int i = 0; i < 16; ++i) { y0[i] = 0.f; y1[i] = 0.f; }
#pragma unroll
      for (int ks = 0; ks < 4; ++ks) { const bf16x8 a = *(LAS bf16x8*)(lds + PL_D + (32 * th + r) * PL_DSTR + (64 * g + 16 * ks + 8 * hh) * 2);
          y0 = MFMA32(a, bw[0][ks], y0); y1 = MFMA32(a, bw[1][ks], y1); }
      const float sc0 = pscale[64 * g + r], sc1 = pscale[64 * g + 32 + r];
      ldsp ys = lds + PL_Y + wid * 32 * PL_YSTR;
#pragma unroll
      for (int i = 0; i < 16; ++i) { *(LAS float*)(ys + crow(i, hh) * PL_YSTR + 4 * r) = y0[i] * sc0; *(LAS float*)(ys + crow(i, hh) * PL_YSTR + 4 * (32 + r)) = y1[i] * sc1; }
      const int tok = lane >> 1, hf = lane & 1;
      const size_t trow = (size_t)(t0 + 32 * th + tok);
#pragma unroll
      for (int k = 0; k < 4; ++k) {
          const u32x4 gv = *(const u32x4*)(pj + trow * NP + C_PG + 64 * g + 32 * hf + 8 * k);
          const f32x4 ya = *(LAS f32x4*)(ys + tok * PL_YSTR + 4 * (32 * hf + 8 * k)), yb = *(LAS f32x4*)(ys + tok * PL_YSTR + 4 * (32 * hf + 8 * k + 4));
          *(u32x4*)(mx + trow * DMIX + O_POOL + 64 * g + 32 * hf + 8 * k) = (u32x4){pk2(ya.x * silu_f(bf_lo(gv.x)), ya.y * silu_f(bf_hi(gv.x))), pk2(ya.z * silu_f(bf_lo(gv.y)), ya.w * silu_f(bf_hi(gv.y))),
                                                                                  pk2(yb.x * silu_f(bf_lo(gv.z)), yb.y * silu_f(bf_hi(gv.z))), pk2(yb.z * silu_f(bf_lo(gv.w)), yb.w * silu_f(bf_hi(gv.w)))}; } }
    __syncthreads();
}

constexpr int U_HG = 128, U_AT = 1024, U_PL = 1024;
constexpr int U_ME = 256;
constexpr int U0_ME = U_HG, U0_SB = U0_ME + U_ME, U0_FX = U0_SB + U_AT, U0_PL = U0_FX + U_AT, U_TOTAL = U0_PL + U_PL;
DI void mixer_phase(ldsp lds, int layer, int cslot) {
    LAS int* slot = (LAS int*)(lds + LDS_SLOT);
    for (;;) {
        __syncthreads();
        if (threadIdx.x == 0) *slot = (int)atomicAdd((unsigned*)(kargs()->ws + WS_CTL) + 64 * cslot, 1u);
        __syncthreads();
        const int u = __builtin_amdgcn_readfirstlane(*slot);
        if (u >= U_TOTAL) break;
        kargp P = kargs();
        const bf16_t* proj = (const bf16_t*)(P->ws + WS_PROJ); bf16_t* mixed = (bf16_t*)(P->ws + WS_MIX);
        if (u < U0_ME) {
#ifndef NO_HGRN
            const int b = u >> 2, h = u & 3;
#pragma unroll 1
            for (int rep = 0; rep < ((PROBE_UNIT & 1) ? 2 : 1); ++rep)
            hgrn_unit(lds, proj + (size_t)b * SEQ * NP, mixed + (size_t)b * SEQ * DMIX, h, layer, P->lb_logits, P->hgrn_out_norm + layer * 256);
#endif
        } else if (u < U0_SB) {
#ifndef NO_MEM
            const int i = u - U0_ME, qt = 4 * (i >> 7), bh = i & 127, b = bh >> 2, h = bh & 3;
            const bf16_t* pb = proj + (size_t)b * SEQ * NP + h * HD; bf16_t* ob = mixed + (size_t)b * SEQ * DMIX + O_MEM + h * HD;
            const bf16_t* kb = (const bf16_t*)(P->ws + WS_KVM + layer * KVM_BYTES) + (size_t)b * NMEM * 512 + h * HD;
#pragma unroll 1
            for (int rep = 0; rep < ((PROBE_UNIT & 8) ? 2 : 1); ++rep)
            attn_unit<2>(lds, pb + C_MQ, kb, kb + 256, 512, pb + C_MG, ob, nullptr, P->mem_q_norm + layer * HD, P->mem_k_norm + layer * HD, qt, 4);
#endif
        } else if (u < U0_FX) {
#ifndef NO_SB
            const int i = u - U0_SB, qt = 7 - (i >> 7), bh = i & 127, b = bh >> 2, h = bh & 3;
            const bf16_t* pb = proj + (size_t)b * SEQ * NP + h * HD; bf16_t* ob = mixed + (size_t)b * SEQ * DMIX + O_SB + h * HD;
#pragma unroll 1
            for (int rep = 0; rep < ((PROBE_UNIT & 2) ? 2 : 1); ++rep)
            attn_unit<1>(lds, pb + C_SQ, pb + C_SK, pb + C_SV, NP, pb + C_SG, ob, nullptr, nullptr, nullptr, qt, 1);
#endif
        } else if (u < U0_PL) {
#ifndef NO_FOX
            const int i = u - U0_FX, qt = 7 - (i >> 7), bh = i & 127, b = bh >> 2, h = bh & 3;
            const bf16_t* pb = proj + (size_t)b * SEQ * NP + h * HD; bf16_t* ob = mixed + (size_t)b * SEQ * DMIX + O_FOX + h * HD;
            const float* lfp = (const float*)(P->ws + WS_LF) + (size_t)b * SEQ * 4 + h;
#pragma unroll 1
            for (int rep = 0; rep < ((PROBE_UNIT & 4) ? 2 : 1); ++rep)
            attn_unit<0>(lds, pb + C_FQ, pb + C_FK, pb + C_FV, NP, pb + C_FG, ob, lfp, P->fox_q_norm + layer * HD, P->fox_k_norm + layer * HD, qt, 1);
#endif
        } else {
#ifndef NO_POOL
            const int i = u - U0_PL, b = i >> 5, t0 = (i & 31) * 64;
#pragma unroll 1
            for (int rep = 0; rep < ((PROBE_UNIT & 16) ? 2 : 1); ++rep)
            pool_unit(lds, proj + (size_t)b * SEQ * NP, mixed + (size_t)b * SEQ * DMIX, t0, (const bf16_t*)(P->ws + WS_WPOOL + layer * WPOOL_BYTES), P->pool_scale + layer * 256);
#endif
        }
    }
}

#define XB_TMO      128
#define XB_XCNT(j)  (256  + 64 * (j))
#define XB_XSUB(j)  (1280 + 64 * (j))
#define XB_XGEN(j)  (2304 + 64 * (j))
#define XB_TOP      3328
#define XB_TOPGEN   3392
#define XCD_BAR_WORDS 3456
#define XB_SPIN_CAP (1u << 18)

__device__ __forceinline__ unsigned xb_ld(unsigned* p)              { return __hip_atomic_load(p, __ATOMIC_RELAXED, __HIP_MEMORY_SCOPE_AGENT); }
__device__ __forceinline__ unsigned xb_add(unsigned* p, unsigned v) { return __hip_atomic_fetch_add(p, v, __ATOMIC_RELAXED, __HIP_MEMORY_SCOPE_AGENT); }
__device__ __forceinline__ unsigned xb_xcc_id() { return (unsigned)__builtin_amdgcn_s_getreg((3 << 11) | 20) & 0xFu; }
#define XB_SPIN(cond, bar) do { unsigned _sp = 0; while (cond) { __builtin_amdgcn_s_sleep(1); \
    if ((++_sp & 255u) == 0u) { if (xb_ld(&(bar)[XB_TMO])) break; if (_sp > XB_SPIN_CAP) { atomicAdd(&(bar)[XB_TMO], 1u); break; } } } } while (0)

struct XcdBarrier {
    unsigned* bar; unsigned x;
    volatile LAS unsigned* st;
};

__device__ __forceinline__ XcdBarrier xcd_barrier_post(unsigned* bar, volatile LAS unsigned* st) {
    XcdBarrier b; b.bar = bar; b.x = xb_xcc_id(); b.st = st;
    if (threadIdx.x == 0) (void)xb_add(&bar[XB_XCNT(b.x)], 1u);
    return b;
}
__device__ __forceinline__ void xcd_barrier_complete(unsigned* bar, unsigned x, unsigned& nloc, unsigned& nx) {
    const unsigned G = gridDim.x * gridDim.y * gridDim.z;
    unsigned sum, cnt, mine, sp = 0u;
    for (;;) {
        sum = 0u; cnt = 0u; mine = 0u;
#pragma unroll
        for (unsigned j = 0; j < 16; ++j) { const unsigned c = xb_ld(&bar[XB_XCNT(j)]); sum += c; cnt += (c > 0u) ? 1u : 0u; mine = (j == x) ? c : mine; }
        if (sum == G) break;
        __builtin_amdgcn_s_sleep(1);
        if ((++sp & 255u) == 0u) { if (xb_ld(&bar[XB_TMO])) break; if (sp > XB_SPIN_CAP) { atomicAdd(&bar[XB_TMO], 1u); break; } }
    }
    nloc = mine > 0u ? mine : 1u; nx = cnt > 0u ? cnt : 1u;
}

__device__ __forceinline__ void xcd_barrier(const XcdBarrier& b) {
    asm volatile("s_waitcnt vmcnt(0)" ::: "memory");
    __syncthreads();
    if (threadIdx.x == 0) {
        unsigned* bar = b.bar;
        __builtin_amdgcn_s_waitcnt(0);
        unsigned nloc = b.st[0], nx = b.st[1];
        if (nloc == 0u) { xcd_barrier_complete(bar, b.x, nloc, nx); b.st[0] = nloc; b.st[1] = nx; }
        const unsigned old = xb_add(&bar[XB_XSUB(b.x)], 1u);
        const unsigned gen = old / nloc;
        if (old + 1u == (gen + 1u) * nloc) {
            __builtin_amdgcn_fence(__ATOMIC_RELEASE, "agent");
            asm volatile("s_waitcnt vmcnt(0)" ::: "memory");
            const unsigned og = xb_add(&bar[XB_TOP], 1u);
            const unsigned tg = og / nx;
            if (og + 1u == (tg + 1u) * nx) xb_add(&bar[XB_TOPGEN], 1u);
            else XB_SPIN(xb_ld(&bar[XB_TOPGEN]) == tg, bar);
            __builtin_amdgcn_fence(__ATOMIC_ACQUIRE, "agent");
            xb_add(&bar[XB_XGEN(b.x)], 1u);
            asm volatile("s_waitcnt vmcnt(0)" ::: "memory");
        } else {
            XB_SPIN(xb_ld(&bar[XB_XGEN(b.x)]) == gen, bar);
            __builtin_amdgcn_fence(__ATOMIC_ACQUIRE, "agent");
            asm volatile("s_waitcnt vmcnt(0)" ::: "memory");
        }
    }
    __syncthreads();
}

constexpr int CW_XBAR = 1024;
DI void seam_barrier(ldsp lds) {
    XcdBarrier b; b.bar = (unsigned*)(kargs()->ws + WS_CTL) + CW_XBAR; b.x = xb_xcc_id(); b.st = (volatile LAS unsigned*)(lds + LDS_BYTES - 32);
    xcd_barrier(b);
}

constexpr int N_PHASES = 8;
DI void in_gemm(ldsp lds, int layer) {
    kargp P = kargs(); unsigned char* ws = P->ws;
    pg8::Gemm g{(const bf16_t*)(ws + WS_HB), (const bf16_t*)(ws + WS_WIN + layer * WIN_BYTES), NTOK, NP, DM}; pg8::StaticOrder S; S.init(NTOK, NP, gridDim.x, blockIdx.x);
    if (EPI_NORM && layer == 1) {
        { const int tid = threadIdx.x, lane = tid & 63, wave = __builtin_amdgcn_readfirstlane(tid >> 6), p16 = lane & 15;
          const float* ssp = (const float*)(ws + WS_SSP); const float* ffp = (const float*)(ws + WS_FFP); float* lf = (float*)(ws + WS_LF);
          const f32x4 bias = *(const f32x4*)(P->fox_f_bias + NH);
          for (int r4 = blockIdx.x * 8 + wave; r4 < NTOK / 4; r4 += gridDim.x * 8) { const size_t row = (size_t)r4 * 4 + (lane >> 4);
              const float s1 = sum16(ssp[row * 16 + p16]); f32x4 f = *(const f32x4*)(ffp + (row * 16 + p16) * 4);
              f.x = sum16(f.x); f.y = sum16(f.y); f.z = sum16(f.z); f.w = sum16(f.w);
              const float rstd = 1.0f / sqrtf(s1 * (1.f / DM) + EPS);
              if (p16 < 4) { const float z = (p16 == 0 ? f.x : p16 == 1 ? f.y : p16 == 2 ? f.z : f.w) * rstd + (p16 == 0 ? bias.x : p16 == 1 ? bias.y : p16 == 2 ? bias.z : bias.w);
                  lf[row * 4 + p16] = fminf(z, 0.f) - log1pf(expf(-fabsf(z))); } } }
        pg8::EpiBf16RowScale E{(bf16_t*)(ws + WS_PROJ), NP, (const float*)(ws + WS_SSP), 1.f / DM, EPS};
        pg8::gemm_phase<pg8::EpiBf16RowScale, pg8::StaticOrder, true, true>(lds, g, S, E);
    } else {
        pg8::EpiBf16<0> E{(bf16_t*)(ws + WS_PROJ), NP, nullptr, 0, 0, 1.f};
        pg8::gemm_phase<pg8::EpiBf16<0>, pg8::StaticOrder, true, true>(lds, g, S, E);
    }
}
DI void kv_gemm(ldsp lds) {
    const int bid = blockIdx.x; if (bid >= 128) return;
    kargp P = kargs(); unsigned char* ws = P->ws; const int l2 = bid >> 6;
    pg8::Gemm g{(const bf16_t*)(ws + WS_MNB + l2 * MNB_BYTES), (const bf16_t*)(ws + WS_WKV + l2 * WKV_BYTES), NB * NMEM, 512, DM}; pg8::StaticOrder S; S.init(NB * NMEM, 512, 64, bid & 63);
    pg8::EpiBf16<0> E{(bf16_t*)(ws + WS_KVM + l2 * KVM_BYTES), 512, nullptr, 0, 0, 1.f};
    pg8::gemm_phase<pg8::EpiBf16<0>, pg8::StaticOrder, true, true>(lds, g, S, E);
}
DI void out_gemm(ldsp lds, int layer) {
    kargp P = kargs(); unsigned char* ws = P->ws;
    pg8::Gemm g{(const bf16_t*)(ws + WS_MIX), (const bf16_t*)(ws + WS_WOUT + layer * WOUT_BYTES), NTOK, DM, DMIX}; pg8::StaticOrder S; S.init(NTOK, DM, gridDim.x, blockIdx.x);
    if (EPI_NORM && layer == 0) { pg8::EpiResStats E{P->x, P->out, DM, (unsigned short*)(ws + WS_HB), (const float*)(ws + WS_GW), (float*)(ws + WS_SSP), (float*)(ws + WS_FFP)};
        pg8::gemm_phase<pg8::EpiResStats, pg8::StaticOrder, true, true>(lds, g, S, E); }
    else { pg8::EpiRes E{layer == 0 ? P->x : P->out, P->out, DM};
        pg8::gemm_phase<pg8::EpiRes, pg8::StaticOrder, true, true>(lds, g, S, E); }
    if (FUSE_NORM && layer + 1 < DEPTH) {
        const int tid = threadIdx.x, lane = tid & 63, wave = __builtin_amdgcn_readfirstlane(tid >> 6);
        __threadfence();
        __syncthreads();
        LAS int* todo = (LAS int*)(lds + 16384);
        if (tid == 0) { int cnt = 0; pg8::Unit u;
            for (int i = 0; S.next(i, u); ++i) { const unsigned old = atomicAdd((unsigned*)(kargs()->ws + WS_CTL) + 256 + u.pm, 1u); if (old == (unsigned)(DM / 256 - 1)) todo[1 + cnt++] = u.pm; }
            todo[0] = cnt; }
        __syncthreads();
        const int ncnt = __builtin_amdgcn_readfirstlane(todo[0]);
        int pms[4];
#pragma unroll
        for (int i = 0; i < 4; ++i) pms[i] = __builtin_amdgcn_readfirstlane(todo[1 + (i < ncnt ? i : 0)]);
        __threadfence();
        if (ncnt > 0) {
            kargp Q = kargs(); const int nl = layer + 1;
#pragma unroll 1
            for (int i = 0; i < ncnt; ++i) { const int pm = i == 0 ? pms[0] : i == 1 ? pms[1] : i == 2 ? pms[2] : pms[3];
                norm_phase(lds, Q->out, Q->norm_g + nl * DM, Q->w_in + (size_t)nl * DM * DIN, Q->fox_f_bias + nl * NH, (bf16_t*)(Q->ws + WS_HB), (float*)(Q->ws + WS_LF), pm * 256 + wave, 8, pm * 256 + 256, tid, lane); }
        }
    }
}
DI void do_norm(ldsp lds, int nl) {
    kargp P = kargs(); const int tid = threadIdx.x, lane = tid & 63, wave = __builtin_amdgcn_readfirstlane(tid >> 6);
    norm_phase(lds, nl ? P->out : P->x, P->norm_g + nl * DM, P->w_in + (size_t)nl * DM * DIN, P->fox_f_bias + nl * NH, (bf16_t*)(P->ws + WS_HB), (float*)(P->ws + WS_LF), blockIdx.x * 8 + wave, gridDim.x * 8, NTOK, tid, lane);
}
__global__ void __launch_bounds__(512, 2) hybrid_fwd(Params Parg) {
    extern __shared__ __attribute__((aligned(16))) unsigned char lds_raw[];
    ldsp lds = (ldsp)lds_raw;
    const int lo = kargs()->ph_lo, hi = kargs()->ph_hi;
    { volatile LAS unsigned* bst = (volatile LAS unsigned*)(lds + LDS_BYTES - 32);
      if (threadIdx.x < 2) bst[threadIdx.x] = 0u;
      __syncthreads();
      (void)xcd_barrier_post((unsigned*)(kargs()->ws + WS_CTL) + CW_XBAR, bst); }
#define IN(k) (lo <= (k) && (k) < hi)
#define SEAM(k) do { if (IN(k) && IN((k) + 1) && !(EPI_NORM && (k) == 4)) { if ((k) == 0) cg::this_grid().sync(); else seam_barrier(lds); } } while (0)
    if (IN(0)) {
        const int tid = threadIdx.x, lane = tid & 63, wave = __builtin_amdgcn_readfirstlane(tid >> 6);
        weights_phase(lds, blockIdx.x * 8 + wave, gridDim.x * 8, wave, lane);
        __syncthreads();
        memnorm_phase(blockIdx.x * 8 + wave, gridDim.x * 8, lane);
        do_norm(lds, 0);
    }
    SEAM(0);
    if (IN(1)) { in_gemm(lds, 0); kv_gemm(lds);
#if PROBE_PH & 2
        __syncthreads(); in_gemm(lds, 0);
#endif
    }
    SEAM(1);
    if (IN(2)) { mixer_phase(lds, 0, 0);
#if PROBE_PH & 4
        mixer_phase(lds, 0, 2);
#endif
    }
    SEAM(2);
    if (IN(3)) out_gemm(lds, 0);
    SEAM(3);
    if (IN(4) && !EPI_NORM) do_norm(lds, 1);
    SEAM(4);
    if (IN(5)) in_gemm(lds, 1);
    SEAM(5);
    if (IN(6)) mixer_phase(lds, 1, 1);
    SEAM(6);
    if (IN(7)) out_gemm(lds, 1);
#undef IN
#undef SEAM
}

extern "C" void kernel_launch(void* const* d_in, const int* in_sizes, int n_in, void* d_out, int out_size, void* d_ws, size_t ws_size, hipStream_t stream) {
    static int grid = 0;
    if (grid == 0) {
        if (n_in != 16 || in_sizes[0] != NTOK * DM || out_size != NTOK * DM || ws_size < WS_END) { fprintf(stderr, "kernel_launch: unexpected shapes (n_in %d, in0 %d, out %d, ws %zu)\n", n_in, n_in > 0 ? in_sizes[0] : -1, out_size, ws_size); grid = -1; return; }
        int dev = 0, cus = 0, per_cu = 0;
        (void)hipGetDevice(&dev); (void)hipDeviceGetAttribute(&cus, hipDeviceAttributeMultiprocessorCount, dev);
        if (hipFuncSetAttribute((const void*)hybrid_fwd, hipFuncAttributeMaxDynamicSharedMemorySize, LDS_BYTES) != hipSuccess) { fprintf(stderr, "kernel_launch: hipFuncSetAttribute failed\n"); grid = -1; return; }
        if (hipOccupancyMaxActiveBlocksPerMultiprocessor(&per_cu, (const void*)hybrid_fwd, 512, LDS_BYTES) != hipSuccess || per_cu < 1) { fprintf(stderr, "kernel_launch: occupancy query gave %d\n", per_cu); per_cu = 1; }
        (void)hipGetLastError();
        grid = cus * per_cu;
    }
    if (grid < 0) return;
    (void)hipMemsetAsync((char*)d_ws + WS_CTL, 0, CTL_ZERO_BYTES, stream);
    Params p{};
    p.x = (const float*)d_in[0]; p.mem = (const float*)d_in[1]; p.norm_g = (const float*)d_in[2]; p.w_in = (const float*)d_in[3]; p.fox_f_bias = (const float*)d_in[4];
    p.fox_q_norm = (const float*)d_in[5]; p.fox_k_norm = (const float*)d_in[6]; p.lb_logits = (const float*)d_in[7]; p.hgrn_out_norm = (const float*)d_in[8]; p.pool_w = (const float*)d_in[9];
    p.pool_scale = (const float*)d_in[10]; p.mem_norm_g = (const float*)d_in[11]; p.mem_w_kv = (const float*)d_in[12]; p.mem_q_norm = (const float*)d_in[13]; p.mem_k_norm = (const float*)d_in[14];
    p.w_out = (const float*)d_in[15]; p.out = (float*)d_out; p.ws = (unsigned char*)d_ws;
#if MK_SINGLE_LAUNCH
    p.ph_lo = 0; p.ph_hi = N_PHASES;
    void* args[] = {&p};
    const hipError_t e = hipLaunchCooperativeKernel((const void*)hybrid_fwd, dim3(grid), dim3(512), args, LDS_BYTES, stream);
    if (e != hipSuccess) fprintf(stderr, "kernel_launch: cooperative launch failed: %s (grid %d)\n", hipGetErrorString(e), grid);
#else
    for (int ph = 0; ph < N_PHASES; ++ph) { p.ph_lo = ph; p.ph_hi = ph + 1; hipLaunchKernelGGL(hybrid_fwd, dim3(grid), dim3(512), LDS_BYTES, stream, p); }
#endif
}
```

```cpp
#include <hip/hip_runtime.h>
#include <hip/hip_cooperative_groups.h>
#include <cstdio>
#include <cstdint>
namespace cg = cooperative_groups;
namespace pg8 {
#define PG8_LAS __attribute__((address_space(3)))
typedef unsigned short bf16_t;
typedef short bf16x8 __attribute__((ext_vector_type(8)));
typedef float f32x4 __attribute__((ext_vector_type(4)));
typedef unsigned u32x4 __attribute__((ext_vector_type(4)));
constexpr int BM = 256, BK = 64, HALF = 128, HTB = HALF * BK * 2  , STAGE_BYTES = 8 * HTB, NXCD = 8, WGM = 8;

__host__ __device__ __forceinline__ int lds_byte(int r, int c) { const int st = (r >> 4) * 2 + (c >> 5), rr = r & 15, cc = c & 31, ob = rr * 64 + cc * 2; return st * 1024 + (ob ^ (((ob >> 9) & 1) << 5)); }
__host__ __device__ __forceinline__ void stage_rc(int b, int& R, int& C) { const int st = b / 1024, sb = b % 1024, swz = sb ^ (((sb >> 9) & 1) << 5); R = (st >> 1) * 16 + swz / 64; C = (st & 1) * 32 + (swz % 64) / 2; }
__host__ __device__ __forceinline__ int perm32(int rho) { const int n = rho >> 4, i = rho & 15; return 8 * (i >> 2) + 4 * n + (i & 3); }

struct Unit { int pm, pn; };
struct Gemm { const bf16_t* A; const bf16_t* Bt; int M, N, K; };

struct StaticOrder {
    int nM, nN, nwg, G, c;
    __host__ __device__ void init(int M, int N, int G_, int c_) { nM = M / BM; nN = N / BM; nwg = nM * nN; G = G_; c = c_; }
    __host__ __device__ bool next(int i, Unit& u) const {
        const long L = (long)i * G + c; if (L >= nwg) return false;
        int wgid = (int)L; { const int q = nwg / NXCD, r = nwg % NXCD, xcd = wgid % NXCD, off = wgid / NXCD; wgid = (xcd < r ? xcd * (q + 1) : r * (q + 1) + (xcd - r) * q) + off; }
        const int nig = WGM * nN, gid = wgid / nig, fm = gid * WGM, gsz = (nM - fm) < WGM ? (nM - fm) : WGM;
        u.pm = fm + ((wgid % nig) % gsz); u.pn = (wgid % nig) / gsz; return true;
    }
    __device__ __forceinline__ void a_ready(const Unit&) const {}
    __device__ __forceinline__ void done(const Unit&) const {}
};

__device__ __forceinline__ unsigned cvt_pk_bf16(float lo, float hi) { unsigned r; asm volatile("v_cvt_pk_bf16_f32 %0, %1, %2" : "=v"(r) : "v"(lo), "v"(hi)); return r; }
typedef float f32x2 __attribute__((ext_vector_type(2)));
__device__ __forceinline__ f32x2 gelu_pk(f32x2 v) {
    const f32x2 av = __builtin_elementwise_abs(v), d = av * 0.2316418882f + 1.0f;
    f32x2 t; t.x = __builtin_amdgcn_rcpf(d.x); t.y = __builtin_amdgcn_rcpf(d.y);
    f32x2 q = t * 0.5307027145f + (-0.7265760135f); q = q * t + 0.7107068705f; q = q * t + (-0.142248368f); q = q * t + 0.127414796f; q = q * t;
    const f32x2 s = (v * v) * (-0.72134752044f);
    f32x2 e; e.x = __builtin_amdgcn_exp2f(s.x); e.y = __builtin_amdgcn_exp2f(s.y);
    const f32x2 m = v * (q * e), r = v - m;
    f32x2 o; o.x = v.x < 0.f ? m.x : r.x; o.y = v.y < 0.f ? m.y : r.y; return o;
}

template <int ACT  > struct EpiBf16 {
    static constexpr bool PERM = true, AFTER_DRAIN = false; static_assert(ACT == 0 || ACT == 1, "EpiBf16: ACT is 0 (none) or 1 (gelu_pk)");
    bf16_t* O; int ldc; const float* bias; int split_cols; size_t split_stride; float scale0;
    __device__ __forceinline__ void operator()(const f32x4 (&acc)[2][2][4][2], const Unit& u, int wr, int wc, int fr, int fq) const {
        const int row0 = u.pm * BM + wr * 64 + fr; int colt = u.pn * BM; bf16_t* base = O;
        float sc = 1.f; if (split_cols) { const int t = colt / split_cols; base += (size_t)t * split_stride; colt -= t * split_cols; if (t == 0) sc = scale0; }
        const int col0 = colt + wc * 32 + 8 * fq, bcol0 = u.pn * BM + wc * 32 + 8 * fq;
        f32x4 bv[2][2];
#pragma unroll
        for (int bj = 0; bj < 2; ++bj)
#pragma unroll
            for (int n = 0; n < 2; ++n) bv[bj][n] = bias ? *(const f32x4*)(bias + bcol0 + bj * HALF + 4 * n) : (f32x4){0.f, 0.f, 0.f, 0.f};
#pragma unroll
        for (int ai = 0; ai < 2; ++ai)
#pragma unroll
            for (int m = 0; m < 4; ++m) { bf16_t* rowp = base + (size_t)(row0 + ai * HALF + m * 16) * ldc + col0;
#pragma unroll
                for (int bj = 0; bj < 2; ++bj) { f32x4 v0 = acc[ai][bj][m][0] + bv[bj][0], v1 = acc[ai][bj][m][1] + bv[bj][1];
                    if (ACT == 1) { f32x2 a = gelu_pk((f32x2){v0[0], v0[1]}), b = gelu_pk((f32x2){v0[2], v0[3]}), c = gelu_pk((f32x2){v1[0], v1[1]}), d = gelu_pk((f32x2){v1[2], v1[3]});
                        v0 = (f32x4){a.x, a.y, b.x, b.y}; v1 = (f32x4){c.x, c.y, d.x, d.y}; }
                    v0 = v0 * sc; v1 = v1 * sc; u32x4 w; w.x = cvt_pk_bf16(v0[0], v0[1]); w.y = cvt_pk_bf16(v0[2], v0[3]); w.z = cvt_pk_bf16(v1[0], v1[1]); w.w = cvt_pk_bf16(v1[2], v1[3]);
                    *(u32x4*)(rowp + bj * HALF) = w; } }
    }
};

struct EpiRes {
    static constexpr bool PERM = false, AFTER_DRAIN = false;
    const float* base; float* out; int ldc;
    __device__ __forceinline__ void operator()(const f32x4 (&acc)[2][2][4][2], const Unit& u, int wr, int wc, int fr, int fq) const {
        const int col0 = u.pn * BM + wc * 32 + 4 * fq;
#pragma unroll
        for (int ai = 0; ai < 2; ++ai)
#pragma unroll
            for (int m = 0; m < 4; ++m) { const size_t off = (size_t)(u.pm * BM + ai * HALF + wr * 64 + m * 16 + fr) * ldc + col0;
#pragma unroll
                for (int bj = 0; bj < 2; ++bj)
#pragma unroll
                    for (int n = 0; n < 2; ++n) { const f32x4 bs = *(const f32x4*)(base + off + bj * HALF + n * 16); *(f32x4*)(out + off + bj * HALF + n * 16) = bs + acc[ai][bj][m][n]; } }
    }
};

struct EpiResStats {
    static constexpr bool PERM = false, AFTER_DRAIN = false;
    const float* base; float* out; int ldc; unsigned short* xb; const float* gw  ; float* ssp  ; float* ffp  ;
    __device__ __forceinline__ void operator()(const f32x4 (&acc)[2][2][4][2], const Unit& u, int wr, int wc, int fr, int fq) const {
        const int col0 = u.pn * BM + wc * 32 + 4 * fq;
#pragma unroll
        for (int ai = 0; ai < 2; ++ai)
#pragma unroll
            for (int m = 0; m < 4; ++m) {
                float ss = 0.f; f32x4 ff = {0.f, 0.f, 0.f, 0.f};
                const size_t rbase = (size_t)(u.pm * BM + ai * HALF + wr * 64 + m * 16 + fr);
#pragma unroll
                for (int bj = 0; bj < 2; ++bj)
#pragma unroll
                    for (int n = 0; n < 2; ++n) {
                        const int c = col0 + bj * HALF + n * 16; const size_t off = rbase * ldc + c;
                        const f32x4 o = *(const f32x4*)(base + off) + acc[ai][bj][m][n];
                        *(f32x4*)(out + off) = o;
                        typedef unsigned u32x2_ __attribute__((ext_vector_type(2)));
                        *(u32x2_*)(xb + off) = (u32x2_){cvt_pk_bf16(o[0], o[1]), cvt_pk_bf16(o[2], o[3])};
                        ss += (o[0] * o[0] + o[1] * o[1]) + (o[2] * o[2] + o[3] * o[3]);
                        ff += *(const f32x4*)(gw + 4 * (size_t)c) * o[0] + *(const f32x4*)(gw + 4 * (size_t)c + 4) * o[1] + *(const f32x4*)(gw + 4 * (size_t)c + 8) * o[2] + *(const f32x4*)(gw + 4 * (size_t)c + 12) * o[3]; }
                float v5[5] = {ss, ff[0], ff[1], ff[2], ff[3]};
#pragma unroll
                for (int q = 0; q < 5; ++q) { auto a_ = __builtin_amdgcn_permlane16_swap(__float_as_uint(v5[q]), __float_as_uint(v5[q]), false, false); const float s_ = __uint_as_float(a_[0]) + __uint_as_float(a_[1]);
                    auto b_ = __builtin_amdgcn_permlane32_swap(__float_as_uint(s_), __float_as_uint(s_), false, false); v5[q] = __uint_as_float(b_[0]) + __uint_as_float(b_[1]); }
                if (fq == 0) { const int slot = u.pn * 4 + wc; ssp[rbase * 16 + slot] = v5[0]; *(f32x4*)(ffp + (rbase * 16 + slot) * 4) = (f32x4){v5[1], v5[2], v5[3], v5[4]}; }
                asm volatile("" ::: "memory");
            }
    }
};
struct EpiBf16RowScale {
    static constexpr bool PERM = true, AFTER_DRAIN = false;
    bf16_t* O; int ldc; const float* ssp; float inv_k, eps;
    __device__ __forceinline__ void operator()(const f32x4 (&acc)[2][2][4][2], const Unit& u, int wr, int wc, int fr, int fq) const {
        const int row0 = u.pm * BM + wr * 64 + fr; const int col0 = u.pn * BM + wc * 32 + 8 * fq;
#pragma unroll
        for (int ai = 0; ai < 2; ++ai)
#pragma unroll
            for (int m = 0; m < 4; ++m) { const size_t row = (size_t)(row0 + ai * HALF + m * 16);
                const f32x4 a = *(const f32x4*)(ssp + row * 16), b = *(const f32x4*)(ssp + row * 16 + 4), c = *(const f32x4*)(ssp + row * 16 + 8), d = *(const f32x4*)(ssp + row * 16 + 12);
                const float tot = ((a[0] + a[1]) + (a[2] + a[3])) + ((b[0] + b[1]) + (b[2] + b[3])) + ((c[0] + c[1]) + (c[2] + c[3])) + ((d[0] + d[1]) + (d[2] + d[3]));
                const float sc = 1.0f / sqrtf(tot * inv_k + eps);
                bf16_t* rowp = O + row * ldc + col0;
#pragma unroll
                for (int bj = 0; bj < 2; ++bj) { const f32x4 v0 = acc[ai][bj][m][0] * sc, v1 = acc[ai][bj][m][1] * sc;
                    u32x4 w; w.x = cvt_pk_bf16(v0[0], v0[1]); w.y = cvt_pk_bf16(v0[2], v0[3]); w.z = cvt_pk_bf16(v1[0], v1[1]); w.w = cvt_pk_bf16(v1[2], v1[3]);
                    *(u32x4*)(rowp + bj * HALF) = w; } }
    }
};
template <class Epi, class Sched, bool ALIGN_EPI = false, bool SP2 = false>
__device__ __forceinline__ void gemm_phase(PG8_LAS unsigned char* lds, const Gemm g, const Sched& S, const Epi& E) {
    const int tid = threadIdx.x, wid = __builtin_amdgcn_readfirstlane(tid >> 6), lane = tid & 63, wr = wid >> 2, wc = wid & 3, fr = lane & 15, fq = lane >> 4;
    const int K = g.K, nt = K / BK;
    unsigned voffA[2], voffB[2];
#pragma unroll
    for (int i = 0; i < 2; ++i) { int R, C; stage_rc(tid * 16 + i * 8192, R, C); const int Rb = Epi::PERM ? ((R & ~31) + perm32(R & 31)) : R;
        voffA[i] = (unsigned)(R * K + C) * 2u; voffB[i] = (unsigned)(Rb * K + C) * 2u; }
    const size_t kstep = (size_t)(BK * 2);
    const size_t hstep = (size_t)HALF * K * 2;
    const size_t tstep = 2 * hstep;
    const unsigned ldsw = (unsigned)wid * 1024u;
    const int aoff = lds_byte(wr * 64 + fr, fq * 8), boff = lds_byte(wc * 32 + fr, fq * 8);
#define PG8_SA(b, h) (((b) * 2 + (h)) * HTB)
#define PG8_SB(b, h) ((4 + (b) * 2 + (h)) * HTB)
#define PG8_STAGE(bufoff, gbase, voff) do { _Pragma("unroll") for (int _i = 0; _i < 2; ++_i) \
        __builtin_amdgcn_global_load_lds((const unsigned*)((const char*)(gbase) + (voff)[_i]), (PG8_LAS unsigned*)(lds + (bufoff) + ldsw + _i * 8192), 16, 0, 0); } while (0)
#define PG8_LDA(dst, b, h) do { _Pragma("unroll") for (int m = 0; m < 4; ++m) _Pragma("unroll") for (int k = 0; k < 2; ++k) dst[m][k] = *(const PG8_LAS bf16x8*)(lds + PG8_SA(b, h) + aoff + m * 2048 + k * 1024); } while (0)
#define PG8_LDB(dst, b, h) do { _Pragma("unroll") for (int n = 0; n < 2; ++n) _Pragma("unroll") for (int k = 0; k < 2; ++k) dst[n][k] = *(const PG8_LAS bf16x8*)(lds + PG8_SB(b, h) + boff + n * 2048 + k * 1024); } while (0)
#define PG8_MMA(ai, bj, At, Bt) do { __builtin_amdgcn_s_setprio(1); _Pragma("unroll") for (int m = 0; m < 4; ++m) _Pragma("unroll") for (int n = 0; n < 2; ++n) _Pragma("unroll") for (int k = 0; k < 2; ++k) \
        acc[ai][bj][m][n] = __builtin_amdgcn_mfma_f32_16x16x32_bf16(Bt[n][k], At[m][k], acc[ai][bj][m][n], 0, 0, 0); __builtin_amdgcn_s_setprio(0); } while (0)
#define PG8_WAIT_V(n) asm volatile("s_waitcnt vmcnt(" #n ")" ::: "memory")
#define PG8_WAIT_L(n) asm volatile("s_waitcnt lgkmcnt(" #n ")" ::: "memory")
#define PG8_BAR __builtin_amdgcn_s_barrier()
#define PG8_SCHED __builtin_amdgcn_sched_barrier(0)
    Unit cur, nxt; int ui = 0;
    if (!S.next(0, cur)) return;
    f32x4 acc[2][2][4][2];
#pragma unroll
    for (int a = 0; a < 2; ++a)
#pragma unroll
        for (int b = 0; b < 2; ++b)
#pragma unroll
            for (int m = 0; m < 4; ++m)
#pragma unroll
                for (int n = 0; n < 2; ++n) acc[a][b][m][n] = (f32x4){0.f, 0.f, 0.f, 0.f};
    bf16x8 At[4][2], B0[2][2], B1[2][2];
    const char* cA = (const char*)g.A + (size_t)cur.pm * tstep; const char* cB = (const char*)g.Bt + (size_t)cur.pn * tstep;
    S.a_ready(cur);
    if constexpr (SP2) {
        PG8_STAGE(PG8_SB(0, 0), cB, voffB); PG8_STAGE(PG8_SB(0, 1), cB + hstep, voffB); PG8_STAGE(PG8_SA(0, 0), cA, voffA); PG8_STAGE(PG8_SA(0, 1), cA + hstep, voffA);
        if (wr == 1) PG8_BAR;
        PG8_WAIT_V(2); PG8_BAR;
        PG8_STAGE(PG8_SB(1, 0), cB + kstep, voffB); PG8_STAGE(PG8_SA(1, 0), cA + kstep, voffA); PG8_STAGE(PG8_SB(1, 1), cB + hstep + kstep, voffB);
        PG8_WAIT_V(6); PG8_BAR;
    } else {
        PG8_STAGE(PG8_SB(0, 0), cB, voffB); PG8_STAGE(PG8_SA(0, 0), cA, voffA); PG8_STAGE(PG8_SB(0, 1), cB + hstep, voffB); PG8_STAGE(PG8_SA(0, 1), cA + hstep, voffA);
        if (wr == 1) PG8_BAR;
        PG8_WAIT_V(4); PG8_BAR;
        PG8_STAGE(PG8_SB(1, 0), cB + kstep, voffB); PG8_STAGE(PG8_SA(1, 0), cA + kstep, voffA); PG8_STAGE(PG8_SB(1, 1), cB + hstep + kstep, voffB);
        PG8_WAIT_V(6); PG8_BAR;
    }
    for (;;) {
        const bool has_next = S.next(ui + 1, nxt);
        const char* nA = has_next ? (const char*)g.A + (size_t)nxt.pm * tstep : cA; const char* nB = has_next ? (const char*)g.Bt + (size_t)nxt.pn * tstep : cB;
        for (int t = 0; t < nt; t += 2) {
            const bool last = (t == nt - 2);
            const char* a1 = cA + (size_t)(t + 1) * kstep;
            const char* a2 = last ? nA : cA + (size_t)(t + 2) * kstep; const char* b2 = last ? nB : cB + (size_t)(t + 2) * kstep;
            const char* a3 = a2 + kstep; const char* b3 = b2 + kstep;
            if (last && has_next) S.a_ready(nxt);
            if constexpr (SP2) {
            PG8_LDB(B0, 0, 0); PG8_LDB(B1, 0, 1); PG8_SCHED; PG8_LDA(At, 0, 0); PG8_STAGE(PG8_SA(1, 1), a1 + hstep, voffA);
            PG8_WAIT_V(8); PG8_WAIT_L(0); PG8_BAR; PG8_MMA(0, 0, At, B0); PG8_MMA(0, 1, At, B1); PG8_BAR; PG8_SCHED;
            PG8_LDA(At, 0, 1); PG8_STAGE(PG8_SB(0, 0), b2, voffB); PG8_STAGE(PG8_SB(0, 1), b2 + hstep, voffB); PG8_STAGE(PG8_SA(0, 0), a2, voffA);
            PG8_WAIT_V(8); PG8_WAIT_L(0); PG8_BAR; PG8_MMA(1, 0, At, B0); PG8_MMA(1, 1, At, B1); PG8_BAR; PG8_SCHED;
            PG8_LDB(B0, 1, 0); PG8_LDB(B1, 1, 1); PG8_SCHED; PG8_LDA(At, 1, 0); PG8_STAGE(PG8_SA(0, 1), a2 + hstep, voffA);
            PG8_WAIT_V(8); PG8_WAIT_L(0); PG8_BAR; PG8_MMA(0, 0, At, B0); PG8_MMA(0, 1, At, B1); PG8_BAR; PG8_SCHED;
            PG8_LDA(At, 1, 1); PG8_STAGE(PG8_SB(1, 0), b3, voffB); PG8_STAGE(PG8_SB(1, 1), b3 + hstep, voffB); PG8_STAGE(PG8_SA(1, 0), a3, voffA);
            PG8_WAIT_V(8); PG8_WAIT_L(0); PG8_BAR; PG8_MMA(1, 0, At, B0); PG8_MMA(1, 1, At, B1); PG8_BAR; PG8_SCHED;
            } else {
            PG8_LDB(B0, 0, 0); PG8_SCHED; PG8_LDA(At, 0, 0); PG8_STAGE(PG8_SA(1, 1), a1 + hstep, voffA);
            PG8_WAIT_L(8); PG8_BAR; PG8_WAIT_L(0); PG8_MMA(0, 0, At, B0); PG8_BAR; PG8_SCHED;
            PG8_LDB(B1, 0, 1); PG8_STAGE(PG8_SB(0, 0), b2, voffB);
            PG8_BAR; PG8_WAIT_L(0); PG8_MMA(0, 1, At, B1); PG8_BAR;
            PG8_LDA(At, 0, 1); PG8_STAGE(PG8_SA(0, 0), a2, voffA);
            PG8_BAR; PG8_WAIT_L(0); PG8_MMA(1, 0, At, B0); PG8_BAR; PG8_SCHED;
            PG8_STAGE(PG8_SB(0, 1), b2 + hstep, voffB);
            PG8_WAIT_V(6); PG8_BAR; PG8_MMA(1, 1, At, B1); PG8_BAR;
            PG8_LDB(B0, 1, 0); PG8_SCHED; PG8_LDA(At, 1, 0); PG8_STAGE(PG8_SA(0, 1), a2 + hstep, voffA);
            PG8_WAIT_L(8); PG8_BAR; PG8_WAIT_L(0); PG8_MMA(0, 0, At, B0); PG8_BAR; PG8_SCHED;
            PG8_LDB(B1, 1, 1); PG8_STAGE(PG8_SB(1, 0), b3, voffB);
            PG8_BAR; PG8_WAIT_L(0); PG8_MMA(0, 1, At, B1); PG8_BAR;
            PG8_LDA(At, 1, 1); PG8_STAGE(PG8_SA(1, 0), a3, voffA);
            PG8_BAR; PG8_WAIT_L(0); PG8_MMA(1, 0, At, B0); PG8_BAR; PG8_SCHED;
            PG8_STAGE(PG8_SB(1, 1), b3 + hstep, voffB);
            PG8_WAIT_V(6); PG8_BAR; PG8_MMA(1, 1, At, B1); PG8_BAR;
            }
        }
        if constexpr (ALIGN_EPI) { if (wr == 0) PG8_BAR; }
        if constexpr (!Epi::AFTER_DRAIN) { E(acc, cur, wr, wc, fr, fq); S.done(cur); }
        if (!has_next) break;
#pragma unroll
        for (int a = 0; a < 2; ++a)
#pragma unroll
            for (int b = 0; b < 2; ++b)
#pragma unroll
                for (int m = 0; m < 4; ++m)
#pragma unroll
                    for (int n = 0; n < 2; ++n) acc[a][b][m][n] = (f32x4){0.f, 0.f, 0.f, 0.f};
        cur = nxt; cA = nA; cB = nB; ++ui;
        if constexpr (ALIGN_EPI) { if (wr == 1) PG8_BAR; }
    }
    PG8_WAIT_V(0);
    if constexpr (!ALIGN_EPI) { if (wr == 0) PG8_BAR; }
    PG8_BAR;
    if constexpr (Epi::AFTER_DRAIN) { E.fused(acc, cur, wr, wc, fr, fq, lds, wid, lane); S.done(cur); }
#undef PG8_SA
#undef PG8_SB
#undef PG8_STAGE
#undef PG8_LDA
#undef PG8_LDB
#undef PG8_MMA
#undef PG8_WAIT_V
#undef PG8_WAIT_L
#undef PG8_BAR
#undef PG8_SCHED
}
}
#ifndef EPI_NORM
#define EPI_NORM 0
#endif

#ifndef PROBE_PH
#define PROBE_PH 0
#endif
#ifndef PROBE_UNIT
#define PROBE_UNIT 0
#endif
#ifndef PROBE_SUB
#define PROBE_SUB 0
#endif
#ifndef MK_SINGLE_LAUNCH
#define MK_SINGLE_LAUNCH 1
#endif

constexpr int DM = 1024, NB = 32, SEQ = 2048, NTOK = NB * SEQ, NMEM = 256, DIN = 4100, NP = 4096, DMIX = 1280, NH = 4, HD = 64, DEPTH = 2;
constexpr float EPS = 1e-6f, LOG2E = 1.4426950408889634f;
constexpr int C_FQ = 0, C_FK = 256, C_FV = 512, C_FG = 768, C_SQ = 1024, C_SK = 1280, C_SV = 1536, C_SG = 1792, C_HQ = 2048, C_HF = 2304, C_HI = 2560, C_HG = 2816, C_PV = 3072, C_PG = 3328, C_MQ = 3584, C_MG = 3840;
constexpr int O_FOX = 0, O_SB = 256, O_HG = 512, O_POOL = 768, O_MEM = 1024;

constexpr size_t MiB = 1u << 20;
constexpr size_t WS_CTL = 0, CTL_ZERO_BYTES = 32768;
constexpr size_t WS_WIN = 2 * MiB, WIN_BYTES = (size_t)NP * DM * 2;
constexpr size_t WS_WOUT = 18 * MiB, WOUT_BYTES = (size_t)DM * DMIX * 2;
constexpr size_t WS_WKV = 24 * MiB, WKV_BYTES = (size_t)512 * DM * 2;
constexpr size_t WS_WPOOL = 27 * MiB, WPOOL_BYTES = 4 * 64 * 64 * 2;
constexpr size_t WS_LF = 26 * MiB;
constexpr size_t WS_MNB = 28 * MiB, MNB_BYTES = (size_t)NB * NMEM * DM * 2;
constexpr size_t WS_KVM = 60 * MiB, KVM_BYTES = (size_t)NB * NMEM * 512 * 2;
constexpr size_t WS_HB = 76 * MiB;
constexpr size_t WS_MIX = 204 * MiB;
constexpr size_t WS_PROJ = 364 * MiB;
constexpr size_t WS_C2 = 876 * MiB;
constexpr size_t WS_SSP = 877 * MiB;
constexpr size_t WS_FFP = 881 * MiB;
constexpr size_t WS_GW = 897 * MiB;
constexpr size_t WS_END = 898 * MiB;

constexpr int LDS_BYTES = 147456;
constexpr int LDS_SLOT = LDS_BYTES - 64;

#define LAS __attribute__((address_space(3)))
typedef LAS unsigned char* ldsp;
typedef unsigned short bf16_t;
typedef short bf16x8 __attribute__((ext_vector_type(8)));
typedef short s16x4 __attribute__((ext_vector_type(4)));
typedef float f32x16 __attribute__((ext_vector_type(16)));
typedef float f32x4 __attribute__((ext_vector_type(4)));
typedef float f32x2 __attribute__((ext_vector_type(2)));
typedef unsigned u32x4 __attribute__((ext_vector_type(4)));
typedef unsigned u32x2 __attribute__((ext_vector_type(2)));
typedef __bf16 bf16x2_t __attribute__((ext_vector_type(2)));

#define DI __device__ __forceinline__
DI float bf_lo(unsigned u) { return __uint_as_float(u << 16); }
DI float bf_hi(unsigned u) { return __uint_as_float(u & 0xffff0000u); }
DI unsigned pk2(float lo, float hi) { f32x2 v = {lo, hi}; bf16x2_t b = __builtin_convertvector(v, bf16x2_t); return __builtin_bit_cast(unsigned, b); }
DI float ex2(float x) { return __builtin_amdgcn_exp2f(x); }
DI float rcpf_(float x) { return __builtin_amdgcn_rcpf(x); }
DI float silu_f(float x) { return x * rcpf_(1.f + ex2(-x * LOG2E)); }
template <int CTRL> DI float dppf(float v) { return __uint_as_float((unsigned)__builtin_amdgcn_update_dpp(0, (int)__float_as_uint(v), CTRL, 0xF, 0xF, true)); }
DI float sum8(float v) { v += dppf<0xB1>(v); v += dppf<0x4E>(v); v += dppf<0x141>(v); return v; }
DI float sum16(float v) { v = sum8(v); v += dppf<0x140>(v); return v; }
DI float wave_sum(float v) { v = sum16(v);
    return (__int_as_float(__builtin_amdgcn_readlane(__float_as_int(v), 0)) + __int_as_float(__builtin_amdgcn_readlane(__float_as_int(v), 16))) +
           (__int_as_float(__builtin_amdgcn_readlane(__float_as_int(v), 32)) + __int_as_float(__builtin_amdgcn_readlane(__float_as_int(v), 48))); }
DI void halves(float x, float& lo, float& hi) { auto rr = __builtin_amdgcn_permlane32_swap(__float_as_uint(x), __float_as_uint(x), false, false); lo = __uint_as_float(rr[0]); hi = __uint_as_float(rr[1]); }
template <class T> DI T* launder(T* p) { asm volatile("" : "+s"(p)); return p; }
#define MFMA32(a, b, c) __builtin_amdgcn_mfma_f32_32x32x16_bf16((a), (b), (c), 0, 0, 0)

struct Params {
    const float *x, *mem, *norm_g, *w_in, *fox_f_bias, *fox_q_norm, *fox_k_norm, *lb_logits, *hgrn_out_norm, *pool_w, *pool_scale, *mem_norm_g, *mem_w_kv, *mem_q_norm, *mem_k_norm, *w_out;
    float* out; unsigned char* ws; int ph_lo, ph_hi;
};
typedef const __attribute__((address_space(4))) Params* kargp;
DI kargp kargs() { kargp p = (kargp)__builtin_amdgcn_kernarg_segment_ptr(); asm volatile("" : "+s"(p)); return p; }

DI void transpose_item(const float* W, int K, int ldw, bf16_t* WT, int k0, int src_n0, int dst_n0, LAS float* scr, int lane, const float* kscale = nullptr) {
#pragma unroll 8
    for (int i = 0; i < 32; ++i) { const int kk = 2 * i + (lane >> 5); scr[kk * 33 + (lane & 31)] = W[(size_t)(k0 + kk) * ldw + src_n0 + (lane & 31)] * (kscale ? kscale[k0 + kk] : 1.f); }
    asm volatile("s_waitcnt lgkmcnt(0)" ::: "memory");
    const int c = lane & 7;
#pragma unroll
    for (int j = 0; j < 4; ++j) { const int n = (lane >> 3) + 8 * j; const LAS float* s = scr + (8 * c) * 33 + n;
        u32x4 o; o.x = pk2(s[0 * 33], s[1 * 33]); o.y = pk2(s[2 * 33], s[3 * 33]); o.z = pk2(s[4 * 33], s[5 * 33]); o.w = pk2(s[6 * 33], s[7 * 33]);
        *(u32x4*)(WT + (size_t)(dst_n0 + n) * K + k0 + 8 * c) = o; }
    asm volatile("s_waitcnt lgkmcnt(0)" ::: "memory");
}

DI void weights_phase(ldsp lds, int gw, int NGW, int wave, int lane) {
    if (EPI_NORM) { kargp P = kargs(); float* gwt = (float*)(P->ws + WS_GW);
      for (int i = gw * 64 + lane; i < DM * 4; i += NGW * 64) { const int c = i >> 2, j = i & 3; gwt[i] = P->norm_g[DM + c] * P->w_in[(size_t)DM * DIN + (size_t)c * DIN + 1024 + j]; } }
    { kargp P = kargs(); const float* pw = P->pool_w; bf16_t* wt = (bf16_t*)(P->ws + WS_WPOOL);
      for (int i = gw * 64 + lane; i < DEPTH * 4 * 64 * 64; i += NGW * 64) { const int lg = i >> 12, c = (i >> 6) & 63, d = i & 63; wt[(lg * 64 + d) * 64 + c] = (bf16_t)(pk2(pw[i], 0.f) & 0xffffu); } }
    LAS float* scr = (LAS float*)(lds + wave * 16384);
    constexpr int I_IN = (DM / 64) * (NP / 32), I_OUT = (DMIX / 64) * (DM / 32), I_KV = (DM / 64) * (512 / 32), I_L = I_IN + I_OUT + I_KV;
    for (int it = gw; it < DEPTH * I_L; it += NGW) {
        const int l = it / I_L; int r = it % I_L; kargp P = kargs();
        if (r < I_IN) { const int nblk = NP / 32, kb = r / nblk, nb = r % nblk, n0 = 32 * nb;
            transpose_item(P->w_in + (size_t)l * DM * DIN, DM, DIN, (bf16_t*)(P->ws + WS_WIN + l * WIN_BYTES), 64 * kb, n0 + (n0 >= 1024 ? 4 : 0), n0, scr, lane, (EPI_NORM && l == 1) ? P->norm_g + DM : nullptr); continue; }
        r -= I_IN;
        if (r < I_OUT) { const int nblk = DM / 32, kb = r / nblk, nb = r % nblk;
            transpose_item(P->w_out + (size_t)l * DMIX * DM, DMIX, DM, (bf16_t*)(P->ws + WS_WOUT + l * WOUT_BYTES), 64 * kb, 32 * nb, 32 * nb, scr, lane); continue; }
        r -= I_OUT;
        { const int nblk = 512 / 32, kb = r / nblk, nb = r % nblk;
            transpose_item(P->mem_w_kv + (size_t)l * DM * 512, DM, 512, (bf16_t*)(P->ws + WS_WKV + l * WKV_BYTES), 64 * kb, 32 * nb, 32 * nb, scr, lane); }
    }
}

DI void memnorm_phase(int gw, int NGW, int lane) {
    kargp P = kargs(); const float* mng = P->mem_norm_g; const float* memp = P->mem; unsigned char* ws = P->ws;
    f32x4 g0[4], g1[4];
#pragma unroll
    for (int j = 0; j < 4; ++j) { g0[j] = ((const f32x4*)mng)[64 * j + lane]; g1[j] = ((const f32x4*)(mng + DM))[64 * j + lane]; }
    for (int m = gw; m < NB * NMEM; m += NGW) {
        const f32x4* xr = (const f32x4*)(memp + (size_t)m * DM) + lane;
        f32x4 v[4]; float s = 0.f;
#pragma unroll
        for (int j = 0; j < 4; ++j) { v[j] = xr[64 * j]; s += (v[j].x * v[j].x + v[j].y * v[j].y) + (v[j].z * v[j].z + v[j].w * v[j].w); }
        const float rstd = __builtin_amdgcn_rsqf(wave_sum(s) * (1.f / DM) + EPS);
        u32x2* o0 = (u32x2*)(ws + WS_MNB + (size_t)m * DM * 2) + lane; u32x2* o1 = (u32x2*)(ws + WS_MNB + MNB_BYTES + (size_t)m * DM * 2) + lane;
#pragma unroll
        for (int j = 0; j < 4; ++j) { const f32x4 y = v[j] * rstd; const f32x4 a = y * g0[j], b = y * g1[j];
            o0[64 * j] = (u32x2){pk2(a.x, a.y), pk2(a.z, a.w)}; o1[64 * j] = (u32x2){pk2(b.x, b.y), pk2(b.z, b.w)}; }
    }
}

DI void norm_phase(ldsp lds, const float* x, const float* g, const float* w_in_l, const float* fbias, bf16_t* hb, float* lf, int gw, int NGW, int mend, int tid, int lane) {
    for (int k = tid; k < DM; k += 512) { const int j = k >> 8, ln = (k & 255) >> 2, i = k & 3;
        *(LAS f32x4*)(lds + 16 * ((j * 4 + i) * 64 + ln)) = *(const f32x4*)(w_in_l + (size_t)k * DIN + 1024); }
    __syncthreads();
    f32x4 gv[4];
#pragma unroll
    for (int j = 0; j < 4; ++j) gv[j] = ((const f32x4*)g)[64 * j + lane];
    const float mybias = fbias[lane & 3];
    f32x4 nv[4], nv2[4];
    if (gw < mend) { const f32x4* xr = (const f32x4*)(x + (size_t)gw * DM) + lane;
#pragma unroll
        for (int j = 0; j < 4; ++j) nv[j] = __builtin_nontemporal_load(xr + 64 * j); }
    if (gw + NGW < mend) { const f32x4* xr = (const f32x4*)(x + (size_t)(gw + NGW) * DM) + lane;
#pragma unroll
        for (int j = 0; j < 4; ++j) nv2[j] = __builtin_nontemporal_load(xr + 64 * j); }
    for (int m = gw; m < mend; m += NGW) {
        f32x4 v[4]; float s = 0.f;
#pragma unroll
        for (int j = 0; j < 4; ++j) { v[j] = nv[j]; nv[j] = nv2[j]; }
        if (m + 2 * NGW < mend) { const f32x4* xn = (const f32x4*)(x + (size_t)(m + 2 * NGW) * DM) + lane;
#pragma unroll
            for (int j = 0; j < 4; ++j) nv2[j] = __builtin_nontemporal_load(xn + 64 * j); }
#pragma unroll
        for (int j = 0; j < 4; ++j) s += (v[j].x * v[j].x + v[j].y * v[j].y) + (v[j].z * v[j].z + v[j].w * v[j].w);
        const float rstd = __builtin_amdgcn_rsqf(wave_sum(s) * (1.f / DM) + EPS);
        u32x2* o8 = (u32x2*)(hb + (size_t)m * DM) + lane;
        f32x4 ff = {0.f, 0.f, 0.f, 0.f};
#pragma unroll
        for (int j = 0; j < 4; ++j) { const f32x4 y = (v[j] * rstd) * gv[j];
            o8[64 * j] = (u32x2){pk2(y.x, y.y), pk2(y.z, y.w)};
#pragma unroll
            for (int i = 0; i < 4; ++i) { const f32x4 w = *(LAS f32x4*)(lds + 16 * ((j * 4 + i) * 64 + lane)); ff += w * y[i]; } }
        ff.x = wave_sum(ff.x); ff.y = wave_sum(ff.y); ff.z = wave_sum(ff.z); ff.w = wave_sum(ff.w);
        if (lane < 4) { const float z = (lane == 0 ? ff.x : lane == 1 ? ff.y : lane == 2 ? ff.z : ff.w) + mybias;
            lf[(size_t)m * 4 + lane] = fminf(z, 0.f) - 0.6931471805599453f * __builtin_amdgcn_logf(1.f + ex2(-fabsf(z) * LOG2E)); }
    }
    __syncthreads();
}

DI void knorm_rows(bf16_t* base, int nrows4  , int stride, const float* kw, int gw, int NGW, int lane) {
    const f32x4 w0 = *(const f32x4*)(kw + 8 * (lane & 7)), w1 = *(const f32x4*)(kw + 8 * (lane & 7) + 4);
    for (int r8 = gw; r8 < nrows4 / 8; r8 += NGW) { const int rid = r8 * 8 + (lane >> 3);
        u32x4* p = (u32x4*)(base + (size_t)(rid >> 2) * stride + (rid & 3) * HD + 8 * (lane & 7));
        const u32x4 kr = *p;
        const float f[8] = {bf_lo(kr.x), bf_hi(kr.x), bf_lo(kr.y), bf_hi(kr.y), bf_lo(kr.z), bf_hi(kr.z), bf_lo(kr.w), bf_hi(kr.w)};
        float ss = 0.f;
#pragma unroll
        for (int j = 0; j < 8; ++j) ss += f[j] * f[j];
        ss = sum8(ss);
        const float rstd = __builtin_amdgcn_rsqf(ss * (1.f / HD) + EPS);
        *p = (u32x4){pk2(f[0] * rstd * w0.x, f[1] * rstd * w0.y), pk2(f[2] * rstd * w0.z, f[3] * rstd * w0.w), pk2(f[4] * rstd * w1.x, f[5] * rstd * w1.y), pk2(f[6] * rstd * w1.z, f[7] * rstd * w1.w)}; }
}
DI void kprep_phase(ldsp lds, int layer) {
    kargp P = kargs(); const int tid = threadIdx.x, lane = tid & 63, wave = __builtin_amdgcn_readfirstlane(tid >> 6), gw = blockIdx.x * 8 + wave, NGW = gridDim.x * 8;
    knorm_rows((bf16_t*)(P->ws + WS_PROJ) + C_FK, NTOK * 4, NP, P->fox_k_norm + layer * HD, gw, NGW, lane);
    knorm_rows((bf16_t*)(P->ws + WS_KVM + layer * KVM_BYTES), NB * NMEM * 4, 512, P->mem_k_norm + layer * HD, gw, NGW, lane);
    if (blockIdx.x < NB * NH) {
        const int b = blockIdx.x >> 2, h = blockIdx.x & 3;
        const float* lfp = (const float*)(P->ws + WS_LF) + (size_t)b * SEQ * 4 + h;
        float a[4];
#pragma unroll
        for (int j = 0; j < 4; ++j) a[j] = lfp[(size_t)(4 * tid + j) * 4];
        const float s0 = a[0], s1 = s0 + a[1], s2 = s1 + a[2], s3 = s2 + a[3];
        float inc = s3;
#pragma unroll
        for (int off = 1; off < 64; off <<= 1) { const float v = __shfl_up(inc, off); if (lane >= off) inc += v; }
        LAS float* wsum = (LAS float*)lds;
        if (lane == 63) wsum[wave] = inc;
        __syncthreads();
        float offs = 0.f;
        for (int w = 0; w < wave; ++w) offs += wsum[w];
        const float pre = offs + inc - s3;
        *(f32x4*)((float*)(P->ws + WS_C2) + (size_t)blockIdx.x * SEQ + 4 * tid) = (f32x4){(pre + s0) * LOG2E, (pre + s1) * LOG2E, (pre + s2) * LOG2E, (pre + s3) * LOG2E};
        __syncthreads();
    }
}

constexpr int ATT_SLOT = 16384, ATT_NSLOT = 5, ATT_NRES = 6, ATT_CS = ATT_NRES * ATT_SLOT, ATT_FLAG = ATT_CS + 8192, ATT_RK = ATT_FLAG + 128, ATT_WT = ATT_RK + ATT_NRES * 256, ATT_Q = ATT_WT + 64, ATT_QN = ATT_Q + 32768, ATT_END = ATT_QN + 1024;
static_assert(ATT_END <= 147392, "attention LDS map");
#ifndef FUSE_NORM
#define FUSE_NORM 0
#endif
#ifndef ATT_STAGGER
#define ATT_STAGGER 0
#endif
#ifndef ATT_TILE_SKIP
#define ATT_TILE_SKIP 1
#endif
DI int crow(int reg, int h) { return (reg & 3) + 8 * (reg >> 2) + 4 * h; }
DI int swz8(int row) { const int x = (row >> 1) & 7; return ((x & 1) << 2) | (x >> 1); }
DI u32x4 pack8(const f32x16& p, int s) { return (u32x4){pk2(p[8 * s], p[8 * s + 1]), pk2(p[8 * s + 2], p[8 * s + 3]), pk2(p[8 * s + 4], p[8 * s + 5]), pk2(p[8 * s + 6], p[8 * s + 7])}; }
DI s16x4 tr_rd(ldsp p) { typedef short v4i16_t __attribute__((ext_vector_type(4))); return __builtin_bit_cast(s16x4, __builtin_amdgcn_ds_read_tr16_b64_v4i16((LAS v4i16_t*)p)); }
DI void att_zero(f32x16& p0, f32x16& p1) {
#pragma unroll
    for (int i = 0; i < 16; ++i) { p0[i] = 0.f; p1[i] = 0.f; }
}
template <int MODE> DI void att_bias(f32x16& p0, f32x16& p1, ldsp lds, int slot, int kt, int hh) {
    if (MODE == 1) return;
#pragma unroll
    for (int g = 0; g < 4; ++g) {
        const f32x4 r0 = *(LAS f32x4*)(lds + ATT_RK + 4 * (64 * slot + 8 * g + 4 * hh)), r1 = *(LAS f32x4*)(lds + ATT_RK + 4 * (64 * slot + 32 + 8 * g + 4 * hh));
        if (MODE == 0) { const f32x4 c0 = *(LAS f32x4*)(lds + ATT_CS + 4 * (64 * kt + 8 * g + 4 * hh)), c1 = *(LAS f32x4*)(lds + ATT_CS + 4 * (64 * kt + 32 + 8 * g + 4 * hh));
#pragma unroll
            for (int j = 0; j < 4; ++j) { p0[4 * g + j] = p0[4 * g + j] * r0[j] + c0[j]; p1[4 * g + j] = p1[4 * g + j] * r1[j] + c1[j]; } }
        else {
#pragma unroll
            for (int j = 0; j < 4; ++j) { p0[4 * g + j] *= r0[j]; p1[4 * g + j] *= r1[j]; } }
    }
}
template <int MODE> DI void att_prep(ldsp lds, int slot, int kt, const float* lfp, int tid, int lane, int wid) {
    if (MODE == 1) return;
    { const int row = tid >> 3, sc = tid & 7;
      const u32x4 kr = *(LAS u32x4*)(lds + slot * ATT_SLOT + row * 128 + ((sc ^ swz8(row)) << 4));
      const float f[8] = {bf_lo(kr.x), bf_hi(kr.x), bf_lo(kr.y), bf_hi(kr.y), bf_lo(kr.z), bf_hi(kr.z), bf_lo(kr.w), bf_hi(kr.w)};
      float ss = 0.f;
#pragma unroll
      for (int j = 0; j < 8; ++j) ss += f[j] * f[j];
      ss = sum8(ss);
      if (sc == 0) *(LAS float*)(lds + ATT_RK + 4 * (64 * slot + row)) = __builtin_amdgcn_rsqf(ss * (1.f / HD) + EPS); }
    if (MODE == 0 && wid == 0) {
        const float a = lfp[(size_t)(64 * kt + lane) * 4] * LOG2E;
        float suf = a;
#pragma unroll
        for (int off = 1; off < 64; off <<= 1) { const float v = __shfl_down(suf, off); if (lane + off < 64) suf += v; }
        const float E = *(LAS float*)(lds + ATT_WT + 32);
        *(LAS float*)(lds + ATT_CS + 4 * (64 * kt + lane)) = E + suf - a;
        if (lane == 0) *(LAS float*)(lds + ATT_WT + 32) = E + suf;
    }
}
DI void att_qk(f32x16& p0, f32x16& p1, ldsp Kb, ldsp Qb  , int r, int hh) {
    const int sw = swz8(r);
#pragma unroll
    for (int ks = 0; ks < 4; ++ks) {
        const int co = ((2 * ks + hh) ^ sw) << 4;
        const bf16x8 k0 = *(LAS bf16x8*)(Kb + r * 128 + co);
        const bf16x8 k1 = *(LAS bf16x8*)(Kb + (32 + r) * 128 + co);
        const bf16x8 qv = *(LAS bf16x8*)(Qb + 1024 * ks);
        p0 = MFMA32(k0, qv, p0); p1 = MFMA32(k1, qv, p1); }
}
DI void att_pv(f32x16& o0, f32x16& o1, ldsp Vb, const f32x16& p0, const f32x16& p1, int hh, int q4, int p4, int blk) {
    const int rl = 4 * hh + q4, sl = swz8(rl), sh = swz8(rl + 8), cb = 2 * blk + (p4 >> 1), in8 = 8 * (p4 & 1);
    const int ol0 = rl * 128 + ((cb ^ sl) << 4) + in8, ol1 = rl * 128 + (((4 + cb) ^ sl) << 4) + in8;
    const int oh0 = (rl + 8) * 128 + ((cb ^ sh) << 4) + in8, oh1 = (rl + 8) * 128 + (((4 + cb) ^ sh) << 4) + in8;
#pragma unroll
    for (int sb = 0; sb < 2; ++sb)
#pragma unroll
        for (int s = 0; s < 2; ++s) {
            const bf16x8 pf = __builtin_bit_cast(bf16x8, pack8(sb ? p1 : p0, s));
            ldsp a = Vb + (32 * sb + 16 * s) * 128;
            const s16x4 l0 = tr_rd(a + ol0), h0 = tr_rd(a + oh0), l1 = tr_rd(a + ol1), h1 = tr_rd(a + oh1);
            const bf16x8 v0 = __builtin_shufflevector(l0, h0, 0, 1, 2, 3, 4, 5, 6, 7), v1 = __builtin_shufflevector(l1, h1, 0, 1, 2, 3, 4, 5, 6, 7);
            o0 = MFMA32(v0, pf, o0); o1 = MFMA32(v1, pf, o1);
        }
}
DI void att_softmax(f32x16& p0, f32x16& p1, float& m_run, float& l_run, f32x16& o0, f32x16& o1) {
    float tm = fmaxf(p0[0], p1[0]);
#pragma unroll
    for (int i = 1; i < 16; ++i) tm = fmaxf(tm, fmaxf(p0[i], p1[i]));
    { float lo_, hi_; halves(tm, lo_, hi_); tm = fmaxf(lo_, hi_); }
    const float mn = fmaxf(m_run, tm);
    if (__any(mn > m_run)) { const float alpha = ex2(m_run - mn); l_run *= alpha;
#pragma unroll
        for (int i = 0; i < 16; ++i) { o0[i] *= alpha; o1[i] *= alpha; } }
    m_run = mn;
    float rs = 0.f;
#pragma unroll
    for (int i = 0; i < 16; ++i) { p0[i] = ex2(p0[i] - mn); p1[i] = ex2(p1[i] - mn); rs += p0[i] + p1[i]; }
    l_run += rs;
}
DI float mul_s(float a, float b) { return a * b; }
template <bool BAND> DI void att_sb(f32x16& p0, f32x16& p1, float& R, int jrel, int qrel, int hh) {
#pragma unroll
    for (int sb = 1; sb >= 0; --sb) {
#pragma unroll
        for (int g = 3; g >= 0; --g) {
            float omb[4], be[4];
#pragma unroll
            for (int j = 0; j < 4; ++j) { const float z = sb ? p1[4 * g + j] : p0[4 * g + j];
                float e = ex2(z);
                if (BAND) { const int kv = 64 * jrel + 32 * sb + 8 * g + 4 * hh + j; if (kv >= qrel) e = 0.f; }
                omb[j] = rcpf_(1.f + e); be[j] = 1.f - omb[j]; }
            const float t2 = omb[3], t1 = mul_s(t2, omb[2]), t0 = mul_s(t1, omb[1]), my4 = mul_s(t0, omb[0]);
            float lo_, hi_; halves(my4, lo_, hi_);
            const float base = hh ? R : mul_s(R, hi_);
            const float w3 = mul_s(be[3], base), w2 = mul_s(be[2], mul_s(base, t2)), w1 = mul_s(be[1], mul_s(base, t1)), w0 = mul_s(be[0], mul_s(base, t0));
            R = mul_s(R, mul_s(lo_, hi_));
            if (sb) { p1[4 * g] = w0; p1[4 * g + 1] = w1; p1[4 * g + 2] = w2; p1[4 * g + 3] = w3; }
            else { p0[4 * g] = w0; p0[4 * g + 1] = w1; p0[4 * g + 2] = w2; p0[4 * g + 3] = w3; }
        }
    }
}
DI void glds16(const void* gsrc, unsigned lds_dst) { unsigned keep;
    asm volatile("s_mov_b32 %0, m0\n\ts_mov_b32 m0, %2\n\ts_nop 0\n\tglobal_load_lds_dwordx4 %1, off\n\ts_mov_b32 m0, %0" : "=&s"(keep) : "v"(gsrc), "s"(lds_dst) : "memory"); }
#define ATT_WAITBAR(N) asm volatile("s_waitcnt vmcnt(" #N ") lgkmcnt(0)\n\ts_barrier" ::: "memory")

template <int MODE>
DI void attn_unit(ldsp lds, const bf16_t* Qp, const bf16_t* Kp, const bf16_t* Vp, int kvstride, const bf16_t* Gp, bf16_t* Op, const float* lfp  , const float* qnw, const float* knw, int qt, int nq) {
    int tid_ = threadIdx.x; asm volatile("" : "+v"(tid_));
    const int tid = tid_, lane = tid & 63, wid = __builtin_amdgcn_readfirstlane(tid >> 6), r = lane & 31, hh = lane >> 5;
    qnw = launder(qnw); lfp = launder(lfp); knw = launder(knw);
    const int NT = (MODE == 2) ? 4 : 4 * qt + 4;
    const int NRES = NT < ATT_NRES ? NT : ATT_NRES;
#define ATT_KT(i) ((MODE == 2) ? (i) : NT - 1 - (i))
    const int drow = 8 * wid + (lane >> 3);
    const size_t dma_off = (size_t)drow * kvstride + 8 * ((lane & 7) ^ swz8(drow));
    const unsigned lds0 = (unsigned)(uintptr_t)lds;
#define ATT_DMA_TO(i, slot) do { const size_t to_ = (size_t)ATT_KT(i) * 64 * kvstride + dma_off; const unsigned sl_ = __builtin_amdgcn_readfirstlane(lds0 + (slot) * ATT_SLOT + wid * 1024); \
        glds16(Kp + to_, sl_); glds16(Vp + to_, sl_ + 8192); } while (0)
#define ATT_DMA(i) ATT_DMA_TO(i, (i) % ATT_NSLOT)
    u32x4 qraw[4];
    { const bf16_t* qrow = Qp + (size_t)(qt * 256 + wid * 32 + (lane >> 3)) * NP + 8 * (lane & 7);
#pragma unroll
      for (int i = 0; i < 4; ++i) qraw[i] = *(const u32x4*)(qrow + (size_t)(8 * i) * NP); }
#pragma unroll 1
    for (int i = 0; i < NRES; ++i) ATT_DMA_TO(i, i);
    if (tid < 24) *(LAS unsigned*)(lds + ATT_FLAG + 4 * tid) = 0u;
    float sufv = 0.f, av = 0.f; const int klo = 64 * (NT - NRES), kcnt = 64 * NRES;
    if (MODE == 0) {
        if (tid < kcnt) av = lfp[(size_t)(klo + tid) * 4] * LOG2E;
        sufv = av;
#pragma unroll
        for (int off = 1; off < 64; off <<= 1) { const float v = __shfl_down(sufv, off); if (lane + off < 64) sufv += v; }
        if (lane == 0) *(LAS float*)(lds + ATT_WT + 4 * wid) = sufv;
    }
    ATT_WAITBAR(0);
#pragma unroll 1
    for (int i = 0; i < NRES; ++i) att_prep<(MODE == 0) ? 2 : MODE>(lds, i, 0, nullptr, tid, lane, wid);
    if (MODE == 0) { float offs = 0.f;
#pragma unroll
        for (int w = 0; w < 8; ++w) { const float x = *(LAS float*)(lds + ATT_WT + 4 * w); if (w > wid) offs += x; }
        if (tid < kcnt) *(LAS float*)(lds + ATT_CS + 4 * (klo + tid)) = offs + sufv - av;
        if (tid == 0) *(LAS float*)(lds + ATT_WT + 32) = offs + sufv; }
    asm volatile("s_waitcnt lgkmcnt(0)\n\ts_barrier" ::: "memory");
    const int qrel = 32 * wid + r;
    const int q4 = (lane & 15) >> 2, p4 = lane & 3, blk = (lane >> 4) & 1;
    ldsp Qb = lds + ATT_Q + wid * 4096 + lane * 16;
#pragma unroll 1
    for (int qq = 0; qq < nq; ++qq) {
        const int q0 = (qt + qq) * 256;
        { const int c8 = lane & 7;
          float w[8];
#pragma unroll
          for (int j = 0; j < 8; ++j) w[j] = (MODE != 1) ? qnw[8 * c8 + j] * knw[8 * c8 + j] : 1.f;
#pragma unroll
          for (int i = 0; i < 4; ++i) { const u32x4 raw = qraw[i]; const int rho = (lane >> 3) + 8 * i;
              float v[8] = {bf_lo(raw.x), bf_hi(raw.x), bf_lo(raw.y), bf_hi(raw.y), bf_lo(raw.z), bf_hi(raw.z), bf_lo(raw.w), bf_hi(raw.w)};
              float sc_all = 0.125f * LOG2E;
              if (MODE != 1) { float ss = 0.f;
#pragma unroll
                  for (int j = 0; j < 8; ++j) ss += v[j] * v[j];
                  sc_all *= __builtin_amdgcn_rsqf(sum8(ss) * (1.f / HD) + EPS); }
              float q2 = 0.f;
#pragma unroll
              for (int j = 0; j < 8; ++j) { v[j] = v[j] * sc_all * w[j]; q2 += v[j] * v[j]; }
              *(LAS u32x4*)(lds + ATT_Q + wid * 4096 + (c8 >> 1) * 1024 + ((c8 & 1) * 32 + rho) * 16) = (u32x4){pk2(v[0], v[1]), pk2(v[2], v[3]), pk2(v[4], v[5]), pk2(v[6], v[7])};
              if (MODE == 0) { q2 = sum8(q2); if (c8 == 0) *(LAS float*)(lds + ATT_QN + wid * 128 + 4 * rho) = sqrtf(q2) * 8.f * 1.02f; } } }
        if (qq + 1 < nq) { const bf16_t* qrow = Qp + (size_t)(q0 + 256 + wid * 32 + (lane >> 3)) * NP + 8 * (lane & 7);
#pragma unroll
            for (int i = 0; i < 4; ++i) qraw[i] = *(const u32x4*)(qrow + (size_t)(8 * i) * NP); }
        u32x4 graw[4];
#pragma unroll
        for (int i = 0; i < 4; ++i) graw[i] = *(const u32x4*)(Gp + (size_t)(q0 + wid * 32 + (lane >> 3) + 8 * i) * NP + 8 * (lane & 7));
        float smax = 0.f;
        if (MODE == 0) smax = *(LAS float*)(lds + ATT_QN + wid * 128 + 4 * r);

        float m_run = -INFINITY, l_run = 0.f, R = 1.f;
        f32x16 o0, o1, p0, p1;
#pragma unroll
        for (int i = 0; i < 16; ++i) { o0[i] = 0.f; o1[i] = 0.f; }
        bool done = false;
#pragma unroll 1
        for (int it = (MODE == 2) ? 0 : 3 - ((32 * wid + 31) >> 6); it < NRES; ++it) {
            const bool band = (MODE != 2) && it < 4;
            const int jrel = 3 - it;
#if ATT_TILE_SKIP
            if (MODE != 2 && !band) {
                bool sk;
                if (MODE == 0) { const float nmax = *(LAS float*)(lds + ATT_CS + 4 * (64 * ATT_KT(it) + 63));
                    sk = !__any(nmax + smax >= m_run - 48.f); }
                else sk = !__any(R >= 0x1p-48f);
                if (sk) { done = true; break; }
            }
#endif
            ldsp Kb = lds + it * ATT_SLOT;
            att_zero(p0, p1);
            att_qk(p0, p1, Kb, Qb, r, hh);
            att_bias<MODE>(p0, p1, lds, it, ATT_KT(it), hh);
            if (MODE == 1) { if (band) att_sb<true>(p0, p1, R, jrel, qrel, hh); else att_sb<false>(p0, p1, R, -1, qrel, hh); }
            else {
                if (MODE == 0 && band) {
#pragma unroll
                    for (int e = 0; e < 16; ++e) { const int kv = 64 * jrel + crow(e, hh); if (kv > qrel) p0[e] = -INFINITY; if (kv + 32 > qrel) p1[e] = -INFINITY; } }
                att_softmax(p0, p1, m_run, l_run, o0, o1);
            }
            att_pv(o0, o1, Kb + 8192, p0, p1, hh, q4, p4, blk);
        }
        if (MODE != 2 && NRES < NT) {
            if (lane == 0) *(LAS unsigned*)(lds + ATT_FLAG + 64 + 4 * wid) = done ? 0u : 1u;
            asm volatile("s_waitcnt lgkmcnt(0)\n\ts_barrier" ::: "memory");
            const u32x4 n0 = *(LAS u32x4*)(lds + ATT_FLAG + 64), n1 = *(LAS u32x4*)(lds + ATT_FLAG + 80);
            if (__builtin_amdgcn_readfirstlane((n0.x | n0.y) | (n0.z | n0.w) | (n1.x | n1.y) | (n1.z | n1.w)) != 0u) {
                const int it0 = NRES;
                ATT_DMA(it0); if (it0 + 1 < NT) ATT_DMA(it0 + 1); if (it0 + 2 < NT) ATT_DMA(it0 + 2);
                ATT_WAITBAR(0);
#pragma unroll 1
                for (int k = 0; k < 3; ++k) if (it0 + k < NT) att_prep<MODE>(lds, (it0 + k) % ATT_NSLOT, ATT_KT(it0 + k), lfp, tid, lane, wid);
                asm volatile("s_waitcnt lgkmcnt(0)\n\ts_barrier" ::: "memory");
                bool skipcur = false;
#pragma unroll 1
                for (int s2 = 2 * it0; s2 < 2 * NT; ++s2) {
                    const int i = s2 >> 1;
#if ATT_TILE_SKIP
                    if ((s2 & 1) == 0 && i > it0) {
                        const u32x4 f0 = *(LAS u32x4*)(lds + ATT_FLAG + 32 * ((i - 1) & 1)), f1 = *(LAS u32x4*)(lds + ATT_FLAG + 32 * ((i - 1) & 1) + 16);
                        if (__builtin_amdgcn_readfirstlane((f0.x & f0.y) & (f0.z & f0.w) & (f1.x & f1.y) & (f1.z & f1.w)) != 0u) break; }
#endif
                    if ((s2 & 1) == 0 && i + 3 < NT) ATT_DMA(i + 3);
                    ldsp Kb = lds + (i % ATT_NSLOT) * ATT_SLOT;
                    if ((s2 & 1) == 0) {
                        skipcur = done;
#if ATT_TILE_SKIP
                        if (!skipcur) {
                            if (MODE == 0) { const float nmax = *(LAS float*)(lds + ATT_CS + 4 * (64 * ATT_KT(i) + 63)); skipcur = !__any(nmax + smax >= m_run - 48.f); }
                            else skipcur = !__any(R >= 0x1p-48f);
                            if (skipcur) done = true; }
                        if (skipcur && lane == 0) *(LAS unsigned*)(lds + ATT_FLAG + 32 * (i & 1) + 4 * wid) = 1u;
#endif
                        if (!skipcur) { att_zero(p0, p1); att_qk(p0, p1, Kb, Qb, r, hh); att_bias<MODE>(p0, p1, lds, i % ATT_NSLOT, ATT_KT(i), hh); }
                    } else {
                        if (!skipcur) {
                            if (MODE == 1) att_sb<false>(p0, p1, R, -1, qrel, hh); else att_softmax(p0, p1, m_run, l_run, o0, o1);
                            att_pv(o0, o1, Kb + 8192, p0, p1, hh, q4, p4, blk); }
                        ATT_WAITBAR(0);
                        if (i + 3 < NT) att_prep<MODE>(lds, (i + 3) % ATT_NSLOT, ATT_KT(i + 3), lfp, tid, lane, wid);
                        asm volatile("s_waitcnt lgkmcnt(0)\n\ts_barrier" ::: "memory");
                    }
                }
                ATT_WAITBAR(0);
            }
        }
        float inv = 1.f;
        if (MODE != 1) { float lo_, hi_; halves(l_run, lo_, hi_); inv = 1.0f / (lo_ + hi_); }
        ldsp st = lds + ATT_Q + wid * 4096;
#pragma unroll
        for (int i = 0; i < 4; ++i) { const int grow = (lane >> 3) + 8 * i; *(LAS u32x4*)(st + grow * 128 + (((lane & 7) ^ (grow & 7)) << 4)) = graw[i]; }
#pragma unroll
        for (int dt = 0; dt < 2; ++dt)
#pragma unroll
            for (int g = 0; g < 4; ++g) {
                const u32x2 gr = *(LAS u32x2*)(st + r * 128 + (((4 * dt + g) ^ (r & 7)) << 4) + 8 * hh);
                const float g0 = silu_f(bf_lo(gr.x)), g1 = silu_f(bf_hi(gr.x)), g2 = silu_f(bf_lo(gr.y)), g3 = silu_f(bf_hi(gr.y));
                const float a0 = dt ? o1[4 * g] : o0[4 * g], a1 = dt ? o1[4 * g + 1] : o0[4 * g + 1], a2 = dt ? o1[4 * g + 2] : o0[4 * g + 2], a3 = dt ? o1[4 * g + 3] : o0[4 * g + 3];
                *(LAS u32x2*)(st + r * 128 + (((4 * dt + g) ^ (r & 7)) << 4) + 8 * hh) = (u32x2){pk2(a0 * inv * g0, a1 * inv * g1), pk2(a2 * inv * g2, a3 * inv * g3)}; }
#pragma unroll
        for (int i = 0; i < 4; ++i) { const int orow = (lane >> 3) + 8 * i, c16 = lane & 7;
            const u32x4 v = *(LAS u32x4*)(st + orow * 128 + ((c16 ^ (orow & 7)) << 4));
            *(u32x4*)(Op + (size_t)(q0 + wid * 32 + orow) * DMIX + 8 * c16) = v; }
    }
    asm volatile("s_waitcnt lgkmcnt(0)\n\ts_barrier" ::: "memory");
#undef ATT_KT
#undef ATT_DMA
#undef ATT_DMA_TO
}

constexpr int HG_Q = 0, HG_F = 8192, HG_V = 16384, HG_O = 24576;
DI void hgrn_unit_valu(ldsp lds, const bf16_t* pj  , bf16_t* mx  , int h, int layer, const float* lb_logits, const float* onorm) {
    int tid_ = threadIdx.x; asm volatile("" : "+v"(tid_));
    const int tid = tid_, lane = tid & 63, wid = __builtin_amdgcn_readfirstlane(tid >> 6);
    lb_logits = launder(lb_logits); onorm = launder(onorm);
    const int tt = tid >> 4, c4 = (tid & 15) * 4;
    float oml[4], onw[4];
#pragma unroll
    for (int j = 0; j < 4; ++j) { const int c = h * HD + c4 + j;
        float lbv = 0.f;
        if (layer == 1) { const float l0 = lb_logits[c], l1 = lb_logits[256 + c], mx_ = fmaxf(l0, l1), e0 = expf(l0 - mx_), e1 = expf(l1 - mx_), p0 = e0 / (e0 + e1), p1 = e1 / (e0 + e1);
            lbv = fminf(fmaxf((p0 + p1) - p0, 0.f), 1.0f - 1e-6f); }
        oml[j] = 1.f - lbv; onw[j] = onorm[c]; }
    f32x2 S2[4];
#pragma unroll
    for (int i = 0; i < 4; ++i) S2[i] = (f32x2){0.f, 0.f};
    const bf16_t* base = pj + (size_t)tt * NP + h * HD + c4;
    u32x2 rq = *(const u32x2*)(base + C_HQ), rf = *(const u32x2*)(base + C_HF), ri = *(const u32x2*)(base + C_HI);
#pragma unroll 1
    for (int ch = 0; ch < SEQ / 32; ++ch) {
        { const float hq[4] = {bf_lo(rq.x), bf_hi(rq.x), bf_lo(rq.y), bf_hi(rq.y)}, hf[4] = {bf_lo(rf.x), bf_hi(rf.x), bf_lo(rf.y), bf_hi(rf.y)};
          f32x4 q, f;
#pragma unroll
          for (int j = 0; j < 4; ++j) { q[j] = silu_f(hq[j]); const float sg = rcpf_(1.f + ex2(hf[j] * LOG2E)); f[j] = 1.f - oml[j] * sg; }
          *(LAS f32x4*)(lds + HG_Q + 4 * (tt * 64 + c4)) = q; *(LAS f32x4*)(lds + HG_F + 4 * (tt * 64 + c4)) = f;
          *(LAS f32x4*)(lds + HG_V + 4 * (tt * 64 + c4)) = (f32x4){bf_lo(ri.x), bf_hi(ri.x), bf_lo(ri.y), bf_hi(ri.y)}; }
        __syncthreads();
        if (ch + 1 < SEQ / 32) { const bf16_t* nb = base + (size_t)(ch + 1) * 32 * NP; rq = *(const u32x2*)(nb + C_HQ); rf = *(const u32x2*)(nb + C_HF); ri = *(const u32x2*)(nb + C_HI); }
        const u32x2 gr = *(const u32x2*)(base + (size_t)ch * 32 * NP + C_HG);
        float acc[32];
#pragma unroll
        for (int t = 0; t < 32; ++t) {
            const f32x4 qa = *(LAS f32x4*)(lds + HG_Q + 4 * (t * 64 + 8 * wid)), qb = *(LAS f32x4*)(lds + HG_Q + 4 * (t * 64 + 8 * wid + 4));
            const f32x4 fa = *(LAS f32x4*)(lds + HG_F + 4 * (t * 64 + 8 * wid)), fb = *(LAS f32x4*)(lds + HG_F + 4 * (t * 64 + 8 * wid + 4));
            const float v = *(LAS float*)(lds + HG_V + 4 * (t * 64 + lane));
            const f32x2 v2 = {v, v};
            S2[0] = (f32x2){fa.x, fa.y} * (S2[0] - v2) + v2; S2[1] = (f32x2){fa.z, fa.w} * (S2[1] - v2) + v2;
            S2[2] = (f32x2){fb.x, fb.y} * (S2[2] - v2) + v2; S2[3] = (f32x2){fb.z, fb.w} * (S2[3] - v2) + v2;
            f32x2 a2 = S2[0] * (f32x2){qa.x, qa.y}, b2 = S2[1] * (f32x2){qa.z, qa.w};
            a2 += S2[2] * (f32x2){qb.x, qb.y}; b2 += S2[3] * (f32x2){qb.z, qb.w};
            a2 += b2; acc[t] = a2.x + a2.y;
        }
#pragma unroll
        for (int t = 0; t < 32; ++t) *(LAS float*)(lds + HG_O + 4 * ((wid * 32 + t) * 64 + lane)) = acc[t];
        __syncthreads();
        f32x4 o = *(LAS f32x4*)(lds + HG_O + 4 * (tt * 64 + c4));
#pragma unroll
        for (int w = 1; w < 8; ++w) o += *(LAS f32x4*)(lds + HG_O + 4 * ((w * 32 + tt) * 64 + c4));
        float ss = (o.x * o.x + o.y * o.y) + (o.z * o.z + o.w * o.w);
        ss = sum16(ss);
        const float rstd = 1.0f / sqrtf(ss * (1.f / HD) + EPS);
        const float g0 = silu_f(bf_lo(gr.x)), g1 = silu_f(bf_hi(gr.x)), g2 = silu_f(bf_lo(gr.y)), g3 = silu_f(bf_hi(gr.y));
        *(u32x2*)(mx + (size_t)(ch * 32 + tt) * DMIX + O_HG + h * HD + c4) = (u32x2){pk2(o.x * rstd * onw[0] * g0, o.y * rstd * onw[1] * g1), pk2(o.z * rstd * onw[2] * g2, o.w * rstd * onw[3] * g3)};
    }
    __syncthreads();
}

typedef short s16x4v __attribute__((ext_vector_type(4)));
#define MFMA16(a, b, c) __builtin_amdgcn_mfma_f32_16x16x16bf16_1k((a), (b), (c), 0, 0, 0)
constexpr int HM_QS = 0, HM_QM = 16 * 136, HM_KM = 2 * 16 * 136, HM_KET = 3 * 16 * 136, HM_VT = HM_KET + 64 * 40, HM_DEC = HM_VT + 64 * 40, HM_SLOT = HM_DEC + 256, HM_NS = 4, HM_OB = HM_NS * HM_SLOT, HM_OSTR = 272;
constexpr int HM_RAW = HM_OB + 2 * 16 * HM_OSTR, HM_RSLOT = 8192, HM_NR = 8;
static_assert(HM_SLOT % 16 == 0 && HM_RAW % 16 == 0 && HM_RAW + HM_NR * HM_RSLOT <= 147392, "HGRN LDS map");
DI s16x4v pack4(const f32x4 v) { u32x2 p = {pk2(v.x, v.y), pk2(v.z, v.w)}; return __builtin_bit_cast(s16x4v, p); }
DI void hgrn_unit(ldsp lds, const bf16_t* pj  , bf16_t* mx  , int h, int layer, const float* lb_logits, const float* onorm) {
    int tid_ = threadIdx.x; asm volatile("" : "+v"(tid_));
    const int tid = tid_, lane = tid & 63, wid = __builtin_amdgcn_readfirstlane(tid >> 6);
    lb_logits = launder(lb_logits); onorm = launder(onorm);
    const bool cons = wid < 4;
    const int fr = lane & 15, fq = lane >> 4;
    constexpr int NBLK = SEQ / 16;
    const int dl = lane >> 2, tq = lane & 3;
    const int pd = 16 * (wid & 3) + dl;
    float oml = 1.f;
    if (layer == 1) { const float l0 = lb_logits[h * HD + pd], l1 = lb_logits[256 + h * HD + pd], mx_ = fmaxf(l0, l1), e0 = expf(l0 - mx_), e1 = expf(l1 - mx_), p0 = e0 / (e0 + e1), p1 = e1 / (e0 + e1);
        oml = 1.f - fminf(fmaxf((p0 + p1) - p0, 0.f), 1.0f - 1e-6f); }
    f32x4 Sacc[4];
#pragma unroll
    for (int i = 0; i < 4; ++i) Sacc[i] = (f32x4){0.f, 0.f, 0.f, 0.f};
    const int e4 = 4 * fr, trow = 4 * wid + fq;
    const f32x4 onw = *(const f32x4*)(onorm + h * HD + e4);
    const unsigned lds0 = (unsigned)(uintptr_t)lds;
    const int pseg = (wid & 3);
    const bf16_t* dsrc = pj + (size_t)(lane >> 3) * NP + (pseg == 0 ? C_HQ : pseg == 1 ? C_HF : pseg == 2 ? C_HI : C_HG) + h * HD + 8 * (lane & 7);
#define HM_DMA(blk) do { const unsigned d_ = __builtin_amdgcn_readfirstlane(lds0 + HM_RAW + ((blk) & (HM_NR - 1)) * HM_RSLOT + pseg * 2048); \
        glds16(dsrc + (size_t)(blk) * 16 * NP, d_); glds16(dsrc + (size_t)((blk) * 16 + 8) * NP, d_ + 1024); } while (0)
    if (!cons) { HM_DMA(0); HM_DMA(1); HM_DMA(2); HM_DMA(3); asm volatile("s_waitcnt vmcnt(6)" ::: "memory"); }
    asm volatile("s_waitcnt lgkmcnt(0)\n\ts_barrier" ::: "memory");
#pragma unroll 1
    for (int n = -2; n <= NBLK; ++n) {
        if (!cons) {
            const int nb = n + 2;
            if (n + 6 < NBLK) HM_DMA(n + 6);
            if (nb < NBLK) {
                ldsp sb = lds + (nb & 3) * HM_SLOT;
                ldsp rw = lds + HM_RAW + (nb & (HM_NR - 1)) * HM_RSLOT + (4 * tq) * 128 + 2 * pd;
                float q[4], k[4], c[4], v[4];
#pragma unroll
                for (int i = 0; i < 4; ++i) { const float hq = __uint_as_float((unsigned)*(LAS bf16_t*)(rw + i * 128) << 16), hf = __uint_as_float((unsigned)*(LAS bf16_t*)(rw + 2048 + i * 128) << 16);
                    v[i] = __uint_as_float((unsigned)*(LAS bf16_t*)(rw + 4096 + i * 128) << 16);
                    q[i] = silu_f(hq); k[i] = oml * rcpf_(1.f + ex2(hf * LOG2E));
                    c[i] = fmaxf(__builtin_amdgcn_logf(1.f - k[i]), -15.f); }
                c[1] += c[0]; c[2] += c[1]; c[3] += c[2];
                float inc = c[3];
                { const float u1 = dppf<0x90>(inc); if (tq >= 1) inc += u1; const float u2 = dppf<0x44>(inc); if (tq >= 2) inc += u2; }
                const float exc = inc - c[3];
                const float Bm = dppf<0x55>(inc), Be = dppf<0xFF>(inc);
                s16x4v ket, vt; bf16_t* ketp = (bf16_t*)&ket; bf16_t* vtp = (bf16_t*)&vt;
#pragma unroll
                for (int i = 0; i < 4; ++i) { const float B = exc + c[i]; const int t = 4 * tq + i;
                    *(LAS bf16_t*)(sb + HM_QS + t * 136 + 2 * pd) = (bf16_t)(pk2(q[i] * ex2(B), 0.f) & 0xffffu);
                    *(LAS bf16_t*)(sb + HM_QM + t * 136 + 2 * pd) = (bf16_t)(pk2(q[i] * ex2(B - Bm), 0.f) & 0xffffu);
                    *(LAS bf16_t*)(sb + HM_KM + t * 136 + 2 * pd) = (bf16_t)(pk2(k[i] * ex2(Bm - B), 0.f) & 0xffffu);
                    ketp[i] = (bf16_t)(pk2(k[i] * ex2(Be - B), 0.f) & 0xffffu); vtp[i] = (bf16_t)(pk2(v[i], 0.f) & 0xffffu); }
                *(LAS s16x4v*)(sb + HM_KET + pd * 40 + 8 * tq) = ket;
                *(LAS s16x4v*)(sb + HM_VT + pd * 40 + 8 * tq) = vt;
                if (tq == 3) *(LAS float*)(sb + HM_DEC + 4 * pd) = ex2(Be);
            }
            { const int ahead = (n + 6 < NBLK ? n + 6 : NBLK - 1) - (n + 3);
              if (ahead >= 3) asm volatile("s_waitcnt vmcnt(6)" ::: "memory"); else if (ahead == 2) asm volatile("s_waitcnt vmcnt(4)" ::: "memory");
              else if (ahead == 1) asm volatile("s_waitcnt vmcnt(2)" ::: "memory"); else asm volatile("s_waitcnt vmcnt(0)" ::: "memory"); }
        } else {
            if (n >= 1) {
                const f32x4 o = *(LAS f32x4*)(lds + HM_OB + ((n - 1) & 1) * 16 * HM_OSTR + trow * HM_OSTR + 4 * e4);
                const u32x2 gv = *(LAS u32x2*)(lds + HM_RAW + ((n - 1) & (HM_NR - 1)) * HM_RSLOT + 3 * 2048 + trow * 128 + 2 * e4);
                const float ss = sum16((o.x * o.x + o.y * o.y) + (o.z * o.z + o.w * o.w));
                const float rstd = __builtin_amdgcn_rsqf(ss * (1.f / HD) + EPS);
                const float g0 = silu_f(bf_lo(gv.x)), g1 = silu_f(bf_hi(gv.x)), g2 = silu_f(bf_lo(gv.y)), g3 = silu_f(bf_hi(gv.y));
                *(u32x2*)(mx + (size_t)(16 * (n - 1) + trow) * DMIX + O_HG + h * HD + e4) = (u32x2){pk2(o.x * rstd * onw.x * g0, o.y * rstd * onw.y * g1), pk2(o.z * rstd * onw.z * g2, o.w * rstd * onw.w * g3)};
            }
            if (n >= 0 && n < NBLK) {
                ldsp sb = lds + (n & 3) * HM_SLOT;
                s16x4v qm[4], qs[4], km[4];
#pragma unroll
                for (int dt = 0; dt < 4; ++dt) { const int co = fr * 136 + (16 * dt + 4 * fq) * 2;
                    qm[dt] = *(LAS s16x4v*)(sb + HM_QM + co); qs[dt] = *(LAS s16x4v*)(sb + HM_QS + co); km[dt] = *(LAS s16x4v*)(sb + HM_KM + co); }
                const s16x4v vt = *(LAS s16x4v*)(sb + HM_VT + (16 * wid + fr) * 40 + 8 * fq);
                f32x4 pt = {0.f, 0.f, 0.f, 0.f};
#pragma unroll
                for (int dt = 0; dt < 4; ++dt) pt = MFMA16(km[dt], qm[dt], pt);
#pragma unroll
                for (int i = 0; i < 4; ++i) if (4 * fq + i > fr) pt[i] = 0.f;
                f32x4 ot = {0.f, 0.f, 0.f, 0.f};
#pragma unroll
                for (int dt = 0; dt < 4; ++dt) ot = MFMA16(pack4(Sacc[dt]), qs[dt], ot);
                ot = MFMA16(vt, pack4(pt), ot);
                *(LAS f32x4*)(lds + HM_OB + (n & 1) * 16 * HM_OSTR + fr * HM_OSTR + 4 * (16 * wid + 4 * fq)) = ot;
#pragma unroll
                for (int dt = 0; dt < 4; ++dt) { const f32x4 dc = *(LAS f32x4*)(sb + HM_DEC + 4 * (16 * dt + 4 * fq));
                    const s16x4v ke = *(LAS s16x4v*)(sb + HM_KET + (16 * dt + fr) * 40 + 8 * fq);
                    Sacc[dt] = MFMA16(ke, vt, Sacc[dt] * dc); }
            }
        }
        asm volatile("s_waitcnt lgkmcnt(0)\n\ts_barrier" ::: "memory");
    }
#undef HM_DMA
}

constexpr int PL_U = 0, PL_D = 79 * 512, PL_DSTR = 528, PL_Y = PL_D + 64 * PL_DSTR, PL_YSTR = 272;
static_assert(PL_Y + 8 * 32 * PL_YSTR <= 147392, "pooling LDS map");
DI void pool_unit(ldsp lds, const bf16_t* pj, bf16_t* mx, int t0, const bf16_t* wt  , const float* pscale) {
    wt = launder(wt); pscale = launder(pscale);
    int tid_ = threadIdx.x; asm volatile("" : "+v"(tid_));
    const int tid = tid_, lane = tid & 63, wid = __builtin_amdgcn_readfirstlane(tid >> 6), r = lane & 31, hh = lane >> 5;
    for (int idx = tid; idx < 79 * 32; idx += 512) { const int rr = idx >> 5, c16 = idx & 31, tok = t0 - 15 + rr;
        u32x4 v = {0u, 0u, 0u, 0u};
        if (tok >= 0) v = *(const u32x4*)(pj + (size_t)tok * NP + C_PV + 8 * c16);
        *(LAS u32x4*)(lds + PL_U + rr * 512 + 16 * c16) = v; }
    const int g = wid >> 1, th = wid & 1;
    bf16x8 bw[2][4];
#pragma unroll
    for (int nt = 0; nt < 2; ++nt)
#pragma unroll
        for (int ks = 0; ks < 4; ++ks) bw[nt][ks] = *(const bf16x8*)(wt + (size_t)(g * 64 + 32 * nt + r) * 64 + 16 * ks + 8 * hh);
    __syncthreads();
    { const int vec = lane & 7, run = lane >> 3, win = 2 << g, tl0 = 32 * th + 4 * run;
      ldsp ub = lds + PL_U + (15 + tl0) * 512 + g * 128 + vec * 16;
      float acc[8];
#pragma unroll
      for (int j = 0; j < 8; ++j) acc[j] = 0.f;
      for (int j = 0; j < win; ++j) { const u32x4 v = *(LAS u32x4*)(ub - j * 512);
          acc[0] += bf_lo(v.x); acc[1] += bf_hi(v.x); acc[2] += bf_lo(v.y); acc[3] += bf_hi(v.y); acc[4] += bf_lo(v.z); acc[5] += bf_hi(v.z); acc[6] += bf_lo(v.w); acc[7] += bf_hi(v.w); }
#pragma unroll
      for (int k = 0; k < 4; ++k) {
          const u32x4 u = *(LAS u32x4*)(ub + k * 512);
          const float us[8] = {bf_lo(u.x), bf_hi(u.x), bf_lo(u.y), bf_hi(u.y), bf_lo(u.z), bf_hi(u.z), bf_lo(u.w), bf_hi(u.w)};
          if (k > 0) { const u32x4 o = *(LAS u32x4*)(ub + (k - win) * 512);
              const float os[8] = {bf_lo(o.x), bf_hi(o.x), bf_lo(o.y), bf_hi(o.y), bf_lo(o.z), bf_hi(o.z), bf_lo(o.w), bf_hi(o.w)};
#pragma unroll
              for (int j = 0; j < 8; ++j) acc[j] += us[j] - os[j]; }
          const int t = t0 + tl0 + k, cnt = (t + 1 < win) ? t + 1 : win;
          const float icnt = 1.0f / (float)cnt;
          *(LAS u32x4*)(lds + PL_D + (tl0 + k) * PL_DSTR + g * 128 + vec * 16) = (u32x4){pk2(acc[0] * icnt - us[0], acc[1] * icnt - us[1]), pk2(acc[2] * icnt - us[2], acc[3] * icnt - us[3]),
                                                                                      pk2(acc[4] * icnt - us[4], acc[5] * icnt - us[5]), pk2(acc[6] * icnt - us[6], acc[7] * icnt - us[7])};
      } }
    { f32x16 y0, y1;
#pragma unroll
      for (int i = 0; i < 16; ++i) { y0[i] = 0.f; y1[i] = 0.f; }
#pragma unroll
      for (int ks = 0; ks < 4; ++ks) { const bf16x8 a = *(LAS bf16x8*)(lds + PL_D + (32 * th + r) * PL_DSTR + (64 * g + 16 * ks + 8 * hh) * 2);
          y0 = MFMA32(a, bw[0][ks], y0); y1 = MFMA32(a, bw[1][ks], y1); }
      const float sc0 = pscale[64 * g + r], sc1 = pscale[64 * g + 32 + r];
      ldsp ys = lds + PL_Y + wid * 32 * PL_YSTR;
#pragma unroll
      for (int i = 0; i < 16; ++i) { *(LAS float*)(ys + crow(i, hh) * PL_YSTR + 4 * r) = y0[i] * sc0; *(LAS float*)(ys + crow(i, hh) * PL_YSTR + 4 * (32 + r)) = y1[i] * sc1; }
      const int tok = lane >> 1, hf = lane & 1;
      const size_t trow = (size_t)(t0 + 32 * th + tok);
#pragma unroll
      for (int k = 0; k < 4; ++k) {
          const u32x4 gv = *(const u32x4*)(pj + trow * NP + C_PG + 64 * g + 32 * hf + 8 * k);
          const f32x4 ya = *(LAS f32x4*)(ys + tok * PL_YSTR + 4 * (32 * hf + 8 * k)), yb = *(LAS f32x4*)(ys + tok * PL_YSTR + 4 * (32 * hf + 8 * k + 4));
          *(u32x4*)(mx + trow * DMIX + O_POOL + 64 * g + 32 * hf + 8 * k) = (u32x4){pk2(ya.x * silu_f(bf_lo(gv.x)), ya.y * silu_f(bf_hi(gv.x))), pk2(ya.z * silu_f(bf_lo(gv.y)), ya.w * silu_f(bf_hi(gv.y))),
                                                                                  pk2(yb.x * silu_f(bf_lo(gv.z)), yb.y * silu_f(bf_hi(gv.z))), pk2(yb.z * silu_f(bf_lo(gv.w)), yb.w * silu_f(bf_hi(gv.w)))}; } }
    __syncthreads();
}

constexpr int U_HG = 128, U_AT = 1024, U_PL = 1024;
constexpr int U_ME = 256;
constexpr int U0_ME = U_HG, U0_SB = U0_ME + U_ME, U0_FX = U0_SB + U_AT, U0_PL = U0_FX + U_AT, U_TOTAL = U0_PL + U_PL;
DI void mixer_phase(ldsp lds, int layer, int cslot) {
    LAS int* slot = (LAS int*)(lds + LDS_SLOT);
    for (;;) {
        __syncthreads();
        if (threadIdx.x == 0) *slot = (int)atomicAdd((unsigned*)(kargs()->ws + WS_CTL) + 64 * cslot, 1u);
        __syncthreads();
        const int u = __builtin_amdgcn_readfirstlane(*slot);
        if (u >= U_TOTAL) break;
        kargp P = kargs();
        const bf16_t* proj = (const bf16_t*)(P->ws + WS_PROJ); bf16_t* mixed = (bf16_t*)(P->ws + WS_MIX);
        if (u < U0_ME) {
#ifndef NO_HGRN
            const int b = u >> 2, h = u & 3;
#pragma unroll 1
            for (int rep = 0; rep < ((PROBE_UNIT & 1) ? 2 : 1); ++rep)
            hgrn_unit(lds, proj + (size_t)b * SEQ * NP, mixed + (size_t)b * SEQ * DMIX, h, layer, P->lb_logits, P->hgrn_out_norm + layer * 256);
#endif
        } else if (u < U0_SB) {
#ifndef NO_MEM
            const int i = u - U0_ME, qt = 4 * (i >> 7), bh = i & 127, b = bh >> 2, h = bh & 3;
            const bf16_t* pb = proj + (size_t)b * SEQ * NP + h * HD; bf16_t* ob = mixed + (size_t)b * SEQ * DMIX + O_MEM + h * HD;
            const bf16_t* kb = (const bf16_t*)(P->ws + WS_KVM + layer * KVM_BYTES) + (size_t)b * NMEM * 512 + h * HD;
#pragma unroll 1
            for (int rep = 0; rep < ((PROBE_UNIT & 8) ? 2 : 1); ++rep)
            attn_unit<2>(lds, pb + C_MQ, kb, kb + 256, 512, pb + C_MG, ob, nullptr, P->mem_q_norm + layer * HD, P->mem_k_norm + layer * HD, qt, 4);
#endif
        } else if (u < U0_FX) {
#ifndef NO_SB
            const int i = u - U0_SB, qt = 7 - (i >> 7), bh = i & 127, b = bh >> 2, h = bh & 3;
            const bf16_t* pb = proj + (size_t)b * SEQ * NP + h * HD; bf16_t* ob = mixed + (size_t)b * SEQ * DMIX + O_SB + h * HD;
#pragma unroll 1
            for (int rep = 0; rep < ((PROBE_UNIT & 2) ? 2 : 1); ++rep)
            attn_unit<1>(lds, pb + C_SQ, pb + C_SK, pb + C_SV, NP, pb + C_SG, ob, nullptr, nullptr, nullptr, qt, 1);
#endif
        } else if (u < U0_PL) {
#ifndef NO_FOX
            const int i = u - U0_FX, qt = 7 - (i >> 7), bh = i & 127, b = bh >> 2, h = bh & 3;
            const bf16_t* pb = proj + (size_t)b * SEQ * NP + h * HD; bf16_t* ob = mixed + (size_t)b * SEQ * DMIX + O_FOX + h * HD;
            const float* lfp = (const float*)(P->ws + WS_LF) + (size_t)b * SEQ * 4 + h;
#pragma unroll 1
            for (int rep = 0; rep < ((PROBE_UNIT & 4) ? 2 : 1); ++rep)
            attn_unit<0>(lds, pb + C_FQ, pb + C_FK, pb + C_FV, NP, pb + C_FG, ob, lfp, P->fox_q_norm + layer * HD, P->fox_k_norm + layer * HD, qt, 1);
#endif
        } else {
#ifndef NO_POOL
            const int i = u - U0_PL, b = i >> 5, t0 = (i & 31) * 64;
#pragma unroll 1
            for (int rep = 0; rep < ((PROBE_UNIT & 16) ? 2 : 1); ++rep)
            pool_unit(lds, proj + (size_t)b * SEQ * NP, mixed + (size_t)b * SEQ * DMIX, t0, (const bf16_t*)(P->ws + WS_WPOOL + layer * WPOOL_BYTES), P->pool_scale + layer * 256);
#endif
        }
    }
}

#define XB_TMO      128
#define XB_XCNT(j)  (256  + 64 * (j))
#define XB_XSUB(j)  (1280 + 64 * (j))
#define XB_XGEN(j)  (2304 + 64 * (j))
#define XB_TOP      3328
#define XB_TOPGEN   3392
#define XCD_BAR_WORDS 3456
#define XB_SPIN_CAP (1u << 18)

__device__ __forceinline__ unsigned xb_ld(unsigned* p)              { return __hip_atomic_load(p, __ATOMIC_RELAXED, __HIP_MEMORY_SCOPE_AGENT); }
__device__ __forceinline__ unsigned xb_add(unsigned* p, unsigned v) { return __hip_atomic_fetch_add(p, v, __ATOMIC_RELAXED, __HIP_MEMORY_SCOPE_AGENT); }
__device__ __forceinline__ unsigned xb_xcc_id() { return (unsigned)__builtin_amdgcn_s_getreg((3 << 11) | 20) & 0xFu; }
#define XB_SPIN(cond, bar) do { unsigned _sp = 0; while (cond) { __builtin_amdgcn_s_sleep(1); \
    if ((++_sp & 255u) == 0u) { if (xb_ld(&(bar)[XB_TMO])) break; if (_sp > XB_SPIN_CAP) { atomicAdd(&(bar)[XB_TMO], 1u); break; } } } } while (0)

struct XcdBarrier {
    unsigned* bar; unsigned x;
    volatile LAS unsigned* st;
};

__device__ __forceinline__ XcdBarrier xcd_barrier_post(unsigned* bar, volatile LAS unsigned* st) {
    XcdBarrier b; b.bar = bar; b.x = xb_xcc_id(); b.st = st;
    if (threadIdx.x == 0) (void)xb_add(&bar[XB_XCNT(b.x)], 1u);
    return b;
}
__device__ __forceinline__ void xcd_barrier_complete(unsigned* bar, unsigned x, unsigned& nloc, unsigned& nx) {
    const unsigned G = gridDim.x * gridDim.y * gridDim.z;
    unsigned sum, cnt, mine, sp = 0u;
    for (;;) {
        sum = 0u; cnt = 0u; mine = 0u;
#pragma unroll
        for (unsigned j = 0; j < 16; ++j) { const unsigned c = xb_ld(&bar[XB_XCNT(j)]); sum += c; cnt += (c > 0u) ? 1u : 0u; mine = (j == x) ? c : mine; }
        if (sum == G) break;
        __builtin_amdgcn_s_sleep(1);
        if ((++sp & 255u) == 0u) { if (xb_ld(&bar[XB_TMO])) break; if (sp > XB_SPIN_CAP) { atomicAdd(&bar[XB_TMO], 1u); break; } }
    }
    nloc = mine > 0u ? mine : 1u; nx = cnt > 0u ? cnt : 1u;
}

__device__ __forceinline__ void xcd_barrier(const XcdBarrier& b) {
    asm volatile("s_waitcnt vmcnt(0)" ::: "memory");
    __syncthreads();
    if (threadIdx.x == 0) {
        unsigned* bar = b.bar;
        __builtin_amdgcn_s_waitcnt(0);
        unsigned nloc = b.st[0], nx = b.st[1];
        if (nloc == 0u) { xcd_barrier_complete(bar, b.x, nloc, nx); b.st[0] = nloc; b.st[1] = nx; }
        const unsigned old = xb_add(&bar[XB_XSUB(b.x)], 1u);
        const unsigned gen = old / nloc;
        if (old + 1u == (gen + 1u) * nloc) {
            __builtin_amdgcn_fence(__ATOMIC_RELEASE, "agent");
            asm volatile("s_waitcnt vmcnt(0)" ::: "memory");
            const unsigned og = xb_add(&bar[XB_TOP], 1u);
            const unsigned tg = og / nx;
            if (og + 1u == (tg + 1u) * nx) xb_add(&bar[XB_TOPGEN], 1u);
            else XB_SPIN(xb_ld(&bar[XB_TOPGEN]) == tg, bar);
            __builtin_amdgcn_fence(__ATOMIC_ACQUIRE, "agent");
            xb_add(&bar[XB_XGEN(b.x)], 1u);
            asm volatile("s_waitcnt vmcnt(0)" ::: "memory");
        } else {
            XB_SPIN(xb_ld(&bar[XB_XGEN(b.x)]) == gen, bar);
            __builtin_amdgcn_fence(__ATOMIC_ACQUIRE, "agent");
            asm volatile("s_waitcnt vmcnt(0)" ::: "memory");
        }
    }
    __syncthreads();
}

constexpr int CW_XBAR = 1024;
DI void seam_barrier(ldsp lds) {
    XcdBarrier b; b.bar = (unsigned*)(kargs()->ws + WS_CTL) + CW_XBAR; b.x = xb_xcc_id(); b.st = (volatile LAS unsigned*)(lds + LDS_BYTES - 32);
    xcd_barrier(b);
}

constexpr int N_PHASES = 8;
DI void in_gemm(ldsp lds, int layer) {
    kargp P = kargs(); unsigned char* ws = P->ws;
    pg8::Gemm g{(const bf16_t*)(ws + WS_HB), (const bf16_t*)(ws + WS_WIN + layer * WIN_BYTES), NTOK, NP, DM}; pg8::StaticOrder S; S.init(NTOK, NP, gridDim.x, blockIdx.x);
    if (EPI_NORM && layer == 1) {
        { const int tid = threadIdx.x, lane = tid & 63, wave = __builtin_amdgcn_readfirstlane(tid >> 6), p16 = lane & 15;
          const float* ssp = (const float*)(ws + WS_SSP); const float* ffp = (const float*)(ws + WS_FFP); float* lf = (float*)(ws + WS_LF);
          const f32x4 bias = *(const f32x4*)(P->fox_f_bias + NH);
          for (int r4 = blockIdx.x * 8 + wave; r4 < NTOK / 4; r4 += gridDim.x * 8) { const size_t row = (size_t)r4 * 4 + (lane >> 4);
              const float s1 = sum16(ssp[row * 16 + p16]); f32x4 f = *(const f32x4*)(ffp + (row * 16 + p16) * 4);
              f.x = sum16(f.x); f.y = sum16(f.y); f.z = sum16(f.z); f.w = sum16(f.w);
              const float rstd = 1.0f / sqrtf(s1 * (1.f / DM) + EPS);
              if (p16 < 4) { const float z = (p16 == 0 ? f.x : p16 == 1 ? f.y : p16 == 2 ? f.z : f.w) * rstd + (p16 == 0 ? bias.x : p16 == 1 ? bias.y : p16 == 2 ? bias.z : bias.w);
                  lf[row * 4 + p16] = fminf(z, 0.f) - log1pf(expf(-fabsf(z))); } } }
        pg8::EpiBf16RowScale E{(bf16_t*)(ws + WS_PROJ), NP, (const float*)(ws + WS_SSP), 1.f / DM, EPS};
        pg8::gemm_phase<pg8::EpiBf16RowScale, pg8::StaticOrder, true, true>(lds, g, S, E);
    } else {
        pg8::EpiBf16<0> E{(bf16_t*)(ws + WS_PROJ), NP, nullptr, 0, 0, 1.f};
        pg8::gemm_phase<pg8::EpiBf16<0>, pg8::StaticOrder, true, true>(lds, g, S, E);
    }
}
DI void kv_gemm(ldsp lds) {
    const int bid = blockIdx.x; if (bid >= 128) return;
    kargp P = kargs(); unsigned char* ws = P->ws; const int l2 = bid >> 6;
    pg8::Gemm g{(const bf16_t*)(ws + WS_MNB + l2 * MNB_BYTES), (const bf16_t*)(ws + WS_WKV + l2 * WKV_BYTES), NB * NMEM, 512, DM}; pg8::StaticOrder S; S.init(NB * NMEM, 512, 64, bid & 63);
    pg8::EpiBf16<0> E{(bf16_t*)(ws + WS_KVM + l2 * KVM_BYTES), 512, nullptr, 0, 0, 1.f};
    pg8::gemm_phase<pg8::EpiBf16<0>, pg8::StaticOrder, true, true>(lds, g, S, E);
}
DI void out_gemm(ldsp lds, int layer) {
    kargp P = kargs(); unsigned char* ws = P->ws;
    pg8::Gemm g{(const bf16_t*)(ws + WS_MIX), (const bf16_t*)(ws + WS_WOUT + layer * WOUT_BYTES), NTOK, DM, DMIX}; pg8::StaticOrder S; S.init(NTOK, DM, gridDim.x, blockIdx.x);
    if (EPI_NORM && layer == 0) { pg8::EpiResStats E{P->x, P->out, DM, (unsigned short*)(ws + WS_HB), (const float*)(ws + WS_GW), (float*)(ws + WS_SSP), (float*)(ws + WS_FFP)};
        pg8::gemm_phase<pg8::EpiResStats, pg8::StaticOrder, true, true>(lds, g, S, E); }
    else { pg8::EpiRes E{layer == 0 ? P->x : P->out, P->out, DM};
        pg8::gemm_phase<pg8::EpiRes, pg8::StaticOrder, true, true>(lds, g, S, E); }
    if (FUSE_NORM && layer + 1 < DEPTH) {
        const int tid = threadIdx.x, lane = tid & 63, wave = __builtin_amdgcn_readfirstlane(tid >> 6);
        __threadfence();
        __syncthreads();
        LAS int* todo = (LAS int*)(lds + 16384);
        if (tid == 0) { int cnt = 0; pg8::Unit u;
            for (int i = 0; S.next(i, u); ++i) { const unsigned old = atomicAdd((unsigned*)(kargs()->ws + WS_CTL) + 256 + u.pm, 1u); if (old == (unsigned)(DM / 256 - 1)) todo[1 + cnt++] = u.pm; }
            todo[0] = cnt; }
        __syncthreads();
        const int ncnt = __builtin_amdgcn_readfirstlane(todo[0]);
        int pms[4];
#pragma unroll
        for (int i = 0; i < 4; ++i) pms[i] = __builtin_amdgcn_readfirstlane(todo[1 + (i < ncnt ? i : 0)]);
        __threadfence();
        if (ncnt > 0) {
            kargp Q = kargs(); const int nl = layer + 1;
#pragma unroll 1
            for (int i = 0; i < ncnt; ++i) { const int pm = i == 0 ? pms[0] : i == 1 ? pms[1] : i == 2 ? pms[2] : pms[3];
                norm_phase(lds, Q->out, Q->norm_g + nl * DM, Q->w_in + (size_t)nl * DM * DIN, Q->fox_f_bias + nl * NH, (bf16_t*)(Q->ws + WS_HB), (float*)(Q->ws + WS_LF), pm * 256 + wave, 8, pm * 256 + 256, tid, lane); }
        }
    }
}
DI void do_norm(ldsp lds, int nl) {
    kargp P = kargs(); const int tid = threadIdx.x, lane = tid & 63, wave = __builtin_amdgcn_readfirstlane(tid >> 6);
    norm_phase(lds, nl ? P->out : P->x, P->norm_g + nl * DM, P->w_in + (size_t)nl * DM * DIN, P->fox_f_bias + nl * NH, (bf16_t*)(P->ws + WS_HB), (float*)(P->ws + WS_LF), blockIdx.x * 8 + wave, gridDim.x * 8, NTOK, tid, lane);
}
__global__ void __launch_bounds__(512, 2) hybrid_fwd(Params Parg) {
    extern __shared__ __attribute__((aligned(16))) unsigned char lds_raw[];
    ldsp lds = (ldsp)lds_raw;
    const int lo = kargs()->ph_lo, hi = kargs()->ph_hi;
    { volatile LAS unsigned* bst = (volatile LAS unsigned*)(lds + LDS_BYTES - 32);
      if (threadIdx.x < 2) bst[threadIdx.x] = 0u;
      __syncthreads();
      (void)xcd_barrier_post((unsigned*)(kargs()->ws + WS_CTL) + CW_XBAR, bst); }
#define IN(k) (lo <= (k) && (k) < hi)
#define SEAM(k) do { if (IN(k) && IN((k) + 1) && !(EPI_NORM && (k) == 4)) { if ((k) == 0) cg::this_grid().sync(); else seam_barrier(lds); } } while (0)
    if (IN(0)) {
        const int tid = threadIdx.x, lane = tid & 63, wave = __builtin_amdgcn_readfirstlane(tid >> 6);
        weights_phase(lds, blockIdx.x * 8 + wave, gridDim.x * 8, wave, lane);
        __syncthreads();
        memnorm_phase(blockIdx.x * 8 + wave, gridDim.x * 8, lane);
        do_norm(lds, 0);
    }
    SEAM(0);
    if (IN(1)) { in_gemm(lds, 0); kv_gemm(lds);
#if PROBE_PH & 2
        __syncthreads(); in_gemm(lds, 0);
#endif
    }
    SEAM(1);
    if (IN(2)) { mixer_phase(lds, 0, 0);
#if PROBE_PH & 4
        mixer_phase(lds, 0, 2);
#endif
    }
    SEAM(2);
    if (IN(3)) out_gemm(lds, 0);
    SEAM(3);
    if (IN(4) && !EPI_NORM) do_norm(lds, 1);
    SEAM(4);
    if (IN(5)) in_gemm(lds, 1);
    SEAM(5);
    if (IN(6)) mixer_phase(lds, 1, 1);
    SEAM(6);
    if (IN(7)) out_gemm(lds, 1);
#undef IN
#undef SEAM
}

extern "C" void kernel_launch(void* const* d_in, const int* in_sizes, int n_in, void* d_out, int out_size, void* d_ws, size_t ws_size, hipStream_t stream) {
    static int grid = 0;
    if (grid == 0) {
        if (n_in != 16 || in_sizes[0] != NTOK * DM || out_size != NTOK * DM || ws_size < WS_END) { fprintf(stderr, "kernel_launch: unexpected shapes (n_in %d, in0 %d, out %d, ws %zu)\n", n_in, n_in > 0 ? in_sizes[0] : -1, out_size, ws_size); grid = -1; return; }
        int dev = 0, cus = 0, per_cu = 0;
        (void)hipGetDevice(&dev); (void)hipDeviceGetAttribute(&cus, hipDeviceAttributeMultiprocessorCount, dev);
        if (hipFuncSetAttribute((const void*)hybrid_fwd, hipFuncAttributeMaxDynamicSharedMemorySize, LDS_BYTES) != hipSuccess) { fprintf(stderr, "kernel_launch: hipFuncSetAttribute failed\n"); grid = -1; return; }
        if (hipOccupancyMaxActiveBlocksPerMultiprocessor(&per_cu, (const void*)hybrid_fwd, 512, LDS_BYTES) != hipSuccess || per_cu < 1) { fprintf(stderr, "kernel_launch: occupancy query gave %d\n", per_cu); per_cu = 1; }
        (void)hipGetLastError();
        grid = cus * per_cu;
    }
    if (grid < 0) return;
    (void)hipMemsetAsync((char*)d_ws + WS_CTL, 0, CTL_ZERO_BYTES, stream);
    Params p{};
    p.x = (const float*)d_in[0]; p.mem = (const float*)d_in[1]; p.norm_g = (const float*)d_in[2]; p.w_in = (const float*)d_in[3]; p.fox_f_bias = (const float*)d_in[4];
    p.fox_q_norm = (const float*)d_in[5]; p.fox_k_norm = (const float*)d_in[6]; p.lb_logits = (const float*)d_in[7]; p.hgrn_out_norm = (const float*)d_in[8]; p.pool_w = (const float*)d_in[9];
    p.pool_scale = (const float*)d_in[10]; p.mem_norm_g = (const float*)d_in[11]; p.mem_w_kv = (const float*)d_in[12]; p.mem_q_norm = (const float*)d_in[13]; p.mem_k_norm = (const float*)d_in[14];
    p.w_out = (const float*)d_in[15]; p.out = (float*)d_out; p.ws = (unsigned char*)d_ws;
#if MK_SINGLE_LAUNCH
    p.ph_lo = 0; p.ph_hi = N_PHASES;
    void* args[] = {&p};
    const hipError_t e = hipLaunchCooperativeKernel((const void*)hybrid_fwd, dim3(grid), dim3(512), args, LDS_BYTES, stream);
    if (e != hipSuccess) fprintf(stderr, "kernel_launch: cooperative launch failed: %s (grid %d)\n", hipGetErrorString(e), grid);
#else
    for (int ph = 0; ph < N_PHASES; ++ph) { p.ph_lo = ph; p.ph_hi = ph + 1; hipLaunchKernelGGL(hybrid_fwd, dim3(grid), dim3(512), LDS_BYTES, stream, p); }
#endif
}
```
